# Optimizing an MI355X kernel written in HIP

```python
import math
import jax
import jax.numpy as jnp
from jax import lax
import numpy as np

D_MODEL = 1024
BATCH = 32
SEQ = 2048
DEPTH = 4

CTX_LEN = 256
GRID_W = 64
N_GROUPS = 4
GROUP_W = D_MODEL // N_GROUPS
MIX_W = N_GROUPS * GROUP_W
HEAD_DIM = 64
ROPE_DIM = 32
ROPE_THETA = 10000.0
QBLOCK = 128
NORM_EPS = 1e-6
NEG_INF = -1e30

NA_HEADS = GROUP_W // HEAD_DIM
NA_KH = 8
NA_KW = 16
MLA_HEADS = GROUP_W // HEAD_DIM
MLA_Q_RANK = GROUP_W
MLA_KV_RANK = D_MODEL // 8
MLA_NOPE = HEAD_DIM
MLA_V = HEAD_DIM
RWKV_HEADS = GROUP_W // HEAD_DIM
RWKV_N = HEAD_DIM
RWKV_W_RANK = 32
RWKV_A_RANK = 32
RWKV_G_RANK = 64
RWKV_LN_EPS = 64e-5
DIFF_HEADS = GROUP_W // HEAD_DIM
DIFF_QK = HEAD_DIM // 2
DIFF_V = HEAD_DIM
DIFF_LN_EPS = 1e-5
D_FF = ((8 * D_MODEL // 3 + 127) // 128) * 128

NA_COLS = 3 * GROUP_W
MLA_COLS = MLA_Q_RANK + MLA_KV_RANK + ROPE_DIM
RWKV_COLS = 3 * GROUP_W + RWKV_W_RANK + RWKV_A_RANK + RWKV_G_RANK
DIFF_COLS = 3 * GROUP_W
IN_COLS = NA_COLS + MLA_COLS + RWKV_COLS + DIFF_COLS
IN_SPLITS = (NA_COLS, NA_COLS + MLA_COLS, NA_COLS + MLA_COLS + RWKV_COLS)
RWKV_SPLITS = (GROUP_W, 2 * GROUP_W, 3 * GROUP_W, 3 * GROUP_W + RWKV_W_RANK,
               3 * GROUP_W + RWKV_W_RANK + RWKV_A_RANK)

kernel_name = 'hybrid_parallel_group_dit'


def rmsnorm(x, g, eps=NORM_EPS):
    xf = x.astype(jnp.float32)
    y = xf * lax.rsqrt(jnp.mean(xf * xf, axis=-1, keepdims=True) + eps)
    return (y * g.astype(jnp.float32)).astype(x.dtype)


def shift_prev(x):
    return jnp.pad(x, ((0, 0), (1, 0), (0, 0)))[:, :-1]


def shift_next(x):
    return jnp.pad(x, ((0, 0), (0, 1), (0, 0)))[:, 1:]


def axial_rope_tables(n_tokens, dtype):
    t = jnp.arange(n_tokens)
    row = (t // GRID_W).astype(jnp.float32)
    col = (t % GRID_W).astype(jnp.float32)
    half = ROPE_DIM // 2
    freqs = ROPE_THETA ** (-jnp.arange(0, half, 2, dtype=jnp.float32) / half)
    ar = row[:, None] * freqs[None, :]
    ac = col[:, None] * freqs[None, :]
    ang = jnp.concatenate([ar, ar, ac, ac], axis=-1)
    return jnp.cos(ang).astype(dtype), jnp.sin(ang).astype(dtype)


def apply_axial_rope(x, cos, sin):
    r1, r2, c1, c2 = jnp.split(x, 4, axis=-1)
    rot = jnp.concatenate([-r2, r1, -c2, c1], axis=-1)
    shape = (1, cos.shape[0]) + (1,) * (x.ndim - 3) + (cos.shape[1],)
    return x * cos.reshape(shape) + rot * sin.reshape(shape)


def map_query_blocks(fn, q):
    B, T = q.shape[0], q.shape[1]
    nb = T // QBLOCK
    qb = jnp.moveaxis(q.reshape((B, nb, QBLOCK) + q.shape[2:]), 1, 0)
    o = jnp.moveaxis(lax.map(fn, qb), 0, 1)
    return o.reshape((B, T) + o.shape[3:])


def softmax_attention(q, k, v, scale):
    s = jnp.einsum('bqhd,bkhd->bhqk', q, k).astype(jnp.float32) * scale
    p = jax.nn.softmax(s, axis=-1).astype(v.dtype)
    return jnp.einsum('bhqk,bkhd->bqhd', p, v)


def neighbourhood_attention(q, k, v, kc, vc, rpb):
    B, T, H, d = q.shape
    rows = T // GRID_W
    kh = min(NA_KH, rows)
    scale = d ** -0.5
    qg = q.reshape(B, rows, GRID_W, H, d)
    kg = k.reshape(B, rows, GRID_W, H, d)
    vg = v.reshape(B, rows, GRID_W, H, d)
    cpos = np.arange(GRID_W)
    cstart = np.clip(cpos - NA_KW // 2, 0, GRID_W - NA_KW)
    col_mask = (cpos[None, :] >= cstart[:, None]) & (cpos[None, :] < cstart[:, None] + NA_KW)
    col_idx = np.clip(cpos[None, :] - cpos[:, None] + NA_KW - 1, 0, 2 * NA_KW - 2)
    mask = jnp.asarray(np.tile(col_mask, (1, kh)))
    n_lat = kh * GRID_W

    def row_block(r):
        rs = jnp.clip(r - kh // 2, 0, rows - kh)
        q_r = lax.dynamic_index_in_dim(qg, r, axis=1, keepdims=False)
        k_r = lax.dynamic_slice_in_dim(kg, rs, kh, axis=1).reshape(B, n_lat, H, d)
        v_r = lax.dynamic_slice_in_dim(vg, rs, kh, axis=1).reshape(B, n_lat, H, d)
        row_off = rs + jnp.arange(kh) - r + NA_KH - 1
        bias = rpb[:, row_off][:, :, col_idx]
        bias = bias.transpose(0, 2, 1, 3).reshape(H, GRID_W, n_lat)
        s_lat = jnp.einsum('bqhd,bkhd->bhqk', q_r, k_r).astype(jnp.float32) * scale + bias.astype(jnp.float32)
        s_lat = jnp.where(mask, s_lat, NEG_INF)
        s_ctx = jnp.einsum('bqhd,bkhd->bhqk', q_r, kc).astype(jnp.float32) * scale
        p = jax.nn.softmax(jnp.concatenate([s_lat, s_ctx], axis=-1), axis=-1).astype(v.dtype)
        return (jnp.einsum('bhqk,bkhd->bqhd', p[..., :n_lat], v_r)
                + jnp.einsum('bhqk,bkhd->bqhd', p[..., n_lat:], vc))

    out = lax.map(row_block, jnp.arange(rows))
    return out.transpose(1, 0, 2, 3, 4).reshape(B, T, H * d)


def na_mixer(z_lat, z_ctx, rpb, need_ctx):
    B = z_lat.shape[0]
    ql, kl, vl = [t.reshape(B, -1, NA_HEADS, HEAD_DIM) for t in jnp.split(z_lat, 3, axis=-1)]
    qc, kc, vc = [t.reshape(B, -1, NA_HEADS, HEAD_DIM) for t in jnp.split(z_ctx, 3, axis=-1)]
    y_lat = neighbourhood_attention(ql, kl, vl, kc, vc, rpb)
    y_ctx = softmax_attention(qc, kc, vc, HEAD_DIM ** -0.5).reshape(B, -1, GROUP_W) if need_ctx else None
    return y_lat, y_ctx


def mla_project(z, q_norm, kv_norm, w_uq, w_ukv, cos, sin, rotary):
    B, T, _ = z.shape
    cq, ckv, k_rope = jnp.split(z, (MLA_Q_RANK, MLA_Q_RANK + MLA_KV_RANK), axis=-1)
    q = (rmsnorm(cq, q_norm) @ w_uq).reshape(B, T, MLA_HEADS, MLA_NOPE + ROPE_DIM)
    kv = (rmsnorm(ckv, kv_norm) @ w_ukv).reshape(B, T, MLA_HEADS, MLA_NOPE + MLA_V)
    q_nope, q_rope = jnp.split(q, (MLA_NOPE,), axis=-1)
    k_nope, v = jnp.split(kv, (MLA_NOPE,), axis=-1)
    if rotary:
        q_rope = apply_axial_rope(q_rope, cos, sin)
        k_rope = apply_axial_rope(k_rope, cos, sin)
    k_rope = jnp.broadcast_to(k_rope[:, :, None, :], (B, T, MLA_HEADS, ROPE_DIM))
    return (jnp.concatenate([q_nope, q_rope], axis=-1),
            jnp.concatenate([k_nope, k_rope], axis=-1), v)


def mla_mixer(z_lat, z_ctx, cos, sin, q_norm, kv_norm, w_uq, w_ukv, need_ctx):
    B, T, _ = z_lat.shape
    ql, kl, vl = mla_project(z_lat, q_norm, kv_norm, w_uq, w_ukv, cos, sin, True)
    qc, kc, vc = mla_project(z_ctx, q_norm, kv_norm, w_uq, w_ukv, cos, sin, False)
    scale = (MLA_NOPE + ROPE_DIM) ** -0.5
    k_all = jnp.concatenate([kl, kc], axis=1)
    v_all = jnp.concatenate([vl, vc], axis=1)
    y_lat = map_query_blocks(lambda qi: softmax_attention(qi, k_all, v_all, scale), ql).reshape(B, T, GROUP_W)
    y_ctx = softmax_attention(qc, kc, vc, scale).reshape(B, -1, GROUP_W) if need_ctx else None
    return y_lat, y_ctx


def rwkv7_prepare(z, mu, w0, w_up, a0, a_up, g_up, k_k, k_a):
    B, T, _ = z.shape
    zs = z + mu[0] * (shift_prev(z) - z) + mu[1] * (shift_next(z) - z)
    r, k, v, wd, ad, gd = jnp.split(zs, RWKV_SPLITS, axis=-1)

    def heads(t):
        return t.reshape(B, T, RWKV_HEADS, RWKV_N)

    kk = heads(k * k_k).astype(jnp.float32)
    kk = (kk * lax.rsqrt(jnp.maximum(jnp.sum(kk * kk, axis=-1, keepdims=True), 1e-24))).astype(z.dtype)
    g = jax.nn.sigmoid(gd) @ g_up
    per_dir = []
    for d in range(2):
        w = -jax.nn.softplus(-(w0[d] + jnp.tanh(wd) @ w_up[d])) - 0.5
        decay = jnp.exp(-jnp.exp(w.astype(jnp.float32)))
        a = jax.nn.sigmoid(a0[d] + ad @ a_up[d])
        kd = k * (1.0 + (a - 1.0) * k_a)
        per_dir.append((heads(decay), heads(kd), -kk, kk * heads(a)))
    return heads(r), heads(k), heads(v), g, per_dir


def rwkv7_scan(r, decay, k, v, a, b, s0, reverse):
    def step(S, inp):
        r_t, w_t, k_t, v_t, a_t, b_t = inp
        sa = jnp.einsum('bhij,bhj->bhi', S, a_t)
        S = S * w_t[:, :, None, :] + sa[..., None] * b_t[:, :, None, :] + v_t[..., None] * k_t[:, :, None, :]
        return S, jnp.einsum('bhij,bhj->bhi', S, r_t)

    xs = tuple(jnp.moveaxis(t.astype(jnp.float32), 1, 0) for t in (r, decay, k, v, a, b))
    s_final, y = lax.scan(step, s0, xs, reverse=reverse)
    return jnp.moveaxis(y, 0, 1), s_final


def rwkv7_output(y, r, k, v, g, r_k, ln_w, ln_b):
    B, T = y.shape[0], y.shape[1]
    mean = jnp.mean(y, axis=-1, keepdims=True)
    var = jnp.mean(jnp.square(y - mean), axis=-1, keepdims=True)
    yn = ((y - mean) * lax.rsqrt(var + RWKV_LN_EPS)).reshape(B, T, GROUP_W).astype(v.dtype) * ln_w + ln_b
    bonus = (jnp.sum(r * k * r_k, axis=-1, keepdims=True) * v).reshape(B, T, GROUP_W)
    return (yn + bonus) * g


def rwkv7_mixer(z_lat, z_ctx, mu, w0, w_up, a0, a_up, g_up, k_k, k_a, r_k, ln_w, ln_b, need_ctx):
    B = z_lat.shape[0]
    rl, kl, vl, gl, dirs_l = rwkv7_prepare(z_lat, mu, w0, w_up, a0, a_up, g_up, k_k, k_a)
    rc, kc, vc, gc, dirs_c = rwkv7_prepare(z_ctx, mu, w0, w_up, a0, a_up, g_up, k_k, k_a)
    s0 = jnp.zeros((B, RWKV_HEADS, RWKV_N, RWKV_N), jnp.float32)
    ys_lat, ys_ctx = [], []
    for d in range(2):
        reverse = d == 1
        dec_c, kd_c, a_c, b_c = dirs_c[d]
        dec_l, kd_l, a_l, b_l = dirs_l[d]
        y_c, s_ctx = rwkv7_scan(rc, dec_c, kd_c, vc, a_c, b_c, s0, reverse)
        y_l, _ = rwkv7_scan(rl, dec_l, kd_l, vl, a_l, b_l, s_ctx, reverse)
        ys_lat.append(y_l)
        ys_ctx.append(y_c)
    y_lat = rwkv7_output(ys_lat[0] + ys_lat[1], rl, kl, vl, gl, r_k, ln_w, ln_b)
    y_ctx = rwkv7_output(ys_ctx[0] + ys_ctx[1], rc, kc, vc, gc, r_k, ln_w, ln_b) if need_ctx else None
    return y_lat, y_ctx


def diff_attention(q, k, v, lam, scale):
    s = jnp.einsum('bqhnd,bkhnd->bhnqk', q, k).astype(jnp.float32) * scale
    p = jax.nn.softmax(s, axis=-1)
    p = p[:, :, 0] - lam * p[:, :, 1]
    return jnp.einsum('bhqk,bkhd->bqhd', p.astype(v.dtype), v)


def diff_mixer(z_lat, z_ctx, cos, sin, lam_p, subln, lam_init, need_ctx):
    B = z_lat.shape[0]

    def split_heads(z):
        T = z.shape[1]
        q, k, v = jnp.split(z, 3, axis=-1)
        return (q.reshape(B, T, DIFF_HEADS, 2, DIFF_QK), k.reshape(B, T, DIFF_HEADS, 2, DIFF_QK),
                v.reshape(B, T, DIFF_HEADS, DIFF_V))

    ql, kl, vl = split_heads(z_lat)
    qc, kc, vc = split_heads(z_ctx)
    ql = apply_axial_rope(ql, cos, sin)
    kl = apply_axial_rope(kl, cos, sin)
    lp = lam_p.astype(jnp.float32)
    lam = jnp.exp(jnp.sum(lp[0] * lp[1])) - jnp.exp(jnp.sum(lp[2] * lp[3])) + lam_init
    scale = DIFF_QK ** -0.5
    k_all = jnp.concatenate([kl, kc], axis=1)
    v_all = jnp.concatenate([vl, vc], axis=1)
    o_lat = map_query_blocks(lambda qi: diff_attention(qi, k_all, v_all, lam, scale), ql)

    def finish(o):
        return (rmsnorm(o, subln, DIFF_LN_EPS) * (1.0 - lam_init)).reshape(B, o.shape[1], GROUP_W)

    y_ctx = finish(diff_attention(qc, kc, vc, lam, scale)) if need_ctx else None
    return finish(o_lat), y_ctx


def conv_glu(h, w_up, conv_w, conv_b, w_down):
    a, b = jnp.split(h @ w_up, 2, axis=-1)
    a = conv_w[0] * shift_prev(a) + conv_w[1] * a + conv_w[2] * shift_next(a) + conv_b
    return (jax.nn.silu(a) * b) @ w_down


def setup_inputs(seed: int = 0) -> dict:
    key = jax.random.key(seed)
    keys = jax.random.split(key, 40)
    L, D = DEPTH, D_MODEL

    def nrm(i, shape, scale):
        return jax.random.normal(keys[i], shape, jnp.float32) * scale

    return {
        'x': nrm(0, (BATCH, SEQ, D), 1.0),
        'c': nrm(1, (BATCH, D), 1.0),
        'ctx': nrm(2, (BATCH, CTX_LEN, D), 1.0),
        'c_ctx': nrm(3, (D,), 1.0),
        'norm1_g': 1.0 + nrm(4, (L, D), 0.05),
        'norm2_g': 1.0 + nrm(5, (L, D), 0.05),
        'ada_w': nrm(6, (L, D, 6 * D), 0.3 * D ** -0.5),
        'ada_b': nrm(7, (L, 6 * D), 0.02),
        'w_in': nrm(8, (L, D, IN_COLS), D ** -0.5),
        'w_out': nrm(9, (L, MIX_W, D), MIX_W ** -0.5),
        'na_rpb': nrm(10, (L, NA_HEADS, 2 * NA_KH - 1, 2 * NA_KW - 1), 0.5),
        'mla_q_norm': 1.0 + nrm(11, (L, MLA_Q_RANK), 0.05),
        'mla_kv_norm': 1.0 + nrm(12, (L, MLA_KV_RANK), 0.05),
        'mla_w_uq': nrm(13, (L, MLA_Q_RANK, MLA_HEADS * (MLA_NOPE + ROPE_DIM)), MLA_Q_RANK ** -0.5),
        'mla_w_ukv': nrm(14, (L, MLA_KV_RANK, MLA_HEADS * (MLA_NOPE + MLA_V)), MLA_KV_RANK ** -0.5),
        'rwkv_mu': jax.random.uniform(keys[15], (L, 2, RWKV_COLS), jnp.float32, 0.0, 0.5),
        'rwkv_w0': -2.0 + nrm(16, (L, 2, GROUP_W), 0.5),
        'rwkv_w_up': nrm(17, (L, 2, RWKV_W_RANK, GROUP_W), RWKV_W_RANK ** -0.5),
        'rwkv_a0': nrm(18, (L, 2, GROUP_W), 0.5),
        'rwkv_a_up': nrm(19, (L, 2, RWKV_A_RANK, GROUP_W), RWKV_A_RANK ** -0.5),
        'rwkv_g_up': nrm(20, (L, RWKV_G_RANK, GROUP_W), RWKV_G_RANK ** -0.5),
        'rwkv_k_k': 0.85 + nrm(21, (L, GROUP_W), 0.05),
        'rwkv_k_a': 1.0 + nrm(22, (L, GROUP_W), 0.05),
        'rwkv_r_k': nrm(23, (L, RWKV_HEADS, RWKV_N), 0.1),
        'rwkv_ln_w': 1.0 + nrm(24, (L, GROUP_W), 0.05),
        'rwkv_ln_b': nrm(25, (L, GROUP_W), 0.02),
        'diff_lambda': nrm(26, (L, 4, DIFF_QK), 0.1),
        'diff_subln': 1.0 + nrm(27, (L, DIFF_V), 0.05),
        'mlp_w_up': nrm(28, (L, D, 2 * D_FF), D ** -0.5),
        'mlp_conv_w': nrm(29, (L, 3, D_FF), 3 ** -0.5),
        'mlp_conv_b': nrm(30, (L, D_FF), 0.02),
        'mlp_w_down': nrm(31, (L, D_FF, D), D_FF ** -0.5),
        'final_norm_g': 1.0 + nrm(32, (D,), 0.05),
    }


def reference(x, c, ctx, c_ctx, norm1_g, norm2_g, ada_w, ada_b, w_in, w_out, na_rpb,
              mla_q_norm, mla_kv_norm, mla_w_uq, mla_w_ukv,
              rwkv_mu, rwkv_w0, rwkv_w_up, rwkv_a0, rwkv_a_up, rwkv_g_up, rwkv_k_k, rwkv_k_a,
              rwkv_r_k, rwkv_ln_w, rwkv_ln_b, diff_lambda, diff_subln,
              mlp_w_up, mlp_conv_w, mlp_conv_b, mlp_w_down, final_norm_g):
    n_lat = x.shape[1]
    cos, sin = axial_rope_tables(n_lat, x.dtype)
    s_lat = jax.nn.silu(c)
    s_ctx = jax.nn.silu(c_ctx)[None]
    xl, xc = x, ctx
    for l in range(DEPTH):
        need_ctx = l < DEPTH - 1
        sh1, sc1, g1, sh2, sc2, g2 = jnp.split((s_lat @ ada_w[l] + ada_b[l])[:, None, :], 6, axis=-1)
        csh1, csc1, cg1, csh2, csc2, cg2 = jnp.split((s_ctx @ ada_w[l] + ada_b[l])[:, None, :], 6, axis=-1)
        h_lat = rmsnorm(xl, norm1_g[l]) * (1.0 + sc1) + sh1
        h_ctx = rmsnorm(xc, norm1_g[l]) * (1.0 + csc1) + csh1
        z_lat = jnp.split(h_lat @ w_in[l], IN_SPLITS, axis=-1)
        z_ctx = jnp.split(h_ctx @ w_in[l], IN_SPLITS, axis=-1)
        na_l, na_c = na_mixer(z_lat[0], z_ctx[0], na_rpb[l], need_ctx)
        mla_l, mla_c = mla_mixer(z_lat[1], z_ctx[1], cos, sin, mla_q_norm[l], mla_kv_norm[l],
                                 mla_w_uq[l], mla_w_ukv[l], need_ctx)
        rk_l, rk_c = rwkv7_mixer(z_lat[2], z_ctx[2], rwkv_mu[l], rwkv_w0[l], rwkv_w_up[l], rwkv_a0[l],
                                 rwkv_a_up[l], rwkv_g_up[l], rwkv_k_k[l], rwkv_k_a[l], rwkv_r_k[l],
                                 rwkv_ln_w[l], rwkv_ln_b[l], need_ctx)
        lam_init = 0.8 - 0.6 * math.exp(-0.3 * l)
        df_l, df_c = diff_mixer(z_lat[3], z_ctx[3], cos, sin, diff_lambda[l], diff_subln[l], lam_init, need_ctx)
        xl = xl + g1 * (jnp.concatenate([na_l, mla_l, rk_l, df_l], axis=-1) @ w_out[l])
        h2 = rmsnorm(xl, norm2_g[l]) * (1.0 + sc2) + sh2
        xl = xl + g2 * conv_glu(h2, mlp_w_up[l], mlp_conv_w[l], mlp_conv_b[l], mlp_w_down[l])
        if need_ctx:
            xc = xc + cg1 * (jnp.concatenate([na_c, mla_c, rk_c, df_c], axis=-1) @ w_out[l])
            hc2 = rmsnorm(xc, norm2_g[l]) * (1.0 + csc2) + csh2
            xc = xc + cg2 * conv_glu(hc2, mlp_w_up[l], mlp_conv_w[l], mlp_conv_b[l], mlp_w_down[l])
    return rmsnorm(xl, final_norm_g)
```

```cpp
#include <hip/hip_runtime.h>
#include <hip/hip_cooperative_groups.h>
#include <cstdio>
#include <cstdint>
namespace cg = cooperative_groups;

#ifndef MK_ONE_LAUNCH
#define MK_ONE_LAUNCH 1
#endif

typedef unsigned short bf16_t;
typedef short bf16x8 __attribute__((ext_vector_type(8)));
typedef float f32x4 __attribute__((ext_vector_type(4)));
typedef unsigned u32x4 __attribute__((ext_vector_type(4)));
typedef unsigned u32x2 __attribute__((ext_vector_type(2)));
#define DEV __device__ __forceinline__
#define LAS __attribute__((address_space(3)))

constexpr int D = 1024, NBATCH = 32, SEQ = 2048, CTXL = 256, TT = 2304, T_ALL = NBATCH * TT, DEPTH = 4, DFF = 2816;
constexpr int NCHUNK = 2, CB = NBATCH / NCHUNK, TC = CB * TT;
constexpr int ZN = 2944, ZRW = 1408;
constexpr int NTHR = 256;
constexpr int LDS_BYTES = 73728;
constexpr int GP = 72;
constexpr int CP = 132;
#ifndef PROBE_MIXSEL
#define PROBE_MIXSEL 3
#endif
#ifndef MIXMASK
#define MIXMASK 31
#endif
#ifndef DMQ
#define DMQ 2
#endif

constexpr size_t al256(size_t x) { return (x + 255) & ~(size_t)255; }
constexpr size_t OFF_CTR = 0;
constexpr size_t OFF_LAM = 1024;
constexpr size_t OFF_XBAR = 4096;
constexpr size_t OFF_COS = 32768;
constexpr size_t OFF_SIN = OFF_COS + 2048 * 16 * 4;
constexpr size_t OFF_MOD = OFF_SIN + 2048 * 16 * 4;
constexpr size_t OFF_RSQ = al256(OFF_MOD + (size_t)DEPTH * 33 * 6144 * 4);
constexpr size_t OFF_RSKV = OFF_RSQ + (size_t)TC * 4;
constexpr size_t OFF_XC = al256(OFF_RSKV + (size_t)TC * 4);
constexpr size_t OFF_W = al256(OFF_XC + (size_t)NBATCH * CTXL * D * 4);
constexpr size_t WE_IN = 0;
constexpr size_t WE_OUT = WE_IN + (size_t)ZN * 1024;
constexpr size_t WE_UP = WE_OUT + (size_t)1024 * 1024;
constexpr size_t WE_DOWN = WE_UP + (size_t)5632 * 1024;
constexpr size_t WE_UQ = WE_DOWN + (size_t)1024 * 2816;
constexpr size_t WE_UKV = WE_UQ + (size_t)384 * 256;
constexpr size_t WE_WA = WE_UKV + (size_t)512 * 128;
constexpr size_t WE_G = WE_WA + (size_t)1024 * 64;
constexpr size_t WE_TOTAL = WE_G + (size_t)256 * 64;
constexpr size_t OFF_H = al256(OFF_W + (size_t)DEPTH * WE_TOTAL * 2);
constexpr size_t OFF_SCR = al256(OFF_H + (size_t)T_ALL * 1024 * 2);
constexpr size_t SO_QK = 0;
constexpr size_t SO_ZR = al256(SO_QK + (size_t)TC * 1024 * 2);
constexpr size_t VT_ELEMS = (size_t)CB * 4 * 64 * TT;
constexpr size_t SO_VTNA = al256(SO_ZR + (size_t)TC * ZRW * 2);
constexpr size_t SO_VTD = SO_VTNA + VT_ELEMS * 2;
constexpr size_t SO_VTM = SO_VTD + VT_ELEMS * 2;
constexpr size_t SO_MQ = SO_VTM + VT_ELEMS * 2;
constexpr size_t SO_KN = al256(SO_MQ + (size_t)TC * 384 * 2);
constexpr size_t SO_AWA = al256(SO_KN + (size_t)TC * 256 * 2);
constexpr size_t SO_AG = al256(SO_AWA + (size_t)TC * 64 * 2);
constexpr size_t SO_SC = al256(SO_AG + (size_t)T_ALL * 64 * 2);
constexpr size_t SO_Y = al256(SO_SC + (size_t)T_ALL * 2048 * 2);
constexpr size_t SO_END = al256(SO_Y + (size_t)2 * T_ALL * 256 * 4);
constexpr size_t SO_G = 0;
constexpr size_t SO_E = al256(SO_G + (size_t)T_ALL * DFF * 2);
constexpr size_t SO_END2 = al256(SO_E + (size_t)(T_ALL / 128) * 6 * DFF * 4);
constexpr size_t WS_NEED = OFF_SCR + (SO_END > SO_END2 ? SO_END : SO_END2);

struct Params { const float* in[33]; float* out; char* ws; };

DEV int tid_() { int t = __builtin_amdgcn_workitem_id_x(); asm volatile("" : "+v"(t)); return t; }
DEV float bf2f(bf16_t b) { return __uint_as_float(((unsigned)b) << 16); }
DEV bf16_t f2bf(float f) { unsigned u = __float_as_uint(f); u += 0x7fffu + ((u >> 16) & 1u); return (bf16_t)(u >> 16); }
typedef __bf16 bf16v2_t __attribute__((ext_vector_type(2)));
typedef float f32v2_t __attribute__((ext_vector_type(2)));
DEV unsigned pk2(float a, float b) { const f32v2_t f = {a, b}; return __builtin_bit_cast(unsigned, __builtin_convertvector(f, bf16v2_t)); }
DEV float lo_bf(unsigned u) { return __uint_as_float(u << 16); }
DEV float hi_bf(unsigned u) { return __uint_as_float(u & 0xffff0000u); }
DEV float wave_sum(float v) {
#pragma unroll
    for (int o = 32; o >= 1; o >>= 1) v += __shfl_xor(v, o);
    return v;
}
template <int CTRL> DEV float dppf(float v) { return __builtin_bit_cast(float, __builtin_amdgcn_update_dpp(0, __builtin_bit_cast(int, v), CTRL, 0xf, 0xf, true)); }
DEV float sum16(float v) { v += dppf<0xB1>(v); v += dppf<0x4E>(v); v += dppf<0x124>(v); v += dppf<0x128>(v); return v; }
DEV float max16(float v) { v = fmaxf(v, dppf<0xB1>(v)); v = fmaxf(v, dppf<0x4E>(v)); v = fmaxf(v, dppf<0x124>(v)); v = fmaxf(v, dppf<0x128>(v)); return v; }
DEV float sum32(float v) { v = sum16(v); v += __shfl_xor(v, 16); return v; }
DEV float sigmoidf_(float x) { return __builtin_amdgcn_rcpf(1.f + __expf(-x)); }
DEV float siluf_(float x) { return x * __builtin_amdgcn_rcpf(1.f + __expf(-x)); }

DEV float* xrow(const Params& p, int g) {
    const int b = g / TT, tt = g - b * TT;
    return tt < SEQ ? p.out + ((size_t)b * SEQ + tt) * D : (float*)(p.ws + OFF_XC) + ((size_t)b * CTXL + (tt - SEQ)) * D;
}
DEV const float* xrow_in(const Params& p, int g) {
    const int b = g / TT, tt = g - b * TT;
    return tt < SEQ ? p.in[0] + ((size_t)b * SEQ + tt) * D : p.in[2] + ((size_t)b * CTXL + (tt - SEQ)) * D;
}
DEV const bf16_t* wl(const Params& p, int l, size_t we) { return (const bf16_t*)(p.ws + OFF_W) + (size_t)l * WE_TOTAL + we; }
DEV bf16_t* wlw(const Params& p, int l, size_t we) { return (bf16_t*)(p.ws + OFF_W) + (size_t)l * WE_TOTAL + we; }

template <class Epi>
DEV void gemm_tile(const bf16_t* __restrict__ A, int lda, const bf16_t* __restrict__ Bt, int ldb, int K, int tm, int tn, char* smem, const Epi& epi) {
    const int tid = tid_(), lane = tid & 63, wid = tid >> 6, wr = wid >> 1, wc = wid & 1, fr = lane & 15, fq = lane >> 4;
    bf16_t* As = (bf16_t*)smem;
    bf16_t* Bs = As + 2 * 128 * 64;
    const int lrow = tid >> 3, lcc = (tid & 7) * 8, lsw = (((tid & 7) ^ (lrow & 7)) * 8);
    const bf16_t* Ag = A + (size_t)(tm * 128 + lrow) * lda + lcc;
    const bf16_t* Bg = Bt + (size_t)(tn * 128 + lrow) * ldb + lcc;
    f32x4 acc[4][4];
#pragma unroll
    for (int m = 0; m < 4; ++m)
#pragma unroll
        for (int n = 0; n < 4; ++n) acc[m][n] = (f32x4){0.f, 0.f, 0.f, 0.f};
    const int gsw = (((tid & 7) ^ (lrow & 7)) * 8);
    const bf16_t* Ad = A + (size_t)(tm * 128 + lrow) * lda + gsw;
    const bf16_t* Bd = Bt + (size_t)(tn * 128 + lrow) * ldb + gsw;
    char* Asb = (char*)As; char* Bsb = (char*)Bs;
#define G_DMA(buf_, kt_) do { const int ko_ = (kt_) * 64; \
        _Pragma("unroll") for (int i = 0; i < 4; ++i) { \
            __builtin_amdgcn_global_load_lds((const unsigned*)(Ad + (size_t)(32 * i) * lda + ko_), (LAS unsigned*)(Asb + (buf_) * 16384 + i * 4096 + tid * 16), 16, 0, 0); \
            __builtin_amdgcn_global_load_lds((const unsigned*)(Bd + (size_t)(32 * i) * ldb + ko_), (LAS unsigned*)(Bsb + (buf_) * 16384 + i * 4096 + tid * 16), 16, 0, 0); } } while (0)
#define G_FRAGS(cur_, ks_) const bf16_t* Ac##ks_ = As + (cur_) * 128 * 64 + (wr * 64 + fr) * 64 + ((((ks_) * 4 + fq) ^ (fr & 7)) * 8); const bf16_t* Bc##ks_ = Bs + (cur_) * 128 * 64 + (wc * 64 + fr) * 64 + ((((ks_) * 4 + fq) ^ (fr & 7)) * 8); \
        bf16x8 af##ks_[4], bfv##ks_[4]; \
        _Pragma("unroll") for (int m = 0; m < 4; ++m) af##ks_[m] = *(const bf16x8*)(Ac##ks_ + m * 16 * 64); \
        _Pragma("unroll") for (int n = 0; n < 4; ++n) bfv##ks_[n] = *(const bf16x8*)(Bc##ks_ + n * 16 * 64);
#define G_MMA(ks_) __builtin_amdgcn_s_setprio(3); _Pragma("unroll") for (int m = 0; m < 4; ++m) \
        _Pragma("unroll") for (int n = 0; n < 4; ++n) acc[m][n] = __builtin_amdgcn_mfma_f32_16x16x32_bf16(bfv##ks_[n], af##ks_[m], acc[m][n], 0, 0, 0); if (hi_half) __builtin_amdgcn_s_setprio(1); else __builtin_amdgcn_s_setprio(0);
    const int nk = K >> 6;
    const bool hi_half = blockIdx.x >= (gridDim.x >> 1);
    G_DMA(0, 0);
    asm volatile("s_waitcnt vmcnt(0)" ::: "memory");
    __syncthreads();
    for (int kt = 0; kt < nk; ++kt) {
        const int cur = kt & 1;
        if (kt + 1 < nk) G_DMA(cur ^ 1, kt + 1);
        {
            G_FRAGS(cur, 0)
            G_MMA(0)
            G_FRAGS(cur, 1)
            G_MMA(1)
        }
        asm volatile("s_waitcnt vmcnt(0)" ::: "memory");
        __syncthreads();
    }
    __builtin_amdgcn_s_setprio(0);
#undef G_DMA
#undef G_FRAGS
#undef G_MMA
    float* Ct = (float*)smem;
#pragma unroll
    for (int m = 0; m < 4; ++m)
#pragma unroll
        for (int n = 0; n < 4; ++n) *(f32x4*)(Ct + (wr * 64 + m * 16 + fr) * CP + wc * 64 + n * 16 + fq * 4) = acc[m][n];
    __syncthreads();
    epi(tm, tn, Ct);
    __syncthreads();
}

DEV f32x4 rope4(const float* Crow, int c, int o, const float* cosT, const float* sinT, int tt, f32x4 v) {
    const int sub = o >> 3, ti = (sub >> 1) * 8 + (o & 7);
    const f32x4 cs = *(const f32x4*)(cosT + tt * 16 + ti), sn = *(const f32x4*)(sinT + tt * 16 + ti);
    const f32x4 pv = *(const f32x4*)(Crow + ((sub & 1) ? c - 8 : c + 8));
    return (sub & 1) ? v * cs + pv * sn : v * cs - pv * sn;
}

DEV void store_vt(const float* Ct, int c0, bf16_t* vt_head  , int tt0, const float* rowscale) {
    for (int item = tid_(); item < 64 * 16; item += NTHR) {
        const int d = item & 63, rg = item >> 6;
        float v[8];
#pragma unroll
        for (int i = 0; i < 8; ++i) { v[i] = Ct[(rg * 8 + i) * CP + c0 + d]; if (rowscale) v[i] *= rowscale[rg * 8 + i]; }
        u32x4 w; w.x = pk2(v[0], v[1]); w.y = pk2(v[2], v[3]); w.z = pk2(v[4], v[5]); w.w = pk2(v[6], v[7]);
        *(u32x4*)(vt_head + (size_t)d * TT + tt0 + rg * 8) = w;
    }
}

DEV f32x4 rope4v(f32x4 v, f32x4 pv, f32x4 cs, f32x4 sn, int sub) { return (sub & 1) ? v * cs + pv * sn : v * cs - pv * sn; }

struct EpiIn {
    bf16_t* QK; bf16_t* ZR; bf16_t* VtNA; bf16_t* VtD; const float* cosT; const float* sinT;
    DEV void operator()(int tm, int tn, const float* Ct) const {
        const int row0 = tm * 128, bl = row0 / TT, tt0 = row0 - bl * TT; const bool lat = tt0 < SEQ;
        if (tn == 4 || tn == 5 || tn == 10 || tn == 11) {
            bf16_t* Vt = (tn < 6) ? VtNA : VtD; const int hp = (tn & 1) * 2;
            store_vt(Ct, 0, Vt + ((size_t)(bl * 4 + hp) * 64) * TT, tt0, nullptr);
            store_vt(Ct, 64, Vt + ((size_t)(bl * 4 + hp + 1) * 64) * TT, tt0, nullptr);
            return;
        }
        bf16_t* dst; int ds, dc; unsigned ropem = 0;
        if (tn < 4) { dst = QK; ds = 1024; dc = tn * 128; }
        else if (tn < 10) { dst = QK; ds = 1024; dc = 512 + (tn - 6) * 128; ropem = 0xf; }
        else { dst = ZR; ds = ZRW; dc = (tn - 12) * 128; if (tn == 21) ropem = 1; }
        if (!lat) ropem = 0;
        const int tid = tid_(), c = (tid & 31) << 2, rb = tid >> 5;
        const bool rp = (ropem >> (c >> 5)) & 1;
        const int o = c & 31, sub = o >> 3, ti = (sub >> 1) * 8 + (o & 7), pc = (sub & 1) ? c - 8 : c + 8;
        bf16_t* dp = dst + (size_t)row0 * ds + dc + c;
#pragma unroll
        for (int it0 = 0; it0 < 16; it0 += 4) {
            f32x4 cs[4], sn[4];
            if (rp) {
#pragma unroll
                for (int u = 0; u < 4; ++u) { const int r = rb + 8 * (it0 + u); cs[u] = *(const f32x4*)(cosT + (tt0 + r) * 16 + ti); sn[u] = *(const f32x4*)(sinT + (tt0 + r) * 16 + ti); }
            }
#pragma unroll
            for (int u = 0; u < 4; ++u) {
                const int r = rb + 8 * (it0 + u);
                f32x4 v = *(const f32x4*)(Ct + r * CP + c);
                if (rp) v = rope4v(v, *(const f32x4*)(Ct + r * CP + pc), cs[u], sn[u], sub);
                u32x2 w; w.x = pk2(v[0], v[1]); w.y = pk2(v[2], v[3]);
                *(u32x2*)(dp + (size_t)r * ds) = w;
            }
        }
    }
};
struct EpiUQ {
    bf16_t* MQ; const float* rs; const float* cosT; const float* sinT;
    DEV void operator()(int tm, int tn, const float* Ct) const {
        const int row0 = tm * 128, bl = row0 / TT, tt0 = row0 - bl * TT; const bool lat = tt0 < SEQ;
        const int tid = tid_(), c = (tid & 31) << 2, rb = tid >> 5, col = tn * 128 + c, hc = col % 96;
        const bool rp = lat && hc >= 64;
        const int o = rp ? hc - 64 : 0, sub = o >> 3, ti = (sub >> 1) * 8 + (o & 7), pc = (sub & 1) ? c - 8 : c + 8;
#pragma unroll
        for (int it0 = 0; it0 < 16; it0 += 4) {
            f32x4 cs[4], sn[4]; float sc[4];
#pragma unroll
            for (int u = 0; u < 4; ++u) { const int r = rb + 8 * (it0 + u); sc[u] = rs[row0 + r]; if (rp) { cs[u] = *(const f32x4*)(cosT + (tt0 + r) * 16 + ti); sn[u] = *(const f32x4*)(sinT + (tt0 + r) * 16 + ti); } }
#pragma unroll
            for (int u = 0; u < 4; ++u) {
                const int r = rb + 8 * (it0 + u);
                f32x4 v = *(const f32x4*)(Ct + r * CP + c);
                if (rp) v = rope4v(v, *(const f32x4*)(Ct + r * CP + pc), cs[u], sn[u], sub);
                v = v * sc[u];
                u32x2 w; w.x = pk2(v[0], v[1]); w.y = pk2(v[2], v[3]);
                *(u32x2*)(MQ + (size_t)(row0 + r) * 384 + col) = w;
            }
        }
    }
};
struct EpiUKV {
    bf16_t* KN; bf16_t* VtM; const float* rs;
    DEV void operator()(int tm, int tn, const float* Ct) const {
        const int row0 = tm * 128, bl = row0 / TT, tt0 = row0 - bl * TT;
        const int tid = tid_(), c = (tid & 15) << 2, rb = tid >> 4;
        float* rsl = (float*)((char*)Ct + 128 * CP * 4);
        if (tid < 128) rsl[tid] = rs[row0 + tid];
        __syncthreads();
#pragma unroll
        for (int it = 0; it < 8; ++it) {
            const int r = rb + 16 * it;
            const f32x4 v = *(const f32x4*)(Ct + r * CP + c) * rsl[r];
            u32x2 w; w.x = pk2(v[0], v[1]); w.y = pk2(v[2], v[3]);
            *(u32x2*)(KN + (size_t)(row0 + r) * 256 + tn * 64 + c) = w;
        }
        store_vt(Ct, 64, VtM + ((size_t)(bl * 4 + tn) * 64) * TT, tt0, rsl);
    }
};
struct EpiWA {
    bf16_t* SC; const float* w0; const float* a0;
    DEV void operator()(int tm, int tn, const float* Ct) const {
        const int row0 = tm * 128, seg = tn >> 1;
        const int tid = tid_(), c = (tid & 31) << 2, rb = tid >> 5, ch = (tn & 1) * 128 + c, h = ch >> 6, j = ch & 63;
        const f32x4 bias = seg < 2 ? *(const f32x4*)(w0 + seg * 256 + ch) : *(const f32x4*)(a0 + (seg - 2) * 256 + ch);
        bf16_t* dp = SC + (size_t)row0 * 2048 + h * 512 + (4 + seg) * 64 + j;
#pragma unroll 4
        for (int it = 0; it < 16; ++it) {
            const int r = rb + 8 * it;
            const f32x4 v = *(const f32x4*)(Ct + r * CP + c) + bias;
            float o[4];
#pragma unroll
            for (int i = 0; i < 4; ++i) {
                if (seg < 2) o[i] = 0.60653065971f * sigmoidf_(v[i]);
                else o[i] = sigmoidf_(v[i]);
            }
            u32x2 w; w.x = pk2(o[0], o[1]); w.y = pk2(o[2], o[3]);
            *(u32x2*)(dp + (size_t)r * 2048) = w;
        }
    }
};
struct EpiG {
    bf16_t* MIX; const bf16_t* SC; const float* Y; const float* r_k; const float* ln_w; const float* ln_b; int gbase;
    DEV void operator()(int tm, int tn, const float* Ct) const {
        const int row0 = tm * 128;
        const int tid = tid_(), l32 = tid & 31, hh = (tid >> 5) & 1, rb = tid >> 6, h = tn * 2 + hh, j = l32 * 2, ch = h * 64 + j;
        const float rk0 = r_k[ch], rk1 = r_k[ch + 1], lw0 = ln_w[ch], lw1 = ln_w[ch + 1], lb0 = ln_b[ch], lb1 = ln_b[ch + 1];
#pragma unroll
        for (int it0 = 0; it0 < 32; it0 += 4) {
            f32v2_t yf[4], yb[4]; unsigned ur[4], uv[4], uk[4];
#pragma unroll
            for (int u = 0; u < 4; ++u) {
                const size_t row = (size_t)(row0 + rb + 4 * (it0 + u));
                yf[u] = *(const f32v2_t*)(Y + row * 256 + ch); yb[u] = *(const f32v2_t*)(Y + ((size_t)T_ALL + row) * 256 + ch);
                const bf16_t* sc = SC + row * 2048 + h * 512 + j;
                ur[u] = *(const unsigned*)(sc); uv[u] = *(const unsigned*)(sc + 64); uk[u] = *(const unsigned*)(sc + 128);
            }
#pragma unroll
            for (int u = 0; u < 4; ++u) {
                const int r = rb + 4 * (it0 + u);
                const float y0 = yf[u][0] + yb[u][0], y1 = yf[u][1] + yb[u][1];
                const float mean = sum32(y0 + y1) * (1.f / 64.f);
                const float d0 = y0 - mean, d1 = y1 - mean;
                const float var = sum32(d0 * d0 + d1 * d1) * (1.f / 64.f);
                const float rstd = rsqrtf(var + 64e-5f);
                const float rk = sum32(lo_bf(ur[u]) * lo_bf(uk[u]) * rk0 + hi_bf(ur[u]) * hi_bf(uk[u]) * rk1);
                const float g0 = Ct[r * CP + hh * 64 + j], g1 = Ct[r * CP + hh * 64 + j + 1];
                const float o0 = (d0 * rstd * lw0 + lb0 + rk * lo_bf(uv[u])) * g0;
                const float o1 = (d1 * rstd * lw1 + lb1 + rk * hi_bf(uv[u])) * g1;
                *(unsigned*)(MIX + (size_t)(row0 + r) * 1024 + 512 + ch) = pk2(o0, o1);
            }
        }
    }
};
struct EpiRes {
    const Params* p; const float* mod; int goff; int from_in;
    DEV void operator()(int tm, int tn, const float* Ct) const {
        const int row0 = tm * 128, b = row0 / TT, tt0 = row0 - b * TT;
        const int tid = tid_(), c = (tid & 31) << 2, rb = tid >> 5;
        const f32x4 g = *(const f32x4*)(mod + (size_t)(tt0 < SEQ ? b : 32) * 6144 + goff + tn * 128 + c);
        float* x0 = xrow(*p, row0) + tn * 128 + c;
        const float* xs = from_in ? xrow_in(*p, row0) + tn * 128 + c : x0;
#pragma unroll
        for (int it0 = 0; it0 < 16; it0 += 8) {
            f32x4 xv[8];
#pragma unroll
            for (int u = 0; u < 8; ++u) xv[u] = *(const f32x4*)(xs + (size_t)(rb + 8 * (it0 + u)) * D);
#pragma unroll
            for (int u = 0; u < 8; ++u) { const int r = rb + 8 * (it0 + u); *(f32x4*)(x0 + (size_t)r * D) = xv[u] + g * *(const f32x4*)(Ct + r * CP + c); }
        }
    }
};
struct EpiUp {
    bf16_t* G; float* E; const float* cw; const float* cb;
    DEV void operator()(int tm, int tn, const float* Ct) const {
        const int row0 = tm * 128, tt0 = row0 % TT;
        const bool first = (tt0 == 0 || tt0 == SEQ), last = (tt0 + 127 == SEQ - 1 || tt0 + 127 == TT - 1);
        const int tid = tid_(), c = (tid & 15) << 2, rb = tid >> 4, j = tn * 64 + c;
        const f32x4 w0 = *(const f32x4*)(cw + j), w1 = *(const f32x4*)(cw + DFF + j), w2 = *(const f32x4*)(cw + 2 * DFF + j), bb = *(const f32x4*)(cb + j);
        const f32x4 z = (f32x4){0.f, 0.f, 0.f, 0.f};
#pragma unroll 2
        for (int it = 0; it < 8; ++it) {
            const int r = rb + 16 * it;
            const f32x4 ac = *(const f32x4*)(Ct + r * CP + c);
            const f32x4 ap = r > 0 ? *(const f32x4*)(Ct + (r - 1) * CP + c) : z;
            const f32x4 an = r < 127 ? *(const f32x4*)(Ct + (r + 1) * CP + c) : z;
            const f32x4 bv = *(const f32x4*)(Ct + r * CP + 64 + c);
            const f32x4 pre = w0 * ap + w1 * ac + w2 * an + bb;
            if ((r == 0 && !first) || (r == 127 && !last)) {
                float* e = E + ((size_t)tm * 6 + (r == 0 ? 0 : 3)) * DFF + j;
                *(f32x4*)(e) = pre; *(f32x4*)(e + DFF) = bv; *(f32x4*)(e + 2 * DFF) = ac;
            } else {
                u32x2 w; w.x = pk2(siluf_(pre[0]) * bv[0], siluf_(pre[1]) * bv[1]); w.y = pk2(siluf_(pre[2]) * bv[2], siluf_(pre[3]) * bv[3]);
                *(u32x2*)(G + (size_t)(row0 + r) * DFF + j) = w;
            }
        }
    }
};

template <class Epi>
DEV void gemm_phase(const bf16_t* A, int lda, const bf16_t* Bt, int ldb, int K, int ntm, int ntn, bool skip_ctx, char* smem, const Epi& epi) {
    if ((gridDim.x & 7) == 0 && (ntm & 7) == 0) {
        const int xcd = blockIdx.x & 7, slot = blockIdx.x >> 3, nper = gridDim.x >> 3, R = ntm >> 3, per = R * ntn;
        const int nfb = ntn >> 3, fullq = nfb * R * 8, w = ntn - nfb * 8;
        for (int q = slot; q < per; q += nper) {
            int tm, tn;
            if (q < fullq) { const int tb = q / (R * 8), r = q - tb * (R * 8); tm = r >> 3; tn = tb * 8 + (r & 7); }
            else { const int q2 = q - fullq; tm = q2 / w; tn = nfb * 8 + (q2 - tm * w); }
            tm += xcd * R;
            if (skip_ctx && ((tm * 128) % TT) >= SEQ) continue;
            gemm_tile(A, lda, Bt, ldb, K, tm, tn, smem, epi);
        }
        return;
    }
    const int total = ntm * ntn;
    for (int t = blockIdx.x; t < total; t += gridDim.x) {
        const int tm = t / ntn, tn = t - tm * ntn;
        if (skip_ctx && ((tm * 128) % TT) >= SEQ) continue;
        gemm_tile(A, lda, Bt, ldb, K, tm, tn, smem, epi);
    }
}

struct AttnArgs {
    const bf16_t* Q; int qs;
    const bf16_t* K; int ks;
    const bf16_t* K2; int k2s;
    const bf16_t* Vt;
    bf16_t* O; int os;
    int nkt; int kstart;
    float sc2;
    int na_r, na_rs; const float* rpb;
    float lam, oscale; const float* subln;
};

DEV unsigned cvt_pk_bf16(float lo, float hi) { return pk2(lo, hi); }
DEV float red_rows_sum(float p) {
    float a = p, b = p;
    asm volatile("s_nop 1\n\tv_permlane16_swap_b32 %0, %1" : "+v"(a), "+v"(b));
    const float q = a + b; a = q; b = q;
    asm volatile("s_nop 1\n\tv_permlane32_swap_b32 %0, %1" : "+v"(a), "+v"(b));
    return a + b;
}
DEV float vmax2(float a, float b) { float r; asm("v_max_f32 %0, %1, %2" : "=v"(r) : "v"(a), "v"(b)); return r; }
DEV float vmax3(float a, float b, float c) { float r; asm("v_max3_f32 %0, %1, %2, %3" : "=v"(r) : "v"(a), "v"(b), "v"(c)); return r; }
DEV float wave_sum_fast(float v) { return red_rows_sum(sum16(v)); }
DEV float red_rows_max(float p) {
    float a = p, b = p;
    asm volatile("s_nop 1\n\tv_permlane16_swap_b32 %0, %1" : "+v"(a), "+v"(b));
    const float q = fmaxf(a, b); a = q; b = q;
    asm volatile("s_nop 1\n\tv_permlane32_swap_b32 %0, %1" : "+v"(a), "+v"(b));
    return fmaxf(a, b);
}
template <int DQK, int NSUB, int MQ, bool NA>
DEV void attn_item(const AttnArgs& a, char* smem) {
    constexpr int KP = DQK + 8, KS = DQK / 32 / NSUB, KCH = DQK / 8, QR = 16 * MQ;
    const int tid = tid_(), lane = tid & 63, wid = tid >> 6, fr = lane & 15, fq = lane >> 4;
    bf16_t* Ksm = (bf16_t*)smem;
    bf16_t* Vsm = Ksm + 2 * 64 * KP;
    float* rpbs = (float*)(Vsm + 2 * 64 * GP);
    if (NA) { for (int i = tid; i < 465; i += NTHR) rpbs[i] = a.rpb[i] * 1.44269504f; }
    const int na_nlo = NA ? (max(16 * wid - 8, 0) >> 4) : 0, na_nhi = NA ? (min(16 * wid + 22, 63) >> 4) : 3;
    bf16x8 qf[MQ][DQK / 32];
#pragma unroll
    for (int mq = 0; mq < MQ; ++mq)
#pragma unroll
        for (int k = 0; k < DQK / 32; ++k) qf[mq][k] = *(const bf16x8*)(a.Q + (size_t)(wid * QR + mq * 16 + fr) * a.qs + k * 32 + fq * 8);
    f32x4 o[NSUB][MQ][4];
    float mrow[NSUB][MQ], lrow[NSUB][MQ];
#pragma unroll
    for (int sb = 0; sb < NSUB; ++sb)
#pragma unroll
        for (int mq = 0; mq < MQ; ++mq) {
            mrow[sb][mq] = -1e30f; lrow[sb][mq] = 0.f;
#pragma unroll
            for (int n = 0; n < 4; ++n) o[sb][mq][n] = (f32x4){0.f, 0.f, 0.f, 0.f};
        }
    constexpr int NKC = (64 * KCH + NTHR - 1) / NTHR;
    u32x4 rk[NKC], rv[2];
#define ATT_TSTART(kt) (NA ? ((kt) < 8 ? (a.na_rs + (kt)) * 64 : SEQ + ((kt) - 8) * 64) : a.kstart + (kt) * 64)
#define ATT_GLOAD(kt) do { const int _t0 = ATT_TSTART(kt); \
        _Pragma("unroll") for (int _i = 0; _i < NKC; ++_i) { const int _q = tid + _i * NTHR; if (_q < 64 * KCH) { const int _r = _q / KCH, _c = _q - _r * KCH; \
            rk[_i] = (_c < 8 || DQK == 64) ? *(const u32x4*)(a.K + (size_t)(_t0 + _r) * a.ks + _c * 8) : *(const u32x4*)(a.K2 + (size_t)(_t0 + _r) * a.k2s + (_c - 8) * 8); } } \
        _Pragma("unroll") for (int _i = 0; _i < 2; ++_i) { const int _q = tid + _i * NTHR, _r = _q >> 3, _c = _q & 7; rv[_i] = *(const u32x4*)(a.Vt + (size_t)_r * TT + _t0 + _c * 8); } } while (0)
#define ATT_LSTORE(buf) do { \
        _Pragma("unroll") for (int _i = 0; _i < NKC; ++_i) { const int _q = tid + _i * NTHR; if (_q < 64 * KCH) { const int _r = _q / KCH, _c = _q - _r * KCH; *(u32x4*)(Ksm + ((buf) * 64 + _r) * KP + _c * 8) = rk[_i]; } } \
        _Pragma("unroll") for (int _i = 0; _i < 2; ++_i) { const int _q = tid + _i * NTHR, _r = _q >> 3, _c = _q & 7; *(u32x4*)(Vsm + ((buf) * 64 + _r) * GP + _c * 8) = rv[_i]; } } while (0)
    ATT_GLOAD(0); ATT_LSTORE(0);
    __syncthreads();
    for (int kt = 0; kt < a.nkt; ++kt) {
        const int cur = kt & 1; const bool more = kt + 1 < a.nkt;
        if (more) ATT_GLOAD(kt + 1);
        const bool natile = NA && kt < 8;
        bf16x8 pb[NSUB][MQ][2];
#pragma unroll
        for (int sb = 0; sb < NSUB; ++sb) {
            f32x4 s[MQ][4];
#pragma unroll
            for (int k = 0; k < KS; ++k) {
                bf16x8 kb[4];
#pragma unroll
                for (int n = 0; n < 4; ++n) kb[n] = *(const bf16x8*)(Ksm + (cur * 64 + n * 16 + fr) * KP + (sb * KS + k) * 32 + fq * 8);
#pragma unroll
                for (int mq = 0; mq < MQ; ++mq)
#pragma unroll
                    for (int n = 0; n < 4; ++n) {
                        if (!natile || (n >= na_nlo && n <= na_nhi)) s[mq][n] = __builtin_amdgcn_mfma_f32_16x16x32_bf16(kb[n], qf[mq][sb * KS + k], k == 0 ? (f32x4){0.f, 0.f, 0.f, 0.f} : s[mq][n], 0, 0, 0);
                        else if (k == 0) s[mq][n] = (f32x4){0.f, 0.f, 0.f, 0.f};
                    }
            }
#pragma unroll
            for (int mq = 0; mq < MQ; ++mq) {
                float mx = -1e30f;
                if (natile) {
                    const int qc = wid * 16 + fr, cst = min(max(qc - 8, 0), 48), ro = a.na_rs + kt - a.na_r + 7;
                    const float* rrow = rpbs + ro * 31 + 15 - qc + fq * 4;
#pragma unroll
                    for (int n = 0; n < 4; ++n) {
                        if (n >= na_nlo && n <= na_nhi) {
#pragma unroll
                            for (int j = 0; j < 4; ++j) {
                                const int kc = n * 16 + fq * 4 + j;
                                const float x = (kc >= cst && kc < cst + 16) ? s[mq][n][j] * a.sc2 + rrow[n * 16 + j] : -1e30f;
                                s[mq][n][j] = x; mx = fmaxf(mx, x);
                            }
                        } else s[mq][n] = (f32x4){-1e30f, -1e30f, -1e30f, -1e30f};
                    }
                } else {
#pragma unroll
                    for (int n = 0; n < 4; ++n) { s[mq][n] = s[mq][n] * a.sc2; mx = fmaxf(fmaxf(mx, fmaxf(s[mq][n][0], s[mq][n][1])), fmaxf(s[mq][n][2], s[mq][n][3])); }
                }
                mx = red_rows_max(mx);
                const float mo = mrow[sb][mq], mn = fmaxf(mo, mx);
                const bool grow = __builtin_amdgcn_ballot_w64(mn > mo) != 0;
                mrow[sb][mq] = mn;
                float rsum = 0.f;
#pragma unroll
                for (int n = 0; n < 4; ++n) {
                    if (!natile || (n >= na_nlo && n <= na_nhi)) {
#pragma unroll
                        for (int j = 0; j < 4; ++j) { const float pv = __builtin_amdgcn_exp2f(s[mq][n][j] - mn); s[mq][n][j] = pv; rsum += pv; }
                    } else s[mq][n] = (f32x4){0.f, 0.f, 0.f, 0.f};
                }
                if (grow) {
                    const float alpha = __builtin_amdgcn_exp2f(mo - mn);
                    lrow[sb][mq] *= alpha;
#pragma unroll
                    for (int n = 0; n < 4; ++n) o[sb][mq][n] *= alpha;
                }
                lrow[sb][mq] += rsum;
#pragma unroll
                for (int k2 = 0; k2 < 2; ++k2) {
                    u32x4 w;
                    w.x = cvt_pk_bf16(s[mq][2 * k2][0], s[mq][2 * k2][1]); w.y = cvt_pk_bf16(s[mq][2 * k2][2], s[mq][2 * k2][3]);
                    w.z = cvt_pk_bf16(s[mq][2 * k2 + 1][0], s[mq][2 * k2 + 1][1]); w.w = cvt_pk_bf16(s[mq][2 * k2 + 1][2], s[mq][2 * k2 + 1][3]);
                    pb[sb][mq][k2] = __builtin_bit_cast(bf16x8, w);
                }
            }
        }
#pragma unroll
        for (int k2 = 0; k2 < 2; ++k2) {
            if (natile && (2 * k2 + 1 < na_nlo || 2 * k2 > na_nhi)) continue;
            bf16x8 va[4];
#pragma unroll
            for (int n = 0; n < 4; ++n) {
                const bf16_t* vp = Vsm + (cur * 64 + n * 16 + fr) * GP + 32 * k2 + fq * 4;
                u32x4 w; const u32x2 lo = *(const u32x2*)(vp), hi = *(const u32x2*)(vp + 16);
                w.x = lo.x; w.y = lo.y; w.z = hi.x; w.w = hi.y;
                va[n] = __builtin_bit_cast(bf16x8, w);
            }
#pragma unroll
            for (int sb = 0; sb < NSUB; ++sb)
#pragma unroll
                for (int mq = 0; mq < MQ; ++mq)
#pragma unroll
                    for (int n = 0; n < 4; ++n) o[sb][mq][n] = __builtin_amdgcn_mfma_f32_16x16x32_bf16(va[n], pb[sb][mq][k2], o[sb][mq][n], 0, 0, 0);
        }
        if (more) ATT_LSTORE(cur ^ 1);
        __syncthreads();
    }
#undef ATT_GLOAD
#undef ATT_LSTORE
#undef ATT_TSTART
#pragma unroll
    for (int mq = 0; mq < MQ; ++mq) {
        f32x4 v[4];
        if (NSUB == 1) {
            const float il = 1.f / red_rows_sum(lrow[0][mq]);
#pragma unroll
            for (int n = 0; n < 4; ++n) v[n] = o[0][mq][n] * il;
        } else {
            const float il0 = 1.f / red_rows_sum(lrow[0][mq]), il1 = a.lam / red_rows_sum(lrow[NSUB - 1][mq]);
            float ss = 0.f;
#pragma unroll
            for (int n = 0; n < 4; ++n) { v[n] = o[0][mq][n] * il0 - o[NSUB - 1][mq][n] * il1; ss += v[n][0] * v[n][0] + v[n][1] * v[n][1] + v[n][2] * v[n][2] + v[n][3] * v[n][3]; }
            ss = red_rows_sum(ss);
            const float rstd = rsqrtf(ss * (1.f / 64.f) + 1e-5f) * a.oscale;
#pragma unroll
            for (int n = 0; n < 4; ++n) v[n] = v[n] * rstd * *(const f32x4*)(a.subln + n * 16 + fq * 4);
        }
        bf16_t* op = a.O + (size_t)(wid * QR + mq * 16 + fr) * a.os + fq * 4;
#pragma unroll
        for (int n = 0; n < 4; ++n) { u32x2 w; w.x = cvt_pk_bf16(v[n][0], v[n][1]); w.y = cvt_pk_bf16(v[n][2], v[n][3]); *(u32x2*)(op + n * 16) = w; }
    }
    __syncthreads();
}

template <int N> DEV float rbc(float x) { return __builtin_bit_cast(float, __builtin_amdgcn_update_dpp(0, __builtin_bit_cast(int, x), 0x150 + N, 0xf, 0xf, true)); }
DEV float red_rows(float p) { return red_rows_sum(p); }
#define REP16(M) M(0) M(1) M(2) M(3) M(4) M(5) M(6) M(7) M(8) M(9) M(10) M(11) M(12) M(13) M(14) M(15)
DEV void scan_item(const bf16_t* SC, float* Y, int bl, int h, int dir, const float* k_a, char* smem) {
    const int tid = tid_(), lane = tid & 63, w = tid >> 6, ch = lane, sq = w;
    float* stg = (float*)smem;
    float* yb = stg + 2 * 16 * 6 * 64;
    const float ka = k_a[h * 64 + ch];
    unsigned short pre[4][6];
    float S[16];
#pragma unroll
    for (int j = 0; j < 16; ++j) S[j] = 0.f;
#define SC_TT(s) (dir == 0 ? ((s) < CTXL ? SEQ + (s) : (s) - CTXL) : ((s) < CTXL ? TT - 1 - (s) : SEQ - 1 - ((s) - CTXL)))
#define SC_GL(chunk) do { _Pragma("unroll") for (int _i = 0; _i < 4; ++_i) { const int _s = (chunk) * 16 + sq + 4 * _i; const int _tt = SC_TT(_s); \
        const bf16_t* _b = SC + ((size_t)(bl * TT + _tt)) * 2048 + h * 512 + ch; \
        pre[_i][0] = _b[0]; pre[_i][1] = _b[64]; pre[_i][2] = _b[128]; pre[_i][3] = _b[192]; pre[_i][4] = _b[(4 + dir) * 64]; pre[_i][5] = _b[(6 + dir) * 64]; } } while (0)
#define SC_ST(buf) do { _Pragma("unroll") for (int _i = 0; _i < 4; ++_i) { const int _st = sq + 4 * _i; \
        const float _r = bf2f(pre[_i][0]), _v = bf2f(pre[_i][1]), _k = bf2f(pre[_i][2]), _kk = bf2f(pre[_i][3]), _e = bf2f(pre[_i][4]), _sg = bf2f(pre[_i][5]); \
        float* _d = stg + (((buf) * 16 + _st) * 6) * 64 + ch; \
        _d[0] = -_kk; _d[64] = __expf(-_e); _d[128] = _kk * _sg; _d[192] = _k * (1.f + (_sg - 1.f) * ka); _d[256] = _r; _d[320] = _v; } } while (0)
    SC_GL(0); SC_ST(0);
    __syncthreads();
    constexpr int NCH = TT / 16;
    const int vrow = w * 16 + (lane & 15);
#define FMAC_BC(acc, x, sv, n) asm("v_fmac_f32_dpp %0, %1, %2 row_newbcast:" #n " row_mask:0xf bank_mask:0xf" : "+v"(acc) : "v"(x), "v"(sv))
#define MUL_BC(dst, x, sv, n) asm("v_mul_f32_dpp %0, %1, %2 row_newbcast:" #n " row_mask:0xf bank_mask:0xf" : "=v"(dst) : "v"(x), "v"(sv))
#define SC_LOAD(st_, A, W, B, K, R, V) do { const float* _dn = d0 + (st_) * 384; A = _dn[lane]; W = _dn[64 + lane]; B = _dn[128 + lane]; K = _dn[192 + lane]; R = _dn[256 + lane]; V = _dn[320 + vrow]; } while (0)
#define SA_(n) if ((n) & 1) FMAC_BC(p1, cA, S[n], n); else FMAC_BC(p0, cA, S[n], n);
#define UP_(n) { float t; MUL_BC(t, cW, S[n], n); FMAC_BC(t, cB, sa, n); FMAC_BC(t, cK, cV, n); S[n] = t; if ((n) & 1) FMAC_BC(y1, cR, t, n); else FMAC_BC(y0, cR, t, n); }
#define SC_STEP(st_, cA, cW, cB, cK, cR, cV) do { float p0 = 0.f, p1 = 0.f; REP16(SA_) const float sa = red_rows(p0 + p1); float y0 = 0.f, y1 = 0.f; REP16(UP_) \
        yb[((st_) * 4 + (lane >> 4)) * 64 + vrow] = y0 + y1; } while (0)
    for (int chunk = 0; chunk < NCH; ++chunk) {
        const int buf = chunk & 1;
        if (chunk + 1 < NCH) SC_GL(chunk + 1);
        const float* d0 = stg + (buf * 16 * 6) * 64;
        float a0, w0, b0, k0, r0, v0, a1, w1, b1, k1, r1, v1;
        SC_LOAD(0, a0, w0, b0, k0, r0, v0);
#pragma unroll 2
        for (int st = 0; st < 16; st += 2) {
            SC_LOAD(st + 1, a1, w1, b1, k1, r1, v1);
#define cA a0
#define cW w0
#define cB b0
#define cK k0
#define cR r0
#define cV v0
            SC_STEP(st, a0, w0, b0, k0, r0, v0);
#undef cA
#undef cW
#undef cB
#undef cK
#undef cR
#undef cV
            if (st + 2 < 16) SC_LOAD(st + 2, a0, w0, b0, k0, r0, v0);
#define cA a1
#define cW w1
#define cB b1
#define cK k1
#define cR r1
#define cV v1
            SC_STEP(st + 1, a1, w1, b1, k1, r1, v1);
#undef cA
#undef cW
#undef cB
#undef cK
#undef cR
#undef cV
        }
        __syncthreads();
#pragma unroll
        for (int i = 0; i < 4; ++i) {
            const int st = sq + 4 * i, s_ = chunk * 16 + st, tt = SC_TT(s_);
            Y[((size_t)dir * T_ALL + (size_t)bl * TT + tt) * 256 + h * 64 + ch] = (yb[(st * 4) * 64 + ch] + yb[(st * 4 + 1) * 64 + ch]) + (yb[(st * 4 + 2) * 64 + ch] + yb[(st * 4 + 3) * 64 + ch]);
        }
        if (chunk + 1 < NCH) SC_ST(buf ^ 1);
        __syncthreads();
    }
#undef SC_TT
#undef SC_GL
#undef SC_ST
#undef FMAC_BC
#undef MUL_BC
#undef SC_LOAD
#undef SA_
#undef UP_
#undef SC_STEP
}

DEV void phase_norm(const Params& p, int l, int which, bool skip_ctx) {
    const float* gam = p.in[which ? 5 : 4] + l * D;
    const float* mod = (const float*)(p.ws + OFF_MOD) + (size_t)l * 33 * 6144;
    bf16_t* H = (bf16_t*)(p.ws + OFF_H);
    const int lane = tid_() & 63, wave = blockIdx.x * 4 + (tid_() >> 6), nw = gridDim.x * 4;
    for (int g0 = wave; g0 < T_ALL; g0 += 2 * nw) {
        f32x4 v[2][4]; const float* m[2]; bool act[2];
#pragma unroll
        for (int u = 0; u < 2; ++u) {
            const int g = g0 + u * nw; act[u] = g < T_ALL;
            const int gg = act[u] ? g : g0;
            const int b = gg / TT, tt = gg - b * TT; const bool lat = tt < SEQ;
            if (!lat && skip_ctx) act[u] = false;
            const float* x = (l == 0 && which == 0) ? xrow_in(p, gg) : xrow(p, gg);
            m[u] = mod + (size_t)(lat ? b : 32) * 6144 + (which ? 3072 : 0);
#pragma unroll
            for (int i = 0; i < 4; ++i) v[u][i] = *(const f32x4*)(x + i * 256 + lane * 4);
        }
#pragma unroll
        for (int u = 0; u < 2; ++u) {
            float ss = 0.f;
#pragma unroll
            for (int i = 0; i < 4; ++i) ss += v[u][i][0] * v[u][i][0] + v[u][i][1] * v[u][i][1] + v[u][i][2] * v[u][i][2] + v[u][i][3] * v[u][i][3];
            ss = wave_sum_fast(ss);
            const float rstd = rsqrtf(ss * (1.f / 1024.f) + 1e-6f);
            if (act[u]) {
                const int g = g0 + u * nw;
#pragma unroll
                for (int i = 0; i < 4; ++i) {
                    const int col = i * 256 + lane * 4;
                    const f32x4 g4 = *(const f32x4*)(gam + col), sh = *(const f32x4*)(m[u] + col), sc = *(const f32x4*)(m[u] + 1024 + col);
                    const f32x4 o = v[u][i] * rstd * g4 * (sc + 1.f) + sh;
                    u32x2 w; w.x = pk2(o[0], o[1]); w.y = pk2(o[2], o[3]);
                    *(u32x2*)(H + (size_t)g * 1024 + col) = w;
                }
            }
        }
    }
}

DEV void phase_final(const Params& p) {
    const float* gam = p.in[32];
    const int lane = tid_() & 63, wave = blockIdx.x * 4 + (tid_() >> 6), nw = gridDim.x * 4;
    for (int g = wave; g < NBATCH * SEQ; g += nw) {
        float* x = p.out + (size_t)g * D;
        f32x4 v[4]; float ss = 0.f;
#pragma unroll
        for (int i = 0; i < 4; ++i) { v[i] = *(const f32x4*)(x + i * 256 + lane * 4); ss += v[i][0] * v[i][0] + v[i][1] * v[i][1] + v[i][2] * v[i][2] + v[i][3] * v[i][3]; }
        ss = wave_sum(ss);
        const float rstd = rsqrtf(ss * (1.f / 1024.f) + 1e-6f);
#pragma unroll
        for (int i = 0; i < 4; ++i) { const int col = i * 256 + lane * 4; *(f32x4*)(x + col) = v[i] * rstd * *(const f32x4*)(gam + col); }
    }
}

DEV void phase_prep(const Params& p, int l, int c) {
    char* scr = p.ws + OFF_SCR;
    const bf16_t* ZR = (const bf16_t*)(scr + SO_ZR);
    bf16_t* SC = (bf16_t*)(scr + SO_SC) + (size_t)c * TC * 2048; bf16_t* AWA = (bf16_t*)(scr + SO_AWA); bf16_t* AG = (bf16_t*)(scr + SO_AG) + (size_t)c * TC * 64;
    float* rsq = (float*)(p.ws + OFF_RSQ); float* rskv = (float*)(p.ws + OFF_RSKV);
    const float* mu0 = p.in[15] + (size_t)l * 2 * 896; const float* mu1 = mu0 + 896;
    const int lane = tid_() & 63, wave = blockIdx.x * 4 + (tid_() >> 6), nw = gridDim.x * 4;
    f32x4 m0[3], m1[3];
#pragma unroll
    for (int s3 = 0; s3 < 3; ++s3) { m0[s3] = *(const f32x4*)(mu0 + s3 * 256 + lane * 4); m1[s3] = *(const f32x4*)(mu1 + s3 * 256 + lane * 4); }
    const f32x4 kk4 = *(const f32x4*)(p.in[21] + l * 256 + lane * 4);
    const float mw0 = mu0[768 + lane], mw1 = mu1[768 + lane], mg0 = mu0[832 + lane], mg1 = mu1[832 + lane];
    for (int t0 = wave; t0 < TC; t0 += 2 * nw) {
        u32x2 q[2], c0[2][3], cp[2][3], cn[2][3]; unsigned kv[2]; bf16_t wz[2][3], gz[2][3]; bool act[2], hp[2], hn[2];
#pragma unroll
        for (int u = 0; u < 2; ++u) {
            const int t = t0 + u * nw; act[u] = t < TC;
            const int ts = act[u] ? t : t0, tt = ts % TT;
            hp[u] = !(tt == 0 || tt == SEQ); hn[u] = !(tt == SEQ - 1 || tt == TT - 1);
            const bf16_t* z = ZR + (size_t)ts * ZRW;
            const bf16_t* zp = hp[u] ? z - ZRW : z; const bf16_t* zn = hn[u] ? z + ZRW : z;
            q[u] = *(const u32x2*)(z + 768 + lane * 4); kv[u] = *(const unsigned*)(z + 1024 + lane * 2);
#pragma unroll
            for (int s3 = 0; s3 < 3; ++s3) { const int col = s3 * 256 + lane * 4; c0[u][s3] = *(const u32x2*)(z + col); cp[u][s3] = *(const u32x2*)(zp + col); cn[u][s3] = *(const u32x2*)(zn + col); }
            wz[u][0] = z[1184 + lane]; wz[u][1] = zp[1184 + lane]; wz[u][2] = zn[1184 + lane];
            gz[u][0] = z[1280 + lane]; gz[u][1] = zp[1280 + lane]; gz[u][2] = zn[1280 + lane];
        }
#pragma unroll
        for (int u = 0; u < 2; ++u) {
            const int t = t0 + u * nw;
            const float fp = hp[u] ? 1.f : 0.f, fn = hn[u] ? 1.f : 0.f;
            float s = lo_bf(q[u].x) * lo_bf(q[u].x) + hi_bf(q[u].x) * hi_bf(q[u].x) + lo_bf(q[u].y) * lo_bf(q[u].y) + hi_bf(q[u].y) * hi_bf(q[u].y);
            s = wave_sum_fast(s);
            float s2 = lo_bf(kv[u]) * lo_bf(kv[u]) + hi_bf(kv[u]) * hi_bf(kv[u]);
            s2 = wave_sum_fast(s2);
            float zs[3][4];
#pragma unroll
            for (int s3 = 0; s3 < 3; ++s3) {
                const float zc[4] = {lo_bf(c0[u][s3].x), hi_bf(c0[u][s3].x), lo_bf(c0[u][s3].y), hi_bf(c0[u][s3].y)};
                const float zp[4] = {lo_bf(cp[u][s3].x) * fp, hi_bf(cp[u][s3].x) * fp, lo_bf(cp[u][s3].y) * fp, hi_bf(cp[u][s3].y) * fp};
                const float zn[4] = {lo_bf(cn[u][s3].x) * fn, hi_bf(cn[u][s3].x) * fn, lo_bf(cn[u][s3].y) * fn, hi_bf(cn[u][s3].y) * fn};
#pragma unroll
                for (int i = 0; i < 4; ++i) zs[s3][i] = zc[i] + m0[s3][i] * (zp[i] - zc[i]) + m1[s3][i] * (zn[i] - zc[i]);
            }
            float kk[4]; float ss = 0.f;
#pragma unroll
            for (int i = 0; i < 4; ++i) { kk[i] = zs[1][i] * kk4[i]; ss += kk[i] * kk[i]; }
            ss = sum16(ss);
            const float inv = rsqrtf(fmaxf(ss, 1e-24f));
            float vw, vg;
            { const float zc = bf2f(wz[u][0]), zp = bf2f(wz[u][1]) * fp, zn = bf2f(wz[u][2]) * fn; vw = zc + mw0 * (zp - zc) + mw1 * (zn - zc); }
            { const float zc = bf2f(gz[u][0]), zp = bf2f(gz[u][1]) * fp, zn = bf2f(gz[u][2]) * fn; vg = zc + mg0 * (zp - zc) + mg1 * (zn - zc); }
            if (act[u]) {
                if (lane == 0) { rsq[t] = rsqrtf(s * (1.f / 256.f) + 1e-6f); rskv[t] = rsqrtf(s2 * (1.f / 128.f) + 1e-6f); }
                const int h = lane >> 4, j = (lane & 15) * 4;
                bf16_t* sc = SC + (size_t)t * 2048 + h * 512 + j;
                u32x2 w;
                w.x = pk2(zs[0][0], zs[0][1]); w.y = pk2(zs[0][2], zs[0][3]); *(u32x2*)(sc) = w;
                w.x = pk2(zs[2][0], zs[2][1]); w.y = pk2(zs[2][2], zs[2][3]); *(u32x2*)(sc + 64) = w;
                w.x = pk2(zs[1][0], zs[1][1]); w.y = pk2(zs[1][2], zs[1][3]); *(u32x2*)(sc + 128) = w;
                w.x = pk2(kk[0] * inv, kk[1] * inv); w.y = pk2(kk[2] * inv, kk[3] * inv); *(u32x2*)(sc + 192) = w;
                AWA[(size_t)t * 64 + lane] = f2bf(lane < 32 ? 2.f * sigmoidf_(2.f * vw) - 1.f : vw);
                AG[(size_t)t * 64 + lane] = f2bf(sigmoidf_(vg));
            }
        }
    }
}

DEV void phase_gemm_small(const Params& p, int l, int c, char* smem) {
    char* scr = p.ws + OFF_SCR;
    const bf16_t* ZR = (const bf16_t*)(scr + SO_ZR);
    const float* cosT = (const float*)(p.ws + OFF_COS); const float* sinT = (const float*)(p.ws + OFF_SIN);
    EpiUQ euq{(bf16_t*)(scr + SO_MQ), (const float*)(p.ws + OFF_RSQ), cosT, sinT};
    EpiUKV eukv{(bf16_t*)(scr + SO_KN), (bf16_t*)(scr + SO_VTM), (const float*)(p.ws + OFF_RSKV)};
    EpiWA ewa{(bf16_t*)(scr + SO_SC) + (size_t)c * TC * 2048, p.in[16] + (size_t)l * 512, p.in[18] + (size_t)l * 512};
    constexpr int NTM = TC / 128;
    constexpr int T1 = NTM * 3, T2 = T1 + NTM * 4, T3 = T2 + NTM * 8;
    for (int t = blockIdx.x; t < T3; t += gridDim.x) {
        if (t < T1) { const int tm = t / 3, tn = t - tm * 3; gemm_tile(ZR + 768, ZRW, wl(p, l, WE_UQ), 256, 256, tm, tn, smem, euq); }
        else if (t < T2) { const int u = t - T1, tm = u >> 2, tn = u & 3; gemm_tile(ZR + 1024, ZRW, wl(p, l, WE_UKV), 128, 128, tm, tn, smem, eukv); }
        else { const int u = t - T2, tm = u >> 3, tn = u & 7; gemm_tile((const bf16_t*)(scr + SO_AWA), 64, wl(p, l, WE_WA), 64, 64, tm, tn, smem, ewa); }
    }
}

DEV void phase_mix(const Params& p, int l, int c, int phase_idx, char* smem, int rmask, int* s_item) {
    char* scr = p.ws + OFF_SCR;
    const bf16_t* QK = (const bf16_t*)(scr + SO_QK); const bf16_t* ZR = (const bf16_t*)(scr + SO_ZR);
    const bf16_t* MQ = (const bf16_t*)(scr + SO_MQ); const bf16_t* KN = (const bf16_t*)(scr + SO_KN);
    const bf16_t* VtNA = (const bf16_t*)(scr + SO_VTNA); const bf16_t* VtD = (const bf16_t*)(scr + SO_VTD); const bf16_t* VtM = (const bf16_t*)(scr + SO_VTM);
    bf16_t* MIX = (bf16_t*)(p.ws + OFF_H) + (size_t)c * TC * 1024;
    int* ctr = (int*)(p.ws + OFF_CTR) + phase_idx;
    const bool need_ctx = l < DEPTH - 1;
    const float lam = ((const float*)(p.ws + OFF_LAM))[l];
    const float lam_init = 0.8f - 0.6f * expf(-0.3f * (float)l);
    constexpr int DQ = 64 * DMQ, DLT = SEQ / DQ, DCT = CTXL / DQ;
    const int N_SCAN = (c == NCHUNK - 1) ? NBATCH * 8 : 0; constexpr int N_ML = CB * 64, N_DL = CB * 4 * DLT, N_NL = CB * 128, N_MC = CB * 8, N_DC = CB * 4 * DCT, N_NC = CB * 16;
    const int E0 = N_SCAN, E1 = E0 + N_ML, E2 = E1 + N_DL, E3 = E2 + N_NL, E4 = E3 + N_MC, E5 = E4 + N_DC, E6 = E5 + N_NC;
    const int total = need_ctx ? E6 : E3;
    constexpr float L2E = 1.44269504f;
    if (rmask & 1) for (int it = blockIdx.x; it < N_SCAN; it += gridDim.x) {
        const int bl = it >> 3, h = (it >> 1) & 3, dir = it & 1;
        __builtin_amdgcn_s_setprio(3);
        scan_item((const bf16_t*)(scr + SO_SC), (float*)(scr + SO_Y), bl, h, dir, p.in[22] + l * 256, smem);
        __builtin_amdgcn_s_setprio(0);
    }
    for (;;) {
        if (tid_() == 0) *s_item = E0 + atomicAdd(ctr, 1);
        __syncthreads();
        const int it = __builtin_amdgcn_readfirstlane(*s_item);
        __syncthreads();
        if (it >= total) break;
        if (!(rmask & 2)) continue;
        AttnArgs a{};
        if (it < E0) {
        } else if (it < E1 || (it >= E3 && it < E4)) {
            const bool cx = it >= E3; int bl, h, q0;
            if (!cx) { const int u = it - E0; bl = u >> 6; h = (u >> 4) & 3; q0 = (u & 15) * 128; }
            else { const int u = it - E3; bl = u >> 3; h = (u >> 1) & 3; q0 = SEQ + (u & 1) * 128; }
            const size_t tb = (size_t)bl * TT;
            a.Q = MQ + (tb + q0) * 384 + h * 96; a.qs = 384;
            a.K = KN + tb * 256 + h * 64; a.ks = 256; a.K2 = ZR + tb * ZRW + 1152; a.k2s = ZRW;
            a.Vt = VtM + ((size_t)(bl * 4 + h) * 64) * TT;
            a.O = MIX + (tb + q0) * 1024 + 256 + h * 64; a.os = 1024;
            a.kstart = cx ? SEQ : 0; a.nkt = cx ? 4 : 36; a.sc2 = 0.10206207261596575f * L2E;
            if (MIXMASK & 2) attn_item<96, 1, 2, false>(a, smem);
        } else if (it < E2 || (it >= E4 && it < E5)) {
            const bool cx = it >= E4; int bl, h, q0;
            if (!cx) { const int u = it - E1; bl = u / (4 * DLT); h = (u / DLT) & 3; q0 = (u % DLT) * DQ; }
            else { const int u = it - E4; bl = u / (4 * DCT); h = (u / DCT) & 3; q0 = SEQ + (u % DCT) * DQ; }
            const size_t tb = (size_t)bl * TT;
            a.Q = QK + (tb + q0) * 1024 + 512 + h * 64; a.qs = 1024;
            a.K = QK + tb * 1024 + 768 + h * 64; a.ks = 1024;
            a.Vt = VtD + ((size_t)(bl * 4 + h) * 64) * TT;
            a.O = MIX + (tb + q0) * 1024 + 768 + h * 64; a.os = 1024;
            a.kstart = cx ? SEQ : 0; a.nkt = cx ? 4 : 36; a.sc2 = 0.17677669529663687f * L2E;
            a.lam = lam; a.oscale = 1.f - lam_init; a.subln = p.in[27] + l * 64;
            if (MIXMASK & 4) attn_item<64, 2, DMQ, false>(a, smem);
        } else {
            const bool cx = it >= E5; int bl, h, q0;
            if (!cx) { const int u = it - E2; bl = u >> 7; h = (u >> 5) & 3; const int r = u & 31; q0 = r * 64; a.na_r = r; a.na_rs = min(max(r - 4, 0), 24); }
            else { const int u = it - E5; bl = u >> 4; h = (u >> 2) & 3; q0 = SEQ + (u & 3) * 64; }
            const size_t tb = (size_t)bl * TT;
            a.Q = QK + (tb + q0) * 1024 + h * 64; a.qs = 1024;
            a.K = QK + tb * 1024 + 256 + h * 64; a.ks = 1024;
            a.Vt = VtNA + ((size_t)(bl * 4 + h) * 64) * TT;
            a.O = MIX + (tb + q0) * 1024 + h * 64; a.os = 1024;
            a.sc2 = 0.125f * L2E; a.rpb = p.in[10] + ((size_t)l * 4 + h) * 465;
            if (!cx) { a.nkt = 12; if (MIXMASK & 8) attn_item<64, 1, 1, true>(a, smem); }
            else { a.kstart = SEQ; a.nkt = 4; if (MIXMASK & 16) attn_item<64, 1, 1, false>(a, smem); }
        }
    }
}

DEV void phase_fix(const Params& p, int l) {
    char* scr = p.ws + OFF_SCR;
    bf16_t* G = (bf16_t*)(scr + SO_G); const float* E = (const float*)(scr + SO_E);
    const float* cw = p.in[29] + (size_t)l * 3 * DFF;
    const bool skip_ctx = !(l < DEPTH - 1);
    constexpr int NTM = T_ALL / 128;
    const int total = NTM * (DFF / 4);
    for (int idx = blockIdx.x * NTHR + tid_(); idx < total; idx += gridDim.x * NTHR) {
        const int tm = idx / (DFF / 4), j = (idx - tm * (DFF / 4)) * 4;
        const int row0 = tm * 128, tt0 = row0 % TT;
        if (skip_ctx && tt0 >= SEQ) continue;
        const bool first = (tt0 == 0 || tt0 == SEQ), last = (tt0 + 127 == SEQ - 1 || tt0 + 127 == TT - 1);
        if (!first) {
            const float* e = E + ((size_t)tm * 6) * DFF + j; const float* ep = E + ((size_t)(tm - 1) * 6 + 5) * DFF + j;
            const f32x4 pre = *(const f32x4*)(e) + *(const f32x4*)(cw + j) * *(const f32x4*)(ep), bv = *(const f32x4*)(e + DFF);
            u32x2 w; w.x = pk2(siluf_(pre[0]) * bv[0], siluf_(pre[1]) * bv[1]); w.y = pk2(siluf_(pre[2]) * bv[2], siluf_(pre[3]) * bv[3]);
            *(u32x2*)(G + (size_t)row0 * DFF + j) = w;
        }
        if (!last) {
            const float* e = E + ((size_t)tm * 6 + 3) * DFF + j; const float* en = E + ((size_t)(tm + 1) * 6 + 2) * DFF + j;
            const f32x4 pre = *(const f32x4*)(e) + *(const f32x4*)(cw + 2 * DFF + j) * *(const f32x4*)(en), bv = *(const f32x4*)(e + DFF);
            u32x2 w; w.x = pk2(siluf_(pre[0]) * bv[0], siluf_(pre[1]) * bv[1]); w.y = pk2(siluf_(pre[2]) * bv[2], siluf_(pre[3]) * bv[3]);
            *(u32x2*)(G + (size_t)(row0 + 127) * DFF + j) = w;
        }
    }
}

DEV int cm_in(int n) {
    if (n < 768) return n;
    if (n < 1536) return 2080 + (n - 768);
    if (n < 2304) return 1184 + (n - 1536);
    if (n < 2560) return 768 + (n - 2304);
    if (n < 2688) return 1024 + (n - 2560);
    if (n < 2816) { const int o = n - 2688; return o < 32 ? 1152 + o : (o < 64 ? 1952 + (o - 32) : (o < 96 ? 1984 + (o - 64) : -1)); }
    { const int o = n - 2816; return o < 64 ? 2016 + o : -1; }
}
DEV int cm_up(int n) { const int t = n >> 7, o = n & 127; return o < 64 ? t * 64 + o : DFF + t * 64 + (o - 64); }

template <int MODE>
DEV void conv_unit(const float* src, int lds_, bf16_t* dst, int K, int nt, int kt, float* tile) {
    const int tid = tid_(), a = tid & 63, b = tid >> 6;
    const int n = nt * 64 + a;
    const int col = MODE == 0 ? cm_in(n) : (MODE == 2 ? cm_up(n) : n);
#pragma unroll 4
    for (int i = 0; i < 16; ++i) { const int kl = b + 4 * i; tile[kl * 65 + a] = col >= 0 ? src[(size_t)(kt * 64 + kl) * lds_ + col] : 0.f; }
    __syncthreads();
#pragma unroll 4
    for (int i = 0; i < 16; ++i) { const int nl = b + 4 * i; dst[(size_t)(nt * 64 + nl) * K + kt * 64 + a] = f2bf(tile[a * 65 + nl]); }
    __syncthreads();
}

DEV void phase_prologue(const Params& p, char* smem) {
    const int tid = tid_(), gtid = blockIdx.x * NTHR + tid, gsz = gridDim.x * NTHR;
    if (blockIdx.x == 0) {
        int* ctr = (int*)(p.ws + OFF_CTR); ctr[tid] = 0;
        if (tid < DEPTH) {
            const float* lp = p.in[26] + tid * 128; float s0 = 0.f, s1 = 0.f;
            for (int i = 0; i < 32; ++i) { s0 += lp[i] * lp[32 + i]; s1 += lp[64 + i] * lp[96 + i]; }
            ((float*)(p.ws + OFF_LAM))[tid] = expf(s0) - expf(s1) + (0.8f - 0.6f * expf(-0.3f * (float)tid));
        }
    }
    for (int i = gtid; i < 2048 * 16; i += gsz) {
        const int tt = i >> 4, f = i & 15; const float pos = (float)(f < 8 ? tt / 64 : tt % 64);
        const float freq = powf(10000.f, -(float)(f & 7) / 8.f); const float ang = pos * freq;
        ((float*)(p.ws + OFF_COS))[i] = cosf(ang); ((float*)(p.ws + OFF_SIN))[i] = sinf(ang);
    }
    for (int i = gtid; i < DEPTH * 245760; i += gsz) {
        const int l = i / 245760; int e = i - l * 245760;
        if (e < 98304) { const int n = e >> 8, k = e & 255; wlw(p, l, WE_UQ)[e] = f2bf(p.in[13][((size_t)l * 256 + k) * 384 + n] * p.in[11][l * 256 + k]); }
        else if ((e -= 98304) < 65536) { const int n = e >> 7, k = e & 127; wlw(p, l, WE_UKV)[e] = f2bf(p.in[14][((size_t)l * 128 + k) * 512 + n] * p.in[12][l * 128 + k]); }
        else if ((e -= 65536) < 65536) { const int n = e >> 6, k = e & 63, seg = n >> 8, ch = n & 255; float v = 0.f;
            if (seg < 2) { if (k < 32) v = p.in[17][(((size_t)l * 2 + seg) * 32 + k) * 256 + ch]; }
            else { if (k >= 32) v = p.in[19][(((size_t)l * 2 + (seg - 2)) * 32 + (k - 32)) * 256 + ch]; }
            wlw(p, l, WE_WA)[e] = f2bf(v); }
        else { e -= 65536; const int n = e >> 6, k = e & 63; wlw(p, l, WE_G)[e] = f2bf(p.in[20][((size_t)l * 64 + k) * 256 + n]); }
    }
    {
        constexpr int U_IN = (ZN / 64) * 16, U_OUT = 16 * 16, U_UP = 88 * 16, U_DN = 16 * 44, U_L = U_IN + U_OUT + U_UP + U_DN;
        float* tile = (float*)smem;
        for (int u = blockIdx.x; u < DEPTH * U_L; u += gridDim.x) {
            const int l = u / U_L; int e = u - l * U_L;
            if (e < U_IN) conv_unit<0>(p.in[8] + (size_t)l * 1024 * 2848, 2848, wlw(p, l, WE_IN), 1024, e >> 4, e & 15, tile);
            else if ((e -= U_IN) < U_OUT) conv_unit<1>(p.in[9] + (size_t)l * 1024 * 1024, 1024, wlw(p, l, WE_OUT), 1024, e >> 4, e & 15, tile);
            else if ((e -= U_OUT) < U_UP) conv_unit<2>(p.in[28] + (size_t)l * 1024 * 5632, 5632, wlw(p, l, WE_UP), 1024, e >> 4, e & 15, tile);
            else { e -= U_UP; conv_unit<1>(p.in[31] + (size_t)l * 2816 * 1024, 1024, wlw(p, l, WE_DOWN), 2816, e / 44, e % 44, tile); }
        }
    }
    {
        float* Ssm = (float*)smem;
        float* red = Ssm + 33 * 128;
        const int lane = tid & 63, w = tid >> 6;
        for (int u = blockIdx.x; u < DEPTH * 96; u += gridDim.x) {
            const int l = u / 96, n0 = (u - l * 96) * 64;
            const float* W = p.in[6] + (size_t)l * 1024 * 6144 + n0 + lane;
            float acc[33];
#pragma unroll
            for (int r = 0; r < 33; ++r) acc[r] = 0.f;
            for (int kc = 0; kc < 8; ++kc) {
                __syncthreads();
                for (int i = tid; i < 33 * 128; i += NTHR) { const int r = i >> 7, k = kc * 128 + (i & 127); const float cv = r < 32 ? p.in[1][r * 1024 + k] : p.in[3][k]; Ssm[i] = siluf_(cv); }
                __syncthreads();
                for (int kk = 0; kk < 32; ++kk) {
                    const int kl = w * 32 + kk; const float wv = W[(size_t)(kc * 128 + kl) * 6144];
#pragma unroll
                    for (int r = 0; r < 33; ++r) acc[r] += Ssm[r * 128 + kl] * wv;
                }
            }
#pragma unroll
            for (int r = 0; r < 33; ++r) red[(w * 33 + r) * 64 + lane] = acc[r];
            __syncthreads();
            for (int i = tid; i < 33 * 64; i += NTHR) {
                const int r = i >> 6, n = i & 63;
                const float v = red[(0 * 33 + r) * 64 + n] + red[(1 * 33 + r) * 64 + n] + red[(2 * 33 + r) * 64 + n] + red[(3 * 33 + r) * 64 + n];
                ((float*)(p.ws + OFF_MOD))[((size_t)l * 33 + r) * 6144 + n0 + n] = v + p.in[7][(size_t)l * 6144 + n0 + n];
            }
            __syncthreads();
        }
    }
}

constexpr int PH_PER_LAYER = 15, N_PHASES = 2 + DEPTH * PH_PER_LAYER;

DEV void run_phase(const Params& p, int ph, char* smem, int ctr_off, int* s_item) {
    if (ph == 0) { phase_prologue(p, smem); return; }
    if (ph == N_PHASES - 1) { phase_final(p); return; }
    const int l = (ph - 1) / PH_PER_LAYER, s = (ph - 1) % PH_PER_LAYER;
    const bool last_layer = (l == DEPTH - 1);
    char* scr = p.ws + OFF_SCR;
    const float* mod = (const float*)(p.ws + OFF_MOD) + (size_t)l * 33 * 6144;
    const bf16_t* H = (const bf16_t*)(p.ws + OFF_H);
    if (s == 0) { phase_norm(p, l, 0, false); return; }
    if (s >= 1 && s <= 8) {
        const int c = (s - 1) / 4, q = (s - 1) % 4;
        if (q == 0) {
            EpiIn e{(bf16_t*)(scr + SO_QK), (bf16_t*)(scr + SO_ZR), (bf16_t*)(scr + SO_VTNA), (bf16_t*)(scr + SO_VTD), (const float*)(p.ws + OFF_COS), (const float*)(p.ws + OFF_SIN)};
            gemm_phase(H + (size_t)c * TC * 1024, 1024, wl(p, l, WE_IN), 1024, 1024, TC / 128, ZN / 128, false, smem, e);
        } else if (q == 1) phase_prep(p, l, c);
        else if (q == 2) phase_gemm_small(p, l, c, smem);
        else phase_mix(p, l, c, ph + ctr_off, smem, ctr_off ? PROBE_MIXSEL : 3, s_item);
        return;
    }
    if (s == 9) {
        EpiG e{(bf16_t*)(p.ws + OFF_H), (const bf16_t*)(scr + SO_SC), (const float*)(scr + SO_Y), p.in[23] + l * 256, p.in[24] + l * 256, p.in[25] + l * 256, 0};
        gemm_phase((const bf16_t*)(scr + SO_AG), 64, wl(p, l, WE_G), 64, 64, T_ALL / 128, 2, last_layer, smem, e);
        return;
    }
    if (s == 10) { EpiRes e{&p, mod, 2048, l == 0 ? 1 : 0}; gemm_phase(H, 1024, wl(p, l, WE_OUT), 1024, 1024, T_ALL / 128, 8, last_layer, smem, e); return; }
    if (s == 11) { phase_norm(p, l, 1, last_layer); return; }
    if (s == 12) { EpiUp e{(bf16_t*)(scr + SO_G), (float*)(scr + SO_E), p.in[29] + (size_t)l * 3 * DFF, p.in[30] + (size_t)l * DFF};
                   gemm_phase(H, 1024, wl(p, l, WE_UP), 1024, 1024, T_ALL / 128, 44, last_layer, smem, e); return; }
    if (s == 13) { phase_fix(p, l); return; }
    { EpiRes e{&p, mod, 5120, 0}; gemm_phase((const bf16_t*)(scr + SO_G), DFF, wl(p, l, WE_DOWN), DFF, DFF, T_ALL / 128, 8, last_layer, smem, e); }
}

#define XB_TMO      128
#define XB_XCNT(j)  (256  + 64 * (j))
#define XB_XSUB(j)  (1280 + 64 * (j))
#define XB_XGEN(j)  (2304 + 64 * (j))
#define XB_TOP      3328
#define XB_TOPGEN   3392
#define XCD_BAR_WORDS 3456
#define XB_SPIN_CAP (1u << 18)

__device__ __forceinline__ unsigned xb_ld(unsigned* p)              { return __hip_atomic_load(p, __ATOMIC_RELAXED, __HIP_MEMORY_SCOPE_AGENT); }
__device__ __forceinline__ unsigned xb_add(unsigned* p, unsigned v) { return __hip_atomic_fetch_add(p, v, __ATOMIC_RELAXED, __HIP_MEMORY_SCOPE_AGENT); }
__device__ __forceinline__ unsigned xb_xcc_id() { return (unsigned)__builtin_amdgcn_s_getreg((3 << 11) | 20) & 0xFu; }
#define XB_SPIN(cond, bar) do { unsigned _sp = 0; while (cond) { __builtin_amdgcn_s_sleep(1); \
    if ((++_sp & 255u) == 0u) { if (xb_ld(&(bar)[XB_TMO])) break; if (_sp > XB_SPIN_CAP) { atomicAdd(&(bar)[XB_TMO], 1u); break; } } } } while (0)

struct XcdBarrier {
    unsigned* bar; unsigned x;
    volatile LAS unsigned* st;
};

__device__ __forceinline__ XcdBarrier xcd_barrier_post(unsigned* bar, volatile LAS unsigned* st) {
    XcdBarrier b; b.bar = bar; b.x = xb_xcc_id(); b.st = st;
    if (threadIdx.x == 0) (void)xb_add(&bar[XB_XCNT(b.x)], 1u);
    return b;
}
__device__ __forceinline__ void xcd_barrier_complete(unsigned* bar, unsigned x, unsigned& nloc, unsigned& nx) {
    const unsigned G = gridDim.x * gridDim.y * gridDim.z;
    unsigned sum, cnt, mine, sp = 0u;
    for (;;) {
        sum = 0u; cnt = 0u; mine = 0u;
#pragma unroll
        for (unsigned j = 0; j < 16; ++j) { const unsigned c = xb_ld(&bar[XB_XCNT(j)]); sum += c; cnt += (c > 0u) ? 1u : 0u; mine = (j == x) ? c : mine; }
        if (sum == G) break;
        __builtin_amdgcn_s_sleep(1);
        if ((++sp & 255u) == 0u) { if (xb_ld(&bar[XB_TMO])) break; if (sp > XB_SPIN_CAP) { atomicAdd(&bar[XB_TMO], 1u); break; } }
    }
    nloc = mine > 0u ? mine : 1u; nx = cnt > 0u ? cnt : 1u;
}

__device__ __forceinline__ void xcd_barrier(const XcdBarrier& b) {
    asm volatile("s_waitcnt vmcnt(0)" ::: "memory");
    __syncthreads();
    if (threadIdx.x == 0) {
        unsigned* bar = b.bar;
        __builtin_amdgcn_s_waitcnt(0);
        unsigned nloc = b.st[0], nx = b.st[1];
        if (nloc == 0u) { xcd_barrier_complete(bar, b.x, nloc, nx); b.st[0] = nloc; b.st[1] = nx; }
        const unsigned old = xb_add(&bar[XB_XSUB(b.x)], 1u);
        const unsigned gen = old / nloc;
        if (old + 1u == (gen + 1u) * nloc) {
            __builtin_amdgcn_fence(__ATOMIC_RELEASE, "agent");
            asm volatile("s_waitcnt vmcnt(0)" ::: "memory");
            const unsigned og = xb_add(&bar[XB_TOP], 1u);
            const unsigned tg = og / nx;
            if (og + 1u == (tg + 1u) * nx) xb_add(&bar[XB_TOPGEN], 1u);
            else XB_SPIN(xb_ld(&bar[XB_TOPGEN]) == tg, bar);
            __builtin_amdgcn_fence(__ATOMIC_ACQUIRE, "agent");
            xb_add(&bar[XB_XGEN(b.x)], 1u);
            asm volatile("s_waitcnt vmcnt(0)" ::: "memory");
        } else {
            XB_SPIN(xb_ld(&bar[XB_XGEN(b.x)]) == gen, bar);
            __builtin_amdgcn_fence(__ATOMIC_ACQUIRE, "agent");
            asm volatile("s_waitcnt vmcnt(0)" ::: "memory");
        }
    }
    __syncthreads();
}


__global__ void __launch_bounds__(NTHR, 2) mk_fwd(Params p, int ph_lo, int ph_hi) {
    extern __shared__ __attribute__((aligned(16))) char smem[];
    __shared__ uint4 s_ctl;
    if (threadIdx.x == 0) s_ctl = make_uint4(0u, 0u, 0u, 0u);
    __syncthreads();
    XcdBarrier xb = xcd_barrier_post((unsigned*)(p.ws + OFF_XBAR), (volatile LAS unsigned*)&s_ctl);
    int* s_item = (int*)&s_ctl + 2;
    for (int ph = ph_lo; ph <= ph_hi; ++ph) {
        run_phase(p, ph, smem, 0, s_item);
#ifdef PROBE_DUP
        if (ph > 0 && ph < N_PHASES - 1) {
            const int s_ = (ph - 1) % PH_PER_LAYER, q_ = (s_ >= 1 && s_ <= 8) ? (s_ - 1) % 4 : -1;
            bool dup = false;
            if ((PROBE_DUP & 1) && (q_ == 0)) dup = true;
            if ((PROBE_DUP & 2) && (s_ == 12)) dup = true;
            if ((PROBE_DUP & 4) && (q_ == 3)) dup = true;
            if ((PROBE_DUP & 8) && (q_ == 2 || s_ == 9)) dup = true;
            if ((PROBE_DUP & 16) && (s_ == 0 || s_ == 11 || q_ == 1 || s_ == 13)) dup = true;
            if (dup) run_phase(p, ph, smem, 100, s_item);
        }
#endif
        if (ph < ph_hi) {
            if (ph_lo < 0) cg::this_grid().sync();
            xcd_barrier(xb);
        }
    }
}

extern "C" void kernel_launch(void* const* d_in, const int* in_sizes, int n_in, void* d_out, int out_size, void* d_ws, size_t ws_size, hipStream_t stream) {
    static int grid = 0;
    if (grid == 0) {
        if (n_in != 33 || ws_size < WS_NEED) { fprintf(stderr, "kernel_launch: n_in %d ws %zu need %zu\n", n_in, ws_size, (size_t)WS_NEED); grid = -1; return; }
        int dev = 0, cus = 0, per_cu = 0;
        hipGetDevice(&dev);
        hipDeviceGetAttribute(&cus, hipDeviceAttributeMultiprocessorCount, dev);
        if (hipFuncSetAttribute((const void*)mk_fwd, hipFuncAttributeMaxDynamicSharedMemorySize, LDS_BYTES) != hipSuccess) { fprintf(stderr, "hipFuncSetAttribute failed\n"); grid = -1; return; }
        if (hipOccupancyMaxActiveBlocksPerMultiprocessor(&per_cu, (const void*)mk_fwd, NTHR, LDS_BYTES) != hipSuccess || per_cu < 1) { fprintf(stderr, "occupancy query failed (%d)\n", per_cu); per_cu = 1; }
        if (per_cu > 2) per_cu = 2;
        grid = cus * per_cu;
        fprintf(stderr, "kernel_launch: grid %d (%d CUs x %d)\n", grid, cus, per_cu);
    }
    if (grid < 0) return;
    Params p{};
    for (int i = 0; i < 33; ++i) p.in[i] = (const float*)d_in[i];
    p.out = (float*)d_out; p.ws = (char*)d_ws;
#if MK_ONE_LAUNCH
    if (hipMemsetAsync((char*)d_ws + OFF_XBAR, 0, XCD_BAR_WORDS * 4, stream) != hipSuccess) { fprintf(stderr, "memset failed\n"); return; }
    int lo = 0, hi = N_PHASES - 1;
    void* args[] = {&p, &lo, &hi};
    hipError_t e = hipLaunchCooperativeKernel((const void*)mk_fwd, dim3(grid), dim3(NTHR), args, LDS_BYTES, stream);
    if (e != hipSuccess) fprintf(stderr, "cooperative launch failed: %s (grid %d)\n", hipGetErrorString(e), grid);
#else
    for (int ph = 0; ph < N_PHASES; ++ph) {
        int lo = ph, hi = ph;
        void* args[] = {&p, &lo, &hi};
        hipError_t e = hipLaunchCooperativeKernel((const void*)mk_fwd, dim3(grid), dim3(NTHR), args, LDS_BYTES, stream);
        if (e != hipSuccess) { fprintf(stderr, "launch %d failed: %s (grid %d)\n", ph, hipGetErrorString(e), grid); break; }
    }
#endif
}
```

```cpp
#include <hip/hip_runtime.h>
#include <hip/hip_cooperative_groups.h>
#include <cstdio>
#include <cstdint>
namespace cg = cooperative_groups;

#ifndef MK_ONE_LAUNCH
#define MK_ONE_LAUNCH 1
#endif

typedef unsigned short bf16_t;
typedef short bf16x8 __attribute__((ext_vector_type(8)));
typedef float f32x4 __attribute__((ext_vector_type(4)));
typedef unsigned u32x4 __attribute__((ext_vector_type(4)));
typedef unsigned u32x2 __attribute__((ext_vector_type(2)));
#define DEV __device__ __forceinline__
#define LAS __attribute__((address_space(3)))

constexpr int D = 1024, NBATCH = 32, SEQ = 2048, CTXL = 256, TT = 2304, T_ALL = NBATCH * TT, DEPTH = 4, DFF = 2816;
constexpr int NCHUNK = 2, CB = NBATCH / NCHUNK, TC = CB * TT;
constexpr int ZN = 2944, ZRW = 1408;
constexpr int NTHR = 256;
constexpr int LDS_BYTES = 73728;
constexpr int GP = 72;
constexpr int CP = 132;
#ifndef PROBE_MIXSEL
#define PROBE_MIXSEL 3
#endif
#ifndef MIXMASK
#define MIXMASK 31
#endif
#ifndef DMQ
#define DMQ 2
#endif

constexpr size_t al256(size_t x) { return (x + 255) & ~(size_t)255; }
constexpr size_t OFF_CTR = 0;
constexpr size_t OFF_LAM = 1024;
constexpr size_t OFF_XBAR = 4096;
constexpr size_t OFF_COS = 32768;
constexpr size_t OFF_SIN = OFF_COS + 2048 * 16 * 4;
constexpr size_t OFF_MOD = OFF_SIN + 2048 * 16 * 4;
constexpr size_t OFF_RSQ = al256(OFF_MOD + (size_t)DEPTH * 33 * 6144 * 4);
constexpr size_t OFF_RSKV = OFF_RSQ + (size_t)TC * 4;
constexpr size_t OFF_XC = al256(OFF_RSKV + (size_t)TC * 4);
constexpr size_t OFF_W = al256(OFF_XC + (size_t)NBATCH * CTXL * D * 4);
constexpr size_t WE_IN = 0;
constexpr size_t WE_OUT = WE_IN + (size_t)ZN * 1024;
constexpr size_t WE_UP = WE_OUT + (size_t)1024 * 1024;
constexpr size_t WE_DOWN = WE_UP + (size_t)5632 * 1024;
constexpr size_t WE_UQ = WE_DOWN + (size_t)1024 * 2816;
constexpr size_t WE_UKV = WE_UQ + (size_t)384 * 256;
constexpr size_t WE_WA = WE_UKV + (size_t)512 * 128;
constexpr size_t WE_G = WE_WA + (size_t)1024 * 64;
constexpr size_t WE_TOTAL = WE_G + (size_t)256 * 64;
constexpr size_t OFF_H = al256(OFF_W + (size_t)DEPTH * WE_TOTAL * 2);
constexpr size_t OFF_SCR = al256(OFF_H + (size_t)T_ALL * 1024 * 2);
constexpr size_t SO_QK = 0;
constexpr size_t SO_ZR = al256(SO_QK + (size_t)TC * 1024 * 2);
constexpr size_t VT_ELEMS = (size_t)CB * 4 * 64 * TT;
constexpr size_t SO_VTNA = al256(SO_ZR + (size_t)TC * ZRW * 2);
constexpr size_t SO_VTD = SO_VTNA + VT_ELEMS * 2;
constexpr size_t SO_VTM = SO_VTD + VT_ELEMS * 2;
constexpr size_t SO_MQ = SO_VTM + VT_ELEMS * 2;
constexpr size_t SO_KN = al256(SO_MQ + (size_t)TC * 384 * 2);
constexpr size_t SO_AWA = al256(SO_KN + (size_t)TC * 256 * 2);
constexpr size_t SO_AG = al256(SO_AWA + (size_t)TC * 64 * 2);
constexpr size_t SO_SC = al256(SO_AG + (size_t)T_ALL * 64 * 2);
constexpr size_t SO_Y = al256(SO_SC + (size_t)T_ALL * 2048 * 2);
constexpr size_t SO_END = al256(SO_Y + (size_t)2 * T_ALL * 256 * 4);
constexpr size_t SO_G = 0;
constexpr size_t SO_E = al256(SO_G + (size_t)T_ALL * DFF * 2);
constexpr size_t SO_END2 = al256(SO_E + (size_t)(T_ALL / 128) * 6 * DFF * 4);
constexpr size_t WS_NEED = OFF_SCR + (SO_END > SO_END2 ? SO_END : SO_END2);

struct Params { const float* in[33]; float* out; char* ws; };

DEV int tid_() { int t = __builtin_amdgcn_workitem_id_x(); asm volatile("" : "+v"(t)); return t; }
DEV float bf2f(bf16_t b) { return __uint_as_float(((unsigned)b) << 16); }
DEV bf16_t f2bf(float f) { unsigned u = __float_as_uint(f); u += 0x7fffu + ((u >> 16) & 1u); return (bf16_t)(u >> 16); }
typedef __bf16 bf16v2_t __attribute__((ext_vector_type(2)));
typedef float f32v2_t __attribute__((ext_vector_type(2)));
DEV unsigned pk2(float a, float b) { const f32v2_t f = {a, b}; return __builtin_bit_cast(unsigned, __builtin_convertvector(f, bf16v2_t)); }
DEV float lo_bf(unsigned u) { return __uint_as_float(u << 16); }
DEV float hi_bf(unsigned u) { return __uint_as_float(u & 0xffff0000u); }
DEV float wave_sum(float v) {
#pragma unroll
    for (int o = 32; o >= 1; o >>= 1) v += __shfl_xor(v, o);
    return v;
}
template <int CTRL> DEV float dppf(float v) { return __builtin_bit_cast(float, __builtin_amdgcn_update_dpp(0, __builtin_bit_cast(int, v), CTRL, 0xf, 0xf, true)); }
DEV float sum16(float v) { v += dppf<0xB1>(v); v += dppf<0x4E>(v); v += dppf<0x124>(v); v += dppf<0x128>(v); return v; }
DEV float max16(float v) { v = fmaxf(v, dppf<0xB1>(v)); v = fmaxf(v, dppf<0x4E>(v)); v = fmaxf(v, dppf<0x124>(v)); v = fmaxf(v, dppf<0x128>(v)); return v; }
DEV float sum32(float v) { v = sum16(v); v += __shfl_xor(v, 16); return v; }
DEV float sigmoidf_(float x) { return __builtin_amdgcn_rcpf(1.f + __expf(-x)); }
DEV float siluf_(float x) { return x * __builtin_amdgcn_rcpf(1.f + __expf(-x)); }

DEV float* xrow(const Params& p, int g) {
    const int b = g / TT, tt = g - b * TT;
    return tt < SEQ ? p.out + ((size_t)b * SEQ + tt) * D : (float*)(p.ws + OFF_XC) + ((size_t)b * CTXL + (tt - SEQ)) * D;
}
DEV const float* xrow_in(const Params& p, int g) {
    const int b = g / TT, tt = g - b * TT;
    return tt < SEQ ? p.in[0] + ((size_t)b * SEQ + tt) * D : p.in[2] + ((size_t)b * CTXL + (tt - SEQ)) * D;
}
DEV const bf16_t* wl(const Params& p, int l, size_t we) { return (const bf16_t*)(p.ws + OFF_W) + (size_t)l * WE_TOTAL + we; }
DEV bf16_t* wlw(const Params& p, int l, size_t we) { return (bf16_t*)(p.ws + OFF_W) + (size_t)l * WE_TOTAL + we; }

template <class Epi>
DEV void gemm_tile(const bf16_t* __restrict__ A, int lda, const bf16_t* __restrict__ Bt, int ldb, int K, int tm, int tn, char* smem, const Epi& epi) {
    const int tid = tid_(), lane = tid & 63, wid = tid >> 6, wr = wid >> 1, wc = wid & 1, fr = lane & 15, fq = lane >> 4;
    bf16_t* As = (bf16_t*)smem;
    bf16_t* Bs = As + 2 * 128 * 64;
    const int lrow = tid >> 3, lcc = (tid & 7) * 8, lsw = (((tid & 7) ^ (lrow & 7)) * 8);
    const bf16_t* Ag = A + (size_t)(tm * 128 + lrow) * lda + lcc;
    const bf16_t* Bg = Bt + (size_t)(tn * 128 + lrow) * ldb + lcc;
    f32x4 acc[4][4];
#pragma unroll
    for (int m = 0; m < 4; ++m)
#pragma unroll
        for (int n = 0; n < 4; ++n) acc[m][n] = (f32x4){0.f, 0.f, 0.f, 0.f};
    const int gsw = (((tid & 7) ^ (lrow & 7)) * 8);
    const bf16_t* Ad = A + (size_t)(tm * 128 + lrow) * lda + gsw;
    const bf16_t* Bd = Bt + (size_t)(tn * 128 + lrow) * ldb + gsw;
    char* Asb = (char*)As; char* Bsb = (char*)Bs;
#define G_DMA(buf_, kt_) do { const int ko_ = (kt_) * 64; \
        _Pragma("unroll") for (int i = 0; i < 4; ++i) { \
            __builtin_amdgcn_global_load_lds((const unsigned*)(Ad + (size_t)(32 * i) * lda + ko_), (LAS unsigned*)(Asb + (buf_) * 16384 + i * 4096 + tid * 16), 16, 0, 0); \
            __builtin_amdgcn_global_load_lds((const unsigned*)(Bd + (size_t)(32 * i) * ldb + ko_), (LAS unsigned*)(Bsb + (buf_) * 16384 + i * 4096 + tid * 16), 16, 0, 0); } } while (0)
#define G_FRAGS(cur_, ks_) const bf16_t* Ac##ks_ = As + (cur_) * 128 * 64 + (wr * 64 + fr) * 64 + ((((ks_) * 4 + fq) ^ (fr & 7)) * 8); const bf16_t* Bc##ks_ = Bs + (cur_) * 128 * 64 + (wc * 64 + fr) * 64 + ((((ks_) * 4 + fq) ^ (fr & 7)) * 8); \
        bf16x8 af##ks_[4], bfv##ks_[4]; \
        _Pragma("unroll") for (int m = 0; m < 4; ++m) af##ks_[m] = *(const bf16x8*)(Ac##ks_ + m * 16 * 64); \
        _Pragma("unroll") for (int n = 0; n < 4; ++n) bfv##ks_[n] = *(const bf16x8*)(Bc##ks_ + n * 16 * 64);
#define G_MMA(ks_) __builtin_amdgcn_s_setprio(1); _Pragma("unroll") for (int m = 0; m < 4; ++m) \
        _Pragma("unroll") for (int n = 0; n < 4; ++n) acc[m][n] = __builtin_amdgcn_mfma_f32_16x16x32_bf16(bfv##ks_[n], af##ks_[m], acc[m][n], 0, 0, 0); __builtin_amdgcn_s_setprio(0);
    const int nk = K >> 6;
    G_DMA(0, 0);
    asm volatile("s_waitcnt vmcnt(0)" ::: "memory");
    __syncthreads();
    for (int kt = 0; kt < nk; ++kt) {
        const int cur = kt & 1;
        if (kt + 1 < nk) G_DMA(cur ^ 1, kt + 1);
        {
            G_FRAGS(cur, 0)
            G_MMA(0)
            G_FRAGS(cur, 1)
            G_MMA(1)
        }
        asm volatile("s_waitcnt vmcnt(0)" ::: "memory");
        __syncthreads();
    }
#undef G_DMA
#undef G_FRAGS
#undef G_MMA
    float* Ct = (float*)smem;
#pragma unroll
    for (int m = 0; m < 4; ++m)
#pragma unroll
        for (int n = 0; n < 4; ++n) *(f32x4*)(Ct + (wr * 64 + m * 16 + fr) * CP + wc * 64 + n * 16 + fq * 4) = acc[m][n];
    __syncthreads();
    epi(tm, tn, Ct);
    __syncthreads();
}

DEV f32x4 rope4(const float* Crow, int c, int o, const float* cosT, const float* sinT, int tt, f32x4 v) {
    const int sub = o >> 3, ti = (sub >> 1) * 8 + (o & 7);
    const f32x4 cs = *(const f32x4*)(cosT + tt * 16 + ti), sn = *(const f32x4*)(sinT + tt * 16 + ti);
    const f32x4 pv = *(const f32x4*)(Crow + ((sub & 1) ? c - 8 : c + 8));
    return (sub & 1) ? v * cs + pv * sn : v * cs - pv * sn;
}

DEV void store_vt(const float* Ct, int c0, bf16_t* vt_head  , int tt0, const float* rowscale) {
    for (int item = tid_(); item < 64 * 16; item += NTHR) {
        const int d = item & 63, rg = item >> 6;
        float v[8];
#pragma unroll
        for (int i = 0; i < 8; ++i) { v[i] = Ct[(rg * 8 + i) * CP + c0 + d]; if (rowscale) v[i] *= rowscale[rg * 8 + i]; }
        u32x4 w; w.x = pk2(v[0], v[1]); w.y = pk2(v[2], v[3]); w.z = pk2(v[4], v[5]); w.w = pk2(v[6], v[7]);
        *(u32x4*)(vt_head + (size_t)d * TT + tt0 + rg * 8) = w;
    }
}

DEV f32x4 rope4v(f32x4 v, f32x4 pv, f32x4 cs, f32x4 sn, int sub) { return (sub & 1) ? v * cs + pv * sn : v * cs - pv * sn; }

struct EpiIn {
    bf16_t* QK; bf16_t* ZR; bf16_t* VtNA; bf16_t* VtD; const float* cosT; const float* sinT;
    DEV void operator()(int tm, int tn, const float* Ct) const {
        const int row0 = tm * 128, bl = row0 / TT, tt0 = row0 - bl * TT; const bool lat = tt0 < SEQ;
        if (tn == 4 || tn == 5 || tn == 10 || tn == 11) {
            bf16_t* Vt = (tn < 6) ? VtNA : VtD; const int hp = (tn & 1) * 2;
            store_vt(Ct, 0, Vt + ((size_t)(bl * 4 + hp) * 64) * TT, tt0, nullptr);
            store_vt(Ct, 64, Vt + ((size_t)(bl * 4 + hp + 1) * 64) * TT, tt0, nullptr);
            return;
        }
        bf16_t* dst; int ds, dc; unsigned ropem = 0;
        if (tn < 4) { dst = QK; ds = 1024; dc = tn * 128; }
        else if (tn < 10) { dst = QK; ds = 1024; dc = 512 + (tn - 6) * 128; ropem = 0xf; }
        else { dst = ZR; ds = ZRW; dc = (tn - 12) * 128; if (tn == 21) ropem = 1; }
        if (!lat) ropem = 0;
        const int tid = tid_(), c = (tid & 31) << 2, rb = tid >> 5;
        const bool rp = (ropem >> (c >> 5)) & 1;
        const int o = c & 31, sub = o >> 3, ti = (sub >> 1) * 8 + (o & 7), pc = (sub & 1) ? c - 8 : c + 8;
        bf16_t* dp = dst + (size_t)row0 * ds + dc + c;
#pragma unroll
        for (int it0 = 0; it0 < 16; it0 += 4) {
            f32x4 cs[4], sn[4];
            if (rp) {
#pragma unroll
                for (int u = 0; u < 4; ++u) { const int r = rb + 8 * (it0 + u); cs[u] = *(const f32x4*)(cosT + (tt0 + r) * 16 + ti); sn[u] = *(const f32x4*)(sinT + (tt0 + r) * 16 + ti); }
            }
#pragma unroll
            for (int u = 0; u < 4; ++u) {
                const int r = rb + 8 * (it0 + u);
                f32x4 v = *(const f32x4*)(Ct + r * CP + c);
                if (rp) v = rope4v(v, *(const f32x4*)(Ct + r * CP + pc), cs[u], sn[u], sub);
                u32x2 w; w.x = pk2(v[0], v[1]); w.y = pk2(v[2], v[3]);
                *(u32x2*)(dp + (size_t)r * ds) = w;
            }
        }
    }
};
struct EpiUQ {
    bf16_t* MQ; const float* rs; const float* cosT; const float* sinT;
    DEV void operator()(int tm, int tn, const float* Ct) const {
        const int row0 = tm * 128, bl = row0 / TT, tt0 = row0 - bl * TT; const bool lat = tt0 < SEQ;
        const int tid = tid_(), c = (tid & 31) << 2, rb = tid >> 5, col = tn * 128 + c, hc = col % 96;
        const bool rp = lat && hc >= 64;
        const int o = rp ? hc - 64 : 0, sub = o >> 3, ti = (sub >> 1) * 8 + (o & 7), pc = (sub & 1) ? c - 8 : c + 8;
#pragma unroll
        for (int it0 = 0; it0 < 16; it0 += 4) {
            f32x4 cs[4], sn[4]; float sc[4];
#pragma unroll
            for (int u = 0; u < 4; ++u) { const int r = rb + 8 * (it0 + u); sc[u] = rs[row0 + r]; if (rp) { cs[u] = *(const f32x4*)(cosT + (tt0 + r) * 16 + ti); sn[u] = *(const f32x4*)(sinT + (tt0 + r) * 16 + ti); } }
#pragma unroll
            for (int u = 0; u < 4; ++u) {
                const int r = rb + 8 * (it0 + u);
                f32x4 v = *(const f32x4*)(Ct + r * CP + c);
                if (rp) v = rope4v(v, *(const f32x4*)(Ct + r * CP + pc), cs[u], sn[u], sub);
                v = v * sc[u];
                u32x2 w; w.x = pk2(v[0], v[1]); w.y = pk2(v[2], v[3]);
                *(u32x2*)(MQ + (size_t)(row0 + r) * 384 + col) = w;
            }
        }
    }
};
struct EpiUKV {
    bf16_t* KN; bf16_t* VtM; const float* rs;
    DEV void operator()(int tm, int tn, const float* Ct) const {
        const int row0 = tm * 128, bl = row0 / TT, tt0 = row0 - bl * TT;
        const int tid = tid_(), c = (tid & 15) << 2, rb = tid >> 4;
        float* rsl = (float*)((char*)Ct + 128 * CP * 4);
        if (tid < 128) rsl[tid] = rs[row0 + tid];
        __syncthreads();
#pragma unroll
        for (int it = 0; it < 8; ++it) {
            const int r = rb + 16 * it;
            const f32x4 v = *(const f32x4*)(Ct + r * CP + c) * rsl[r];
            u32x2 w; w.x = pk2(v[0], v[1]); w.y = pk2(v[2], v[3]);
            *(u32x2*)(KN + (size_t)(row0 + r) * 256 + tn * 64 + c) = w;
        }
        store_vt(Ct, 64, VtM + ((size_t)(bl * 4 + tn) * 64) * TT, tt0, rsl);
    }
};
struct EpiWA {
    bf16_t* SC; const float* w0; const float* a0;
    DEV void operator()(int tm, int tn, const float* Ct) const {
        const int row0 = tm * 128, seg = tn >> 1;
        const int tid = tid_(), c = (tid & 31) << 2, rb = tid >> 5, ch = (tn & 1) * 128 + c, h = ch >> 6, j = ch & 63;
        const f32x4 bias = seg < 2 ? *(const f32x4*)(w0 + seg * 256 + ch) : *(const f32x4*)(a0 + (seg - 2) * 256 + ch);
        bf16_t* dp = SC + (size_t)row0 * 2048 + h * 512 + (4 + seg) * 64 + j;
#pragma unroll 4
        for (int it = 0; it < 16; ++it) {
            const int r = rb + 8 * it;
            const f32x4 v = *(const f32x4*)(Ct + r * CP + c) + bias;
            float o[4];
#pragma unroll
            for (int i = 0; i < 4; ++i) {
                if (seg < 2) o[i] = 0.60653065971f * sigmoidf_(v[i]);
                else o[i] = sigmoidf_(v[i]);
            }
            u32x2 w; w.x = pk2(o[0], o[1]); w.y = pk2(o[2], o[3]);
            *(u32x2*)(dp + (size_t)r * 2048) = w;
        }
    }
};
struct EpiG {
    bf16_t* MIX; const bf16_t* SC; const float* Y; const float* r_k; const float* ln_w; const float* ln_b; int gbase;
    DEV void operator()(int tm, int tn, const float* Ct) const {
        const int row0 = tm * 128;
        const int tid = tid_(), l32 = tid & 31, hh = (tid >> 5) & 1, rb = tid >> 6, h = tn * 2 + hh, j = l32 * 2, ch = h * 64 + j;
        const float rk0 = r_k[ch], rk1 = r_k[ch + 1], lw0 = ln_w[ch], lw1 = ln_w[ch + 1], lb0 = ln_b[ch], lb1 = ln_b[ch + 1];
#pragma unroll
        for (int it0 = 0; it0 < 32; it0 += 4) {
            unsigned yfu[4], ybu[4]; unsigned ur[4], uv[4], uk[4];
#pragma unroll
            for (int u = 0; u < 4; ++u) {
                const size_t row = (size_t)(row0 + rb + 4 * (it0 + u));
                yfu[u] = *(const unsigned*)((const bf16_t*)Y + row * 256 + ch); ybu[u] = *(const unsigned*)((const bf16_t*)Y + ((size_t)T_ALL + row) * 256 + ch);
                const bf16_t* sc = SC + row * 2048 + h * 512 + j;
                ur[u] = *(const unsigned*)(sc); uv[u] = *(const unsigned*)(sc + 64); uk[u] = *(const unsigned*)(sc + 128);
            }
#pragma unroll
            for (int u = 0; u < 4; ++u) {
                const int r = rb + 4 * (it0 + u);
                const float y0 = lo_bf(yfu[u]) + lo_bf(ybu[u]), y1 = hi_bf(yfu[u]) + hi_bf(ybu[u]);
                const float mean = sum32(y0 + y1) * (1.f / 64.f);
                const float d0 = y0 - mean, d1 = y1 - mean;
                const float var = sum32(d0 * d0 + d1 * d1) * (1.f / 64.f);
                const float rstd = rsqrtf(var + 64e-5f);
                const float rk = sum32(lo_bf(ur[u]) * lo_bf(uk[u]) * rk0 + hi_bf(ur[u]) * hi_bf(uk[u]) * rk1);
                const float g0 = Ct[r * CP + hh * 64 + j], g1 = Ct[r * CP + hh * 64 + j + 1];
                const float o0 = (d0 * rstd * lw0 + lb0 + rk * lo_bf(uv[u])) * g0;
                const float o1 = (d1 * rstd * lw1 + lb1 + rk * hi_bf(uv[u])) * g1;
                *(unsigned*)(MIX + (size_t)(row0 + r) * 1024 + 512 + ch) = pk2(o0, o1);
            }
        }
    }
};
struct EpiRes {
    const Params* p; const float* mod; int goff; int from_in;
    DEV void operator()(int tm, int tn, const float* Ct) const {
        const int row0 = tm * 128, b = row0 / TT, tt0 = row0 - b * TT;
        const int tid = tid_(), c = (tid & 31) << 2, rb = tid >> 5;
        const f32x4 g = *(const f32x4*)(mod + (size_t)(tt0 < SEQ ? b : 32) * 6144 + goff + tn * 128 + c);
        float* x0 = xrow(*p, row0) + tn * 128 + c;
        const float* xs = from_in ? xrow_in(*p, row0) + tn * 128 + c : x0;
#pragma unroll
        for (int it0 = 0; it0 < 16; it0 += 8) {
            f32x4 xv[8];
#pragma unroll
            for (int u = 0; u < 8; ++u) xv[u] = *(const f32x4*)(xs + (size_t)(rb + 8 * (it0 + u)) * D);
#pragma unroll
            for (int u = 0; u < 8; ++u) { const int r = rb + 8 * (it0 + u); *(f32x4*)(x0 + (size_t)r * D) = xv[u] + g * *(const f32x4*)(Ct + r * CP + c); }
        }
    }
};
struct EpiUp {
    bf16_t* G; float* E; const float* cw; const float* cb;
    DEV void operator()(int tm, int tn, const float* Ct) const {
        const int row0 = tm * 128, tt0 = row0 % TT;
        const bool first = (tt0 == 0 || tt0 == SEQ), last = (tt0 + 127 == SEQ - 1 || tt0 + 127 == TT - 1);
        const int tid = tid_(), c = (tid & 15) << 2, rb = tid >> 4, j = tn * 64 + c;
        const f32x4 w0 = *(const f32x4*)(cw + j), w1 = *(const f32x4*)(cw + DFF + j), w2 = *(const f32x4*)(cw + 2 * DFF + j), bb = *(const f32x4*)(cb + j);
        const f32x4 z = (f32x4){0.f, 0.f, 0.f, 0.f};
#pragma unroll 2
        for (int it = 0; it < 8; ++it) {
            const int r = rb + 16 * it;
            const f32x4 ac = *(const f32x4*)(Ct + r * CP + c);
            const f32x4 ap = r > 0 ? *(const f32x4*)(Ct + (r - 1) * CP + c) : z;
            const f32x4 an = r < 127 ? *(const f32x4*)(Ct + (r + 1) * CP + c) : z;
            const f32x4 bv = *(const f32x4*)(Ct + r * CP + 64 + c);
            const f32x4 pre = w0 * ap + w1 * ac + w2 * an + bb;
            if ((r == 0 && !first) || (r == 127 && !last)) {
                float* e = E + ((size_t)tm * 6 + (r == 0 ? 0 : 3)) * DFF + j;
                *(f32x4*)(e) = pre; *(f32x4*)(e + DFF) = bv; *(f32x4*)(e + 2 * DFF) = ac;
            } else {
                u32x2 w; w.x = pk2(siluf_(pre[0]) * bv[0], siluf_(pre[1]) * bv[1]); w.y = pk2(siluf_(pre[2]) * bv[2], siluf_(pre[3]) * bv[3]);
                *(u32x2*)(G + (size_t)(row0 + r) * DFF + j) = w;
            }
        }
    }
};

template <class Epi>
DEV void gemm_phase(const bf16_t* A, int lda, const bf16_t* Bt, int ldb, int K, int ntm, int ntn, bool skip_ctx, char* smem, const Epi& epi) {
    if ((gridDim.x & 7) == 0 && (ntm & 7) == 0) {
        const int xcd = blockIdx.x & 7, slot = blockIdx.x >> 3, nper = gridDim.x >> 3, R = ntm >> 3, per = R * ntn;
        const int nfb = ntn >> 3, fullq = nfb * R * 8, w = ntn - nfb * 8;
        for (int q = slot; q < per; q += nper) {
            int tm, tn;
            if (q < fullq) { const int tb = q / (R * 8), r = q - tb * (R * 8); tm = r >> 3; tn = tb * 8 + (r & 7); }
            else { const int q2 = q - fullq; tm = q2 / w; tn = nfb * 8 + (q2 - tm * w); }
            tm += xcd * R;
            if (skip_ctx && ((tm * 128) % TT) >= SEQ) continue;
            gemm_tile(A, lda, Bt, ldb, K, tm, tn, smem, epi);
        }
        return;
    }
    const int total = ntm * ntn;
    for (int t = blockIdx.x; t < total; t += gridDim.x) {
        const int tm = t / ntn, tn = t - tm * ntn;
        if (skip_ctx && ((tm * 128) % TT) >= SEQ) continue;
        gemm_tile(A, lda, Bt, ldb, K, tm, tn, smem, epi);
    }
}

struct AttnArgs {
    const bf16_t* Q; int qs;
    const bf16_t* K; int ks;
    const bf16_t* K2; int k2s;
    const bf16_t* Vt;
    bf16_t* O; int os;
    int nkt; int kstart;
    float sc2;
    int na_r, na_rs; const float* rpb;
    float lam, oscale; const float* subln;
};

DEV unsigned cvt_pk_bf16(float lo, float hi) { return pk2(lo, hi); }
DEV float red_rows_sum(float p) {
    float a = p, b = p;
    asm volatile("s_nop 1\n\tv_permlane16_swap_b32 %0, %1" : "+v"(a), "+v"(b));
    const float q = a + b; a = q; b = q;
    asm volatile("s_nop 1\n\tv_permlane32_swap_b32 %0, %1" : "+v"(a), "+v"(b));
    return a + b;
}
DEV float vmax2(float a, float b) { float r; asm("v_max_f32 %0, %1, %2" : "=v"(r) : "v"(a), "v"(b)); return r; }
DEV float vmax3(float a, float b, float c) { float r; asm("v_max3_f32 %0, %1, %2, %3" : "=v"(r) : "v"(a), "v"(b), "v"(c)); return r; }
DEV float wave_sum_fast(float v) { return red_rows_sum(sum16(v)); }
DEV float red_rows_max(float p) {
    float a = p, b = p;
    asm volatile("s_nop 1\n\tv_permlane16_swap_b32 %0, %1" : "+v"(a), "+v"(b));
    const float q = fmaxf(a, b); a = q; b = q;
    asm volatile("s_nop 1\n\tv_permlane32_swap_b32 %0, %1" : "+v"(a), "+v"(b));
    return fmaxf(a, b);
}
template <int DQK, int NSUB, int MQ, bool NA>
DEV void attn_item(const AttnArgs& a, char* smem) {
    constexpr int KP = DQK + 8, KS = DQK / 32 / NSUB, KCH = DQK / 8, QR = 16 * MQ;
    const int tid = tid_(), lane = tid & 63, wid = tid >> 6, fr = lane & 15, fq = lane >> 4;
    bf16_t* Ksm = (bf16_t*)smem;
    bf16_t* Vsm = Ksm + 2 * 64 * KP;
    float* rpbs = (float*)(Vsm + 2 * 64 * GP);
    if (NA) { for (int i = tid; i < 465; i += NTHR) rpbs[i] = a.rpb[i] * 1.44269504f; }
    const int na_nlo = NA ? (max(16 * wid - 8, 0) >> 4) : 0, na_nhi = NA ? (min(16 * wid + 22, 63) >> 4) : 3;
    bf16x8 qf[MQ][DQK / 32];
#pragma unroll
    for (int mq = 0; mq < MQ; ++mq)
#pragma unroll
        for (int k = 0; k < DQK / 32; ++k) qf[mq][k] = *(const bf16x8*)(a.Q + (size_t)(wid * QR + mq * 16 + fr) * a.qs + k * 32 + fq * 8);
    f32x4 o[NSUB][MQ][4];
    float mrow[NSUB][MQ], lrow[NSUB][MQ];
#pragma unroll
    for (int sb = 0; sb < NSUB; ++sb)
#pragma unroll
        for (int mq = 0; mq < MQ; ++mq) {
            mrow[sb][mq] = -1e30f; lrow[sb][mq] = 0.f;
#pragma unroll
            for (int n = 0; n < 4; ++n) o[sb][mq][n] = (f32x4){0.f, 0.f, 0.f, 0.f};
        }
    constexpr int NKC = (64 * KCH + NTHR - 1) / NTHR;
    u32x4 rk[NKC], rv[2];
#define ATT_TSTART(kt) (NA ? ((kt) < 8 ? (a.na_rs + (kt)) * 64 : SEQ + ((kt) - 8) * 64) : a.kstart + (kt) * 64)
#define ATT_GLOAD(kt) do { const int _t0 = ATT_TSTART(kt); \
        _Pragma("unroll") for (int _i = 0; _i < NKC; ++_i) { const int _q = tid + _i * NTHR; if (_q < 64 * KCH) { const int _r = _q / KCH, _c = _q - _r * KCH; \
            rk[_i] = (_c < 8 || DQK == 64) ? *(const u32x4*)(a.K + (size_t)(_t0 + _r) * a.ks + _c * 8) : *(const u32x4*)(a.K2 + (size_t)(_t0 + _r) * a.k2s + (_c - 8) * 8); } } \
        _Pragma("unroll") for (int _i = 0; _i < 2; ++_i) { const int _q = tid + _i * NTHR, _r = _q >> 3, _c = _q & 7; rv[_i] = *(const u32x4*)(a.Vt + (size_t)_r * TT + _t0 + _c * 8); } } while (0)
#define ATT_LSTORE(buf) do { \
        _Pragma("unroll") for (int _i = 0; _i < NKC; ++_i) { const int _q = tid + _i * NTHR; if (_q < 64 * KCH) { const int _r = _q / KCH, _c = _q - _r * KCH; *(u32x4*)(Ksm + ((buf) * 64 + _r) * KP + _c * 8) = rk[_i]; } } \
        _Pragma("unroll") for (int _i = 0; _i < 2; ++_i) { const int _q = tid + _i * NTHR, _r = _q >> 3, _c = _q & 7; *(u32x4*)(Vsm + ((buf) * 64 + _r) * GP + _c * 8) = rv[_i]; } } while (0)
    ATT_GLOAD(0); ATT_LSTORE(0);
    __syncthreads();
    for (int kt = 0; kt < a.nkt; ++kt) {
        const int cur = kt & 1; const bool more = kt + 1 < a.nkt;
        if (more) ATT_GLOAD(kt + 1);
        const bool natile = NA && kt < 8;
        bf16x8 pb[NSUB][MQ][2];
#pragma unroll
        for (int sb = 0; sb < NSUB; ++sb) {
            f32x4 s[MQ][4];
#pragma unroll
            for (int k = 0; k < KS; ++k) {
                bf16x8 kb[4];
#pragma unroll
                for (int n = 0; n < 4; ++n) kb[n] = *(const bf16x8*)(Ksm + (cur * 64 + n * 16 + fr) * KP + (sb * KS + k) * 32 + fq * 8);
#pragma unroll
                for (int mq = 0; mq < MQ; ++mq)
#pragma unroll
                    for (int n = 0; n < 4; ++n) {
                        if (!natile || (n >= na_nlo && n <= na_nhi)) s[mq][n] = __builtin_amdgcn_mfma_f32_16x16x32_bf16(kb[n], qf[mq][sb * KS + k], k == 0 ? (f32x4){0.f, 0.f, 0.f, 0.f} : s[mq][n], 0, 0, 0);
                        else if (k == 0) s[mq][n] = (f32x4){0.f, 0.f, 0.f, 0.f};
                    }
            }
#pragma unroll
            for (int mq = 0; mq < MQ; ++mq) {
                float mx = -1e30f;
                if (natile) {
                    const int qc = wid * 16 + fr, cst = min(max(qc - 8, 0), 48), ro = a.na_rs + kt - a.na_r + 7;
                    const float* rrow = rpbs + ro * 31 + 15 - qc + fq * 4;
#pragma unroll
                    for (int n = 0; n < 4; ++n) {
                        if (n >= na_nlo && n <= na_nhi) {
#pragma unroll
                            for (int j = 0; j < 4; ++j) {
                                const int kc = n * 16 + fq * 4 + j;
                                const float x = (kc >= cst && kc < cst + 16) ? s[mq][n][j] * a.sc2 + rrow[n * 16 + j] : -1e30f;
                                s[mq][n][j] = x; mx = fmaxf(mx, x);
                            }
                        } else s[mq][n] = (f32x4){-1e30f, -1e30f, -1e30f, -1e30f};
                    }
                } else {
#pragma unroll
                    for (int n = 0; n < 4; ++n) { s[mq][n] = s[mq][n] * a.sc2; mx = fmaxf(fmaxf(mx, fmaxf(s[mq][n][0], s[mq][n][1])), fmaxf(s[mq][n][2], s[mq][n][3])); }
                }
                mx = red_rows_max(mx);
                const float mo = mrow[sb][mq], mn = fmaxf(mo, mx);
                const bool grow = __builtin_amdgcn_ballot_w64(mn > mo) != 0;
                mrow[sb][mq] = mn;
                float rsum = 0.f;
#pragma unroll
                for (int n = 0; n < 4; ++n) {
                    if (!natile || (n >= na_nlo && n <= na_nhi)) {
#pragma unroll
                        for (int j = 0; j < 4; ++j) { const float pv = __builtin_amdgcn_exp2f(s[mq][n][j] - mn); s[mq][n][j] = pv; rsum += pv; }
                    } else s[mq][n] = (f32x4){0.f, 0.f, 0.f, 0.f};
                }
                if (grow) {
                    const float alpha = __builtin_amdgcn_exp2f(mo - mn);
                    lrow[sb][mq] *= alpha;
#pragma unroll
                    for (int n = 0; n < 4; ++n) o[sb][mq][n] *= alpha;
                }
                lrow[sb][mq] += rsum;
#pragma unroll
                for (int k2 = 0; k2 < 2; ++k2) {
                    u32x4 w;
                    w.x = cvt_pk_bf16(s[mq][2 * k2][0], s[mq][2 * k2][1]); w.y = cvt_pk_bf16(s[mq][2 * k2][2], s[mq][2 * k2][3]);
                    w.z = cvt_pk_bf16(s[mq][2 * k2 + 1][0], s[mq][2 * k2 + 1][1]); w.w = cvt_pk_bf16(s[mq][2 * k2 + 1][2], s[mq][2 * k2 + 1][3]);
                    pb[sb][mq][k2] = __builtin_bit_cast(bf16x8, w);
                }
            }
        }
#pragma unroll
        for (int k2 = 0; k2 < 2; ++k2) {
            if (natile && (2 * k2 + 1 < na_nlo || 2 * k2 > na_nhi)) continue;
            bf16x8 va[4];
#pragma unroll
            for (int n = 0; n < 4; ++n) {
                const bf16_t* vp = Vsm + (cur * 64 + n * 16 + fr) * GP + 32 * k2 + fq * 4;
                u32x4 w; const u32x2 lo = *(const u32x2*)(vp), hi = *(const u32x2*)(vp + 16);
                w.x = lo.x; w.y = lo.y; w.z = hi.x; w.w = hi.y;
                va[n] = __builtin_bit_cast(bf16x8, w);
            }
#pragma unroll
            for (int sb = 0; sb < NSUB; ++sb)
#pragma unroll
                for (int mq = 0; mq < MQ; ++mq)
#pragma unroll
                    for (int n = 0; n < 4; ++n) o[sb][mq][n] = __builtin_amdgcn_mfma_f32_16x16x32_bf16(va[n], pb[sb][mq][k2], o[sb][mq][n], 0, 0, 0);
        }
        if (more) ATT_LSTORE(cur ^ 1);
        __syncthreads();
    }
#undef ATT_GLOAD
#undef ATT_LSTORE
#undef ATT_TSTART
#pragma unroll
    for (int mq = 0; mq < MQ; ++mq) {
        f32x4 v[4];
        if (NSUB == 1) {
            const float il = 1.f / red_rows_sum(lrow[0][mq]);
#pragma unroll
            for (int n = 0; n < 4; ++n) v[n] = o[0][mq][n] * il;
        } else {
            const float il0 = 1.f / red_rows_sum(lrow[0][mq]), il1 = a.lam / red_rows_sum(lrow[NSUB - 1][mq]);
            float ss = 0.f;
#pragma unroll
            for (int n = 0; n < 4; ++n) { v[n] = o[0][mq][n] * il0 - o[NSUB - 1][mq][n] * il1; ss += v[n][0] * v[n][0] + v[n][1] * v[n][1] + v[n][2] * v[n][2] + v[n][3] * v[n][3]; }
            ss = red_rows_sum(ss);
            const float rstd = rsqrtf(ss * (1.f / 64.f) + 1e-5f) * a.oscale;
#pragma unroll
            for (int n = 0; n < 4; ++n) v[n] = v[n] * rstd * *(const f32x4*)(a.subln + n * 16 + fq * 4);
        }
        bf16_t* op = a.O + (size_t)(wid * QR + mq * 16 + fr) * a.os + fq * 4;
#pragma unroll
        for (int n = 0; n < 4; ++n) { u32x2 w; w.x = cvt_pk_bf16(v[n][0], v[n][1]); w.y = cvt_pk_bf16(v[n][2], v[n][3]); *(u32x2*)(op + n * 16) = w; }
    }
    __syncthreads();
}

template <int N> DEV float rbc(float x) { return __builtin_bit_cast(float, __builtin_amdgcn_update_dpp(0, __builtin_bit_cast(int, x), 0x150 + N, 0xf, 0xf, true)); }
DEV float red_rows(float p) { return red_rows_sum(p); }
#define REP16(M) M(0) M(1) M(2) M(3) M(4) M(5) M(6) M(7) M(8) M(9) M(10) M(11) M(12) M(13) M(14) M(15)
DEV void scan_item(const bf16_t* SC, float* Y, int bl, int h, int dir, const float* k_a, char* smem) {
    const int tid = tid_(), lane = tid & 63, w = tid >> 6, ch = lane, sq = w;
    float* stg = (float*)smem;
    float* yb = stg + 2 * 16 * 6 * 64;
    const float ka = k_a[h * 64 + ch];
    unsigned short pre[4][6];
    float S[16];
#pragma unroll
    for (int j = 0; j < 16; ++j) S[j] = 0.f;
#define SC_TT(s) (dir == 0 ? ((s) < CTXL ? SEQ + (s) : (s) - CTXL) : ((s) < CTXL ? TT - 1 - (s) : SEQ - 1 - ((s) - CTXL)))
#define SC_GL(chunk) do { _Pragma("unroll") for (int _i = 0; _i < 4; ++_i) { const int _s = (chunk) * 16 + sq + 4 * _i; const int _tt = SC_TT(_s); \
        const bf16_t* _b = SC + ((size_t)(bl * TT + _tt)) * 2048 + h * 512 + ch; \
        pre[_i][0] = _b[0]; pre[_i][1] = _b[64]; pre[_i][2] = _b[128]; pre[_i][3] = _b[192]; pre[_i][4] = _b[(4 + dir) * 64]; pre[_i][5] = _b[(6 + dir) * 64]; } } while (0)
#define SC_ST(buf) do { _Pragma("unroll") for (int _i = 0; _i < 4; ++_i) { const int _st = sq + 4 * _i; \
        const float _r = bf2f(pre[_i][0]), _v = bf2f(pre[_i][1]), _k = bf2f(pre[_i][2]), _kk = bf2f(pre[_i][3]), _e = bf2f(pre[_i][4]), _sg = bf2f(pre[_i][5]); \
        float* _d = stg + (((buf) * 16 + _st) * 6) * 64 + ch; \
        _d[0] = -_kk; _d[64] = __expf(-_e); _d[128] = _kk * _sg; _d[192] = _k * (1.f + (_sg - 1.f) * ka); _d[256] = _r; _d[320] = _v; } } while (0)
    SC_GL(0); SC_ST(0);
    __syncthreads();
    constexpr int NCH = TT / 16;
    const int vrow = w * 16 + (lane & 15);
#define FMAC_BC(acc, x, sv, n) asm("v_fmac_f32_dpp %0, %1, %2 row_newbcast:" #n " row_mask:0xf bank_mask:0xf" : "+v"(acc) : "v"(x), "v"(sv))
#define MUL_BC(dst, x, sv, n) asm("v_mul_f32_dpp %0, %1, %2 row_newbcast:" #n " row_mask:0xf bank_mask:0xf" : "=v"(dst) : "v"(x), "v"(sv))
#define SC_LOAD(st_, A, W, B, K, R, V) do { const float* _dn = d0 + (st_) * 384; A = _dn[lane]; W = _dn[64 + lane]; B = _dn[128 + lane]; K = _dn[192 + lane]; R = _dn[256 + lane]; V = _dn[320 + vrow]; } while (0)
#define SA_(n) if ((n) & 1) FMAC_BC(p1, cA, S[n], n); else FMAC_BC(p0, cA, S[n], n);
#define UP_(n) { float t; MUL_BC(t, cW, S[n], n); FMAC_BC(t, cB, sa, n); FMAC_BC(t, cK, cV, n); S[n] = t; if ((n) & 1) FMAC_BC(y1, cR, t, n); else FMAC_BC(y0, cR, t, n); }
#define SC_STEP(st_, cA, cW, cB, cK, cR, cV) do { float p0 = 0.f, p1 = 0.f; REP16(SA_) const float sa = red_rows(p0 + p1); float y0 = 0.f, y1 = 0.f; REP16(UP_) \
        yb[((st_) * 4 + (lane >> 4)) * 64 + vrow] = y0 + y1; } while (0)
    for (int chunk = 0; chunk < NCH; ++chunk) {
        const int buf = chunk & 1;
        if (chunk + 1 < NCH) SC_GL(chunk + 1);
        const float* d0 = stg + (buf * 16 * 6) * 64;
        float a0, w0, b0, k0, r0, v0, a1, w1, b1, k1, r1, v1;
        SC_LOAD(0, a0, w0, b0, k0, r0, v0);
#pragma unroll 2
        for (int st = 0; st < 16; st += 2) {
            SC_LOAD(st + 1, a1, w1, b1, k1, r1, v1);
#define cA a0
#define cW w0
#define cB b0
#define cK k0
#define cR r0
#define cV v0
            SC_STEP(st, a0, w0, b0, k0, r0, v0);
#undef cA
#undef cW
#undef cB
#undef cK
#undef cR
#undef cV
            if (st + 2 < 16) SC_LOAD(st + 2, a0, w0, b0, k0, r0, v0);
#define cA a1
#define cW w1
#define cB b1
#define cK k1
#define cR r1
#define cV v1
            SC_STEP(st + 1, a1, w1, b1, k1, r1, v1);
#undef cA
#undef cW
#undef cB
#undef cK
#undef cR
#undef cV
        }
        __syncthreads();
#pragma unroll
        for (int i = 0; i < 4; ++i) {
            const int st = sq + 4 * i, s_ = chunk * 16 + st, tt = SC_TT(s_);
            ((bf16_t*)Y)[((size_t)dir * T_ALL + (size_t)bl * TT + tt) * 256 + h * 64 + ch] = f2bf((yb[(st * 4) * 64 + ch] + yb[(st * 4 + 1) * 64 + ch]) + (yb[(st * 4 + 2) * 64 + ch] + yb[(st * 4 + 3) * 64 + ch]));
        }
        if (chunk + 1 < NCH) SC_ST(buf ^ 1);
        __syncthreads();
    }
#undef SC_TT
#undef SC_GL
#undef SC_ST
#undef FMAC_BC
#undef MUL_BC
#undef SC_LOAD
#undef SA_
#undef UP_
#undef SC_STEP
}

DEV void phase_norm(const Params& p, int l, int which, bool skip_ctx) {
    const float* gam = p.in[which ? 5 : 4] + l * D;
    const float* mod = (const float*)(p.ws + OFF_MOD) + (size_t)l * 33 * 6144;
    bf16_t* H = (bf16_t*)(p.ws + OFF_H);
    const int lane = tid_() & 63, wave = blockIdx.x * 4 + (tid_() >> 6), nw = gridDim.x * 4;
    for (int g0 = wave; g0 < T_ALL; g0 += 2 * nw) {
        f32x4 v[2][4]; const float* m[2]; bool act[2];
#pragma unroll
        for (int u = 0; u < 2; ++u) {
            const int g = g0 + u * nw; act[u] = g < T_ALL;
            const int gg = act[u] ? g : g0;
            const int b = gg / TT, tt = gg - b * TT; const bool lat = tt < SEQ;
            if (!lat && skip_ctx) act[u] = false;
            const float* x = (l == 0 && which == 0) ? xrow_in(p, gg) : xrow(p, gg);
            m[u] = mod + (size_t)(lat ? b : 32) * 6144 + (which ? 3072 : 0);
#pragma unroll
            for (int i = 0; i < 4; ++i) v[u][i] = *(const f32x4*)(x + i * 256 + lane * 4);
        }
#pragma unroll
        for (int u = 0; u < 2; ++u) {
            float ss = 0.f;
#pragma unroll
            for (int i = 0; i < 4; ++i) ss += v[u][i][0] * v[u][i][0] + v[u][i][1] * v[u][i][1] + v[u][i][2] * v[u][i][2] + v[u][i][3] * v[u][i][3];
            ss = wave_sum_fast(ss);
            const float rstd = rsqrtf(ss * (1.f / 1024.f) + 1e-6f);
            if (act[u]) {
                const int g = g0 + u * nw;
#pragma unroll
                for (int i = 0; i < 4; ++i) {
                    const int col = i * 256 + lane * 4;
                    const f32x4 g4 = *(const f32x4*)(gam + col), sh = *(const f32x4*)(m[u] + col), sc = *(const f32x4*)(m[u] + 1024 + col);
                    const f32x4 o = v[u][i] * rstd * g4 * (sc + 1.f) + sh;
                    u32x2 w; w.x = pk2(o[0], o[1]); w.y = pk2(o[2], o[3]);
                    *(u32x2*)(H + (size_t)g * 1024 + col) = w;
                }
            }
        }
    }
}

DEV void phase_final(const Params& p) {
    const float* gam = p.in[32];
    const int lane = tid_() & 63, wave = blockIdx.x * 4 + (tid_() >> 6), nw = gridDim.x * 4;
    for (int g = wave; g < NBATCH * SEQ; g += nw) {
        float* x = p.out + (size_t)g * D;
        f32x4 v[4]; float ss = 0.f;
#pragma unroll
        for (int i = 0; i < 4; ++i) { v[i] = *(const f32x4*)(x + i * 256 + lane * 4); ss += v[i][0] * v[i][0] + v[i][1] * v[i][1] + v[i][2] * v[i][2] + v[i][3] * v[i][3]; }
        ss = wave_sum(ss);
        const float rstd = rsqrtf(ss * (1.f / 1024.f) + 1e-6f);
#pragma unroll
        for (int i = 0; i < 4; ++i) { const int col = i * 256 + lane * 4; *(f32x4*)(x + col) = v[i] * rstd * *(const f32x4*)(gam + col); }
    }
}

DEV void phase_prep(const Params& p, int l, int c) {
    char* scr = p.ws + OFF_SCR;
    const bf16_t* ZR = (const bf16_t*)(scr + SO_ZR);
    bf16_t* SC = (bf16_t*)(scr + SO_SC) + (size_t)c * TC * 2048; bf16_t* AWA = (bf16_t*)(scr + SO_AWA); bf16_t* AG = (bf16_t*)(scr + SO_AG) + (size_t)c * TC * 64;
    float* rsq = (float*)(p.ws + OFF_RSQ); float* rskv = (float*)(p.ws + OFF_RSKV);
    const float* mu0 = p.in[15] + (size_t)l * 2 * 896; const float* mu1 = mu0 + 896;
    const int lane = tid_() & 63, wave = blockIdx.x * 4 + (tid_() >> 6), nw = gridDim.x * 4;
    f32x4 m0[3], m1[3];
#pragma unroll
    for (int s3 = 0; s3 < 3; ++s3) { m0[s3] = *(const f32x4*)(mu0 + s3 * 256 + lane * 4); m1[s3] = *(const f32x4*)(mu1 + s3 * 256 + lane * 4); }
    const f32x4 kk4 = *(const f32x4*)(p.in[21] + l * 256 + lane * 4);
    const float mw0 = mu0[768 + lane], mw1 = mu1[768 + lane], mg0 = mu0[832 + lane], mg1 = mu1[832 + lane];
    for (int t0 = wave; t0 < TC; t0 += 2 * nw) {
        u32x2 q[2], c0[2][3], cp[2][3], cn[2][3]; unsigned kv[2]; bf16_t wz[2][3], gz[2][3]; bool act[2], hp[2], hn[2];
#pragma unroll
        for (int u = 0; u < 2; ++u) {
            const int t = t0 + u * nw; act[u] = t < TC;
            const int ts = act[u] ? t : t0, tt = ts % TT;
            hp[u] = !(tt == 0 || tt == SEQ); hn[u] = !(tt == SEQ - 1 || tt == TT - 1);
            const bf16_t* z = ZR + (size_t)ts * ZRW;
            const bf16_t* zp = hp[u] ? z - ZRW : z; const bf16_t* zn = hn[u] ? z + ZRW : z;
            q[u] = *(const u32x2*)(z + 768 + lane * 4); kv[u] = *(const unsigned*)(z + 1024 + lane * 2);
#pragma unroll
            for (int s3 = 0; s3 < 3; ++s3) { const int col = s3 * 256 + lane * 4; c0[u][s3] = *(const u32x2*)(z + col); cp[u][s3] = *(const u32x2*)(zp + col); cn[u][s3] = *(const u32x2*)(zn + col); }
            wz[u][0] = z[1184 + lane]; wz[u][1] = zp[1184 + lane]; wz[u][2] = zn[1184 + lane];
            gz[u][0] = z[1280 + lane]; gz[u][1] = zp[1280 + lane]; gz[u][2] = zn[1280 + lane];
        }
#pragma unroll
        for (int u = 0; u < 2; ++u) {
            const int t = t0 + u * nw;
            const float fp = hp[u] ? 1.f : 0.f, fn = hn[u] ? 1.f : 0.f;
            float s = lo_bf(q[u].x) * lo_bf(q[u].x) + hi_bf(q[u].x) * hi_bf(q[u].x) + lo_bf(q[u].y) * lo_bf(q[u].y) + hi_bf(q[u].y) * hi_bf(q[u].y);
            s = wave_sum_fast(s);
            float s2 = lo_bf(kv[u]) * lo_bf(kv[u]) + hi_bf(kv[u]) * hi_bf(kv[u]);
            s2 = wave_sum_fast(s2);
            float zs[3][4];
#pragma unroll
            for (int s3 = 0; s3 < 3; ++s3) {
                const float zc[4] = {lo_bf(c0[u][s3].x), hi_bf(c0[u][s3].x), lo_bf(c0[u][s3].y), hi_bf(c0[u][s3].y)};
                const float zp[4] = {lo_bf(cp[u][s3].x) * fp, hi_bf(cp[u][s3].x) * fp, lo_bf(cp[u][s3].y) * fp, hi_bf(cp[u][s3].y) * fp};
                const float zn[4] = {lo_bf(cn[u][s3].x) * fn, hi_bf(cn[u][s3].x) * fn, lo_bf(cn[u][s3].y) * fn, hi_bf(cn[u][s3].y) * fn};
#pragma unroll
                for (int i = 0; i < 4; ++i) zs[s3][i] = zc[i] + m0[s3][i] * (zp[i] - zc[i]) + m1[s3][i] * (zn[i] - zc[i]);
            }
            float kk[4]; float ss = 0.f;
#pragma unroll
            for (int i = 0; i < 4; ++i) { kk[i] = zs[1][i] * kk4[i]; ss += kk[i] * kk[i]; }
            ss = sum16(ss);
            const float inv = rsqrtf(fmaxf(ss, 1e-24f));
            float vw, vg;
            { const float zc = bf2f(wz[u][0]), zp = bf2f(wz[u][1]) * fp, zn = bf2f(wz[u][2]) * fn; vw = zc + mw0 * (zp - zc) + mw1 * (zn - zc); }
            { const float zc = bf2f(gz[u][0]), zp = bf2f(gz[u][1]) * fp, zn = bf2f(gz[u][2]) * fn; vg = zc + mg0 * (zp - zc) + mg1 * (zn - zc); }
            if (act[u]) {
                if (lane == 0) { rsq[t] = rsqrtf(s * (1.f / 256.f) + 1e-6f); rskv[t] = rsqrtf(s2 * (1.f / 128.f) + 1e-6f); }
                const int h = lane >> 4, j = (lane & 15) * 4;
                bf16_t* sc = SC + (size_t)t * 2048 + h * 512 + j;
                u32x2 w;
                w.x = pk2(zs[0][0], zs[0][1]); w.y = pk2(zs[0][2], zs[0][3]); *(u32x2*)(sc) = w;
                w.x = pk2(zs[2][0], zs[2][1]); w.y = pk2(zs[2][2], zs[2][3]); *(u32x2*)(sc + 64) = w;
                w.x = pk2(zs[1][0], zs[1][1]); w.y = pk2(zs[1][2], zs[1][3]); *(u32x2*)(sc + 128) = w;
                w.x = pk2(kk[0] * inv, kk[1] * inv); w.y = pk2(kk[2] * inv, kk[3] * inv); *(u32x2*)(sc + 192) = w;
                AWA[(size_t)t * 64 + lane] = f2bf(lane < 32 ? 2.f * sigmoidf_(2.f * vw) - 1.f : vw);
                AG[(size_t)t * 64 + lane] = f2bf(sigmoidf_(vg));
            }
        }
    }
}

DEV void phase_gemm_small(const Params& p, int l, int c, char* smem) {
    char* scr = p.ws + OFF_SCR;
    const bf16_t* ZR = (const bf16_t*)(scr + SO_ZR);
    const float* cosT = (const float*)(p.ws + OFF_COS); const float* sinT = (const float*)(p.ws + OFF_SIN);
    EpiUQ euq{(bf16_t*)(scr + SO_MQ), (const float*)(p.ws + OFF_RSQ), cosT, sinT};
    EpiUKV eukv{(bf16_t*)(scr + SO_KN), (bf16_t*)(scr + SO_VTM), (const float*)(p.ws + OFF_RSKV)};
    EpiWA ewa{(bf16_t*)(scr + SO_SC) + (size_t)c * TC * 2048, p.in[16] + (size_t)l * 512, p.in[18] + (size_t)l * 512};
    constexpr int NTM = TC / 128;
    constexpr int T1 = NTM * 3, T2 = T1 + NTM * 4, T3 = T2 + NTM * 8;
    for (int t = blockIdx.x; t < T3; t += gridDim.x) {
        if (t < T1) { const int tm = t / 3, tn = t - tm * 3; gemm_tile(ZR + 768, ZRW, wl(p, l, WE_UQ), 256, 256, tm, tn, smem, euq); }
        else if (t < T2) { const int u = t - T1, tm = u >> 2, tn = u & 3; gemm_tile(ZR + 1024, ZRW, wl(p, l, WE_UKV), 128, 128, tm, tn, smem, eukv); }
        else { const int u = t - T2, tm = u >> 3, tn = u & 7; gemm_tile((const bf16_t*)(scr + SO_AWA), 64, wl(p, l, WE_WA), 64, 64, tm, tn, smem, ewa); }
    }
}

DEV void phase_mix(const Params& p, int l, int c, int phase_idx, char* smem, int rmask, int* s_item) {
    char* scr = p.ws + OFF_SCR;
    const bf16_t* QK = (const bf16_t*)(scr + SO_QK); const bf16_t* ZR = (const bf16_t*)(scr + SO_ZR);
    const bf16_t* MQ = (const bf16_t*)(scr + SO_MQ); const bf16_t* KN = (const bf16_t*)(scr + SO_KN);
    const bf16_t* VtNA = (const bf16_t*)(scr + SO_VTNA); const bf16_t* VtD = (const bf16_t*)(scr + SO_VTD); const bf16_t* VtM = (const bf16_t*)(scr + SO_VTM);
    bf16_t* MIX = (bf16_t*)(p.ws + OFF_H) + (size_t)c * TC * 1024;
    int* ctr = (int*)(p.ws + OFF_CTR) + phase_idx;
    const bool need_ctx = l < DEPTH - 1;
    const float lam = ((const float*)(p.ws + OFF_LAM))[l];
    const float lam_init = 0.8f - 0.6f * expf(-0.3f * (float)l);
    constexpr int DQ = 64 * DMQ, DLT = SEQ / DQ, DCT = CTXL / DQ;
    const int N_SCAN = (c == NCHUNK - 1) ? NBATCH * 8 : 0; constexpr int N_ML = CB * 64, N_DL = CB * 4 * DLT, N_NL = CB * 128, N_MC = CB * 8, N_DC = CB * 4 * DCT, N_NC = CB * 16;
    const int E0 = N_SCAN, E1 = E0 + N_ML, E2 = E1 + N_DL, E3 = E2 + N_NL, E4 = E3 + N_MC, E5 = E4 + N_DC, E6 = E5 + N_NC;
    const int total = need_ctx ? E6 : E3;
    constexpr float L2E = 1.44269504f;
    if (rmask & 1) for (int it = blockIdx.x; it < N_SCAN; it += gridDim.x) {
        const int bl = it >> 3, h = (it >> 1) & 3, dir = it & 1;
        __builtin_amdgcn_s_setprio(3);
        scan_item((const bf16_t*)(scr + SO_SC), (float*)(scr + SO_Y), bl, h, dir, p.in[22] + l * 256, smem);
        __builtin_amdgcn_s_setprio(0);
    }
    for (;;) {
        if (tid_() == 0) *s_item = E0 + atomicAdd(ctr, 1);
        __syncthreads();
        const int it = __builtin_amdgcn_readfirstlane(*s_item);
        __syncthreads();
        if (it >= total) break;
        if (!(rmask & 2)) continue;
        AttnArgs a{};
        if (it < E0) {
        } else if (it < E1 || (it >= E3 && it < E4)) {
            const bool cx = it >= E3; int bl, h, q0;
            if (!cx) { const int u = it - E0; bl = u >> 6; h = (u >> 4) & 3; q0 = (u & 15) * 128; }
            else { const int u = it - E3; bl = u >> 3; h = (u >> 1) & 3; q0 = SEQ + (u & 1) * 128; }
            const size_t tb = (size_t)bl * TT;
            a.Q = MQ + (tb + q0) * 384 + h * 96; a.qs = 384;
            a.K = KN + tb * 256 + h * 64; a.ks = 256; a.K2 = ZR + tb * ZRW + 1152; a.k2s = ZRW;
            a.Vt = VtM + ((size_t)(bl * 4 + h) * 64) * TT;
            a.O = MIX + (tb + q0) * 1024 + 256 + h * 64; a.os = 1024;
            a.kstart = cx ? SEQ : 0; a.nkt = cx ? 4 : 36; a.sc2 = 0.10206207261596575f * L2E;
            if (MIXMASK & 2) attn_item<96, 1, 2, false>(a, smem);
        } else if (it < E2 || (it >= E4 && it < E5)) {
            const bool cx = it >= E4; int bl, h, q0;
            if (!cx) { const int u = it - E1; bl = u / (4 * DLT); h = (u / DLT) & 3; q0 = (u % DLT) * DQ; }
            else { const int u = it - E4; bl = u / (4 * DCT); h = (u / DCT) & 3; q0 = SEQ + (u % DCT) * DQ; }
            const size_t tb = (size_t)bl * TT;
            a.Q = QK + (tb + q0) * 1024 + 512 + h * 64; a.qs = 1024;
            a.K = QK + tb * 1024 + 768 + h * 64; a.ks = 1024;
            a.Vt = VtD + ((size_t)(bl * 4 + h) * 64) * TT;
            a.O = MIX + (tb + q0) * 1024 + 768 + h * 64; a.os = 1024;
            a.kstart = cx ? SEQ : 0; a.nkt = cx ? 4 : 36; a.sc2 = 0.17677669529663687f * L2E;
            a.lam = lam; a.oscale = 1.f - lam_init; a.subln = p.in[27] + l * 64;
            if (MIXMASK & 4) attn_item<64, 2, DMQ, false>(a, smem);
        } else {
            const bool cx = it >= E5; int bl, h, q0;
            if (!cx) { const int u = it - E2; bl = u >> 7; h = (u >> 5) & 3; const int r = u & 31; q0 = r * 64; a.na_r = r; a.na_rs = min(max(r - 4, 0), 24); }
            else { const int u = it - E5; bl = u >> 4; h = (u >> 2) & 3; q0 = SEQ + (u & 3) * 64; }
            const size_t tb = (size_t)bl * TT;
            a.Q = QK + (tb + q0) * 1024 + h * 64; a.qs = 1024;
            a.K = QK + tb * 1024 + 256 + h * 64; a.ks = 1024;
            a.Vt = VtNA + ((size_t)(bl * 4 + h) * 64) * TT;
            a.O = MIX + (tb + q0) * 1024 + h * 64; a.os = 1024;
            a.sc2 = 0.125f * L2E; a.rpb = p.in[10] + ((size_t)l * 4 + h) * 465;
            if (!cx) { a.nkt = 12; if (MIXMASK & 8) attn_item<64, 1, 1, true>(a, smem); }
            else { a.kstart = SEQ; a.nkt = 4; if (MIXMASK & 16) attn_item<64, 1, 1, false>(a, smem); }
        }
    }
}

DEV void phase_fix(const Params& p, int l) {
    char* scr = p.ws + OFF_SCR;
    bf16_t* G = (bf16_t*)(scr + SO_G); const float* E = (const float*)(scr + SO_E);
    const float* cw = p.in[29] + (size_t)l * 3 * DFF;
    const bool skip_ctx = !(l < DEPTH - 1);
    constexpr int NTM = T_ALL / 128;
    const int total = NTM * (DFF / 4);
    for (int idx = blockIdx.x * NTHR + tid_(); idx < total; idx += gridDim.x * NTHR) {
        const int tm = idx / (DFF / 4), j = (idx - tm * (DFF / 4)) * 4;
        const int row0 = tm * 128, tt0 = row0 % TT;
        if (skip_ctx && tt0 >= SEQ) continue;
        const bool first = (tt0 == 0 || tt0 == SEQ), last = (tt0 + 127 == SEQ - 1 || tt0 + 127 == TT - 1);
        if (!first) {
            const float* e = E + ((size_t)tm * 6) * DFF + j; const float* ep = E + ((size_t)(tm - 1) * 6 + 5) * DFF + j;
            const f32x4 pre = *(const f32x4*)(e) + *(const f32x4*)(cw + j) * *(const f32x4*)(ep), bv = *(const f32x4*)(e + DFF);
            u32x2 w; w.x = pk2(siluf_(pre[0]) * bv[0], siluf_(pre[1]) * bv[1]); w.y = pk2(siluf_(pre[2]) * bv[2], siluf_(pre[3]) * bv[3]);
            *(u32x2*)(G + (size_t)row0 * DFF + j) = w;
        }
        if (!last) {
            const float* e = E + ((size_t)tm * 6 + 3) * DFF + j; const float* en = E + ((size_t)(tm + 1) * 6 + 2) * DFF + j;
            const f32x4 pre = *(const f32x4*)(e) + *(const f32x4*)(cw + 2 * DFF + j) * *(const f32x4*)(en), bv = *(const f32x4*)(e + DFF);
            u32x2 w; w.x = pk2(siluf_(pre[0]) * bv[0], siluf_(pre[1]) * bv[1]); w.y = pk2(siluf_(pre[2]) * bv[2], siluf_(pre[3]) * bv[3]);
            *(u32x2*)(G + (size_t)(row0 + 127) * DFF + j) = w;
        }
    }
}

DEV int cm_in(int n) {
    if (n < 768) return n;
    if (n < 1536) return 2080 + (n - 768);
    if (n < 2304) return 1184 + (n - 1536);
    if (n < 2560) return 768 + (n - 2304);
    if (n < 2688) return 1024 + (n - 2560);
    if (n < 2816) { const int o = n - 2688; return o < 32 ? 1152 + o : (o < 64 ? 1952 + (o - 32) : (o < 96 ? 1984 + (o - 64) : -1)); }
    { const int o = n - 2816; return o < 64 ? 2016 + o : -1; }
}
DEV int cm_up(int n) { const int t = n >> 7, o = n & 127; return o < 64 ? t * 64 + o : DFF + t * 64 + (o - 64); }

template <int MODE>
DEV void conv_unit(const float* src, int lds_, bf16_t* dst, int K, int nt, int kt, float* tile) {
    const int tid = tid_(), a = tid & 63, b = tid >> 6;
    const int n = nt * 64 + a;
    const int col = MODE == 0 ? cm_in(n) : (MODE == 2 ? cm_up(n) : n);
#pragma unroll 4
    for (int i = 0; i < 16; ++i) { const int kl = b + 4 * i; tile[kl * 65 + a] = col >= 0 ? src[(size_t)(kt * 64 + kl) * lds_ + col] : 0.f; }
    __syncthreads();
#pragma unroll 4
    for (int i = 0; i < 16; ++i) { const int nl = b + 4 * i; dst[(size_t)(nt * 64 + nl) * K + kt * 64 + a] = f2bf(tile[a * 65 + nl]); }
    __syncthreads();
}

DEV void phase_prologue(const Params& p, char* smem) {
    const int tid = tid_(), gtid = blockIdx.x * NTHR + tid, gsz = gridDim.x * NTHR;
    if (blockIdx.x == 0) {
        int* ctr = (int*)(p.ws + OFF_CTR); ctr[tid] = 0;
        if (tid < DEPTH) {
            const float* lp = p.in[26] + tid * 128; float s0 = 0.f, s1 = 0.f;
            for (int i = 0; i < 32; ++i) { s0 += lp[i] * lp[32 + i]; s1 += lp[64 + i] * lp[96 + i]; }
            ((float*)(p.ws + OFF_LAM))[tid] = expf(s0) - expf(s1) + (0.8f - 0.6f * expf(-0.3f * (float)tid));
        }
    }
    for (int i = gtid; i < 2048 * 16; i += gsz) {
        const int tt = i >> 4, f = i & 15; const float pos = (float)(f < 8 ? tt / 64 : tt % 64);
        const float freq = powf(10000.f, -(float)(f & 7) / 8.f); const float ang = pos * freq;
        ((float*)(p.ws + OFF_COS))[i] = cosf(ang); ((float*)(p.ws + OFF_SIN))[i] = sinf(ang);
    }
    for (int i = gtid; i < DEPTH * 245760; i += gsz) {
        const int l = i / 245760; int e = i - l * 245760;
        if (e < 98304) { const int n = e >> 8, k = e & 255; wlw(p, l, WE_UQ)[e] = f2bf(p.in[13][((size_t)l * 256 + k) * 384 + n] * p.in[11][l * 256 + k]); }
        else if ((e -= 98304) < 65536) { const int n = e >> 7, k = e & 127; wlw(p, l, WE_UKV)[e] = f2bf(p.in[14][((size_t)l * 128 + k) * 512 + n] * p.in[12][l * 128 + k]); }
        else if ((e -= 65536) < 65536) { const int n = e >> 6, k = e & 63, seg = n >> 8, ch = n & 255; float v = 0.f;
            if (seg < 2) { if (k < 32) v = p.in[17][(((size_t)l * 2 + seg) * 32 + k) * 256 + ch]; }
            else { if (k >= 32) v = p.in[19][(((size_t)l * 2 + (seg - 2)) * 32 + (k - 32)) * 256 + ch]; }
            wlw(p, l, WE_WA)[e] = f2bf(v); }
        else { e -= 65536; const int n = e >> 6, k = e & 63; wlw(p, l, WE_G)[e] = f2bf(p.in[20][((size_t)l * 64 + k) * 256 + n]); }
    }
    {
        constexpr int U_IN = (ZN / 64) * 16, U_OUT = 16 * 16, U_UP = 88 * 16, U_DN = 16 * 44, U_L = U_IN + U_OUT + U_UP + U_DN;
        float* tile = (float*)smem;
        for (int u = blockIdx.x; u < DEPTH * U_L; u += gridDim.x) {
            const int l = u / U_L; int e = u - l * U_L;
            if (e < U_IN) conv_unit<0>(p.in[8] + (size_t)l * 1024 * 2848, 2848, wlw(p, l, WE_IN), 1024, e >> 4, e & 15, tile);
            else if ((e -= U_IN) < U_OUT) conv_unit<1>(p.in[9] + (size_t)l * 1024 * 1024, 1024, wlw(p, l, WE_OUT), 1024, e >> 4, e & 15, tile);
            else if ((e -= U_OUT) < U_UP) conv_unit<2>(p.in[28] + (size_t)l * 1024 * 5632, 5632, wlw(p, l, WE_UP), 1024, e >> 4, e & 15, tile);
            else { e -= U_UP; conv_unit<1>(p.in[31] + (size_t)l * 2816 * 1024, 1024, wlw(p, l, WE_DOWN), 2816, e / 44, e % 44, tile); }
        }
    }
    {
        float* Ssm = (float*)smem;
        float* red = Ssm + 33 * 128;
        const int lane = tid & 63, w = tid >> 6;
        for (int u = blockIdx.x; u < DEPTH * 96; u += gridDim.x) {
            const int l = u / 96, n0 = (u - l * 96) * 64;
            const float* W = p.in[6] + (size_t)l * 1024 * 6144 + n0 + lane;
            float acc[33];
#pragma unroll
            for (int r = 0; r < 33; ++r) acc[r] = 0.f;
            for (int kc = 0; kc < 8; ++kc) {
                __syncthreads();
                for (int i = tid; i < 33 * 128; i += NTHR) { const int r = i >> 7, k = kc * 128 + (i & 127); const float cv = r < 32 ? p.in[1][r * 1024 + k] : p.in[3][k]; Ssm[i] = siluf_(cv); }
                __syncthreads();
                for (int kk = 0; kk < 32; ++kk) {
                    const int kl = w * 32 + kk; const float wv = W[(size_t)(kc * 128 + kl) * 6144];
#pragma unroll
                    for (int r = 0; r < 33; ++r) acc[r] += Ssm[r * 128 + kl] * wv;
                }
            }
#pragma unroll
            for (int r = 0; r < 33; ++r) red[(w * 33 + r) * 64 + lane] = acc[r];
            __syncthreads();
            for (int i = tid; i < 33 * 64; i += NTHR) {
                const int r = i >> 6, n = i & 63;
                const float v = red[(0 * 33 + r) * 64 + n] + red[(1 * 33 + r) * 64 + n] + red[(2 * 33 + r) * 64 + n] + red[(3 * 33 + r) * 64 + n];
                ((float*)(p.ws + OFF_MOD))[((size_t)l * 33 + r) * 6144 + n0 + n] = v + p.in[7][(size_t)l * 6144 + n0 + n];
            }
            __syncthreads();
        }
    }
}

constexpr int PH_PER_LAYER = 15, N_PHASES = 2 + DEPTH * PH_PER_LAYER;

DEV void run_phase(const Params& p, int ph, char* smem, int ctr_off, int* s_item) {
    if (ph == 0) { phase_prologue(p, smem); return; }
    if (ph == N_PHASES - 1) { phase_final(p); return; }
    const int l = (ph - 1) / PH_PER_LAYER, s = (ph - 1) % PH_PER_LAYER;
    const bool last_layer = (l == DEPTH - 1);
    char* scr = p.ws + OFF_SCR;
    const float* mod = (const float*)(p.ws + OFF_MOD) + (size_t)l * 33 * 6144;
    const bf16_t* H = (const bf16_t*)(p.ws + OFF_H);
    if (s == 0) { phase_norm(p, l, 0, false); return; }
    if (s >= 1 && s <= 8) {
        const int c = (s - 1) / 4, q = (s - 1) % 4;
        if (q == 0) {
            EpiIn e{(bf16_t*)(scr + SO_QK), (bf16_t*)(scr + SO_ZR), (bf16_t*)(scr + SO_VTNA), (bf16_t*)(scr + SO_VTD), (const float*)(p.ws + OFF_COS), (const float*)(p.ws + OFF_SIN)};
            gemm_phase(H + (size_t)c * TC * 1024, 1024, wl(p, l, WE_IN), 1024, 1024, TC / 128, ZN / 128, false, smem, e);
        } else if (q == 1) phase_prep(p, l, c);
        else if (q == 2) phase_gemm_small(p, l, c, smem);
        else phase_mix(p, l, c, ph + ctr_off, smem, ctr_off ? PROBE_MIXSEL : 3, s_item);
        return;
    }
    if (s == 9) {
        EpiG e{(bf16_t*)(p.ws + OFF_H), (const bf16_t*)(scr + SO_SC), (const float*)(scr + SO_Y), p.in[23] + l * 256, p.in[24] + l * 256, p.in[25] + l * 256, 0};
        gemm_phase((const bf16_t*)(scr + SO_AG), 64, wl(p, l, WE_G), 64, 64, T_ALL / 128, 2, last_layer, smem, e);
        return;
    }
    if (s == 10) { EpiRes e{&p, mod, 2048, l == 0 ? 1 : 0}; gemm_phase(H, 1024, wl(p, l, WE_OUT), 1024, 1024, T_ALL / 128, 8, last_layer, smem, e); return; }
    if (s == 11) { phase_norm(p, l, 1, last_layer); return; }
    if (s == 12) { EpiUp e{(bf16_t*)(scr + SO_G), (float*)(scr + SO_E), p.in[29] + (size_t)l * 3 * DFF, p.in[30] + (size_t)l * DFF};
                   gemm_phase(H, 1024, wl(p, l, WE_UP), 1024, 1024, T_ALL / 128, 44, last_layer, smem, e); return; }
    if (s == 13) { phase_fix(p, l); return; }
    { EpiRes e{&p, mod, 5120, 0}; gemm_phase((const bf16_t*)(scr + SO_G), DFF, wl(p, l, WE_DOWN), DFF, DFF, T_ALL / 128, 8, last_layer, smem, e); }
}

#define XB_TMO      128
#define XB_XCNT(j)  (256  + 64 * (j))
#define XB_XSUB(j)  (1280 + 64 * (j))
#define XB_XGEN(j)  (2304 + 64 * (j))
#define XB_TOP      3328
#define XB_TOPGEN   3392
#define XCD_BAR_WORDS 3456
#define XB_SPIN_CAP (1u << 18)

__device__ __forceinline__ unsigned xb_ld(unsigned* p)              { return __hip_atomic_load(p, __ATOMIC_RELAXED, __HIP_MEMORY_SCOPE_AGENT); }
__device__ __forceinline__ unsigned xb_add(unsigned* p, unsigned v) { return __hip_atomic_fetch_add(p, v, __ATOMIC_RELAXED, __HIP_MEMORY_SCOPE_AGENT); }
__device__ __forceinline__ unsigned xb_xcc_id() { return (unsigned)__builtin_amdgcn_s_getreg((3 << 11) | 20) & 0xFu; }
#define XB_SPIN(cond, bar) do { unsigned _sp = 0; while (cond) { __builtin_amdgcn_s_sleep(1); \
    if ((++_sp & 255u) == 0u) { if (xb_ld(&(bar)[XB_TMO])) break; if (_sp > XB_SPIN_CAP) { atomicAdd(&(bar)[XB_TMO], 1u); break; } } } } while (0)

struct XcdBarrier {
    unsigned* bar; unsigned x;
    volatile LAS unsigned* st;
};

__device__ __forceinline__ XcdBarrier xcd_barrier_post(unsigned* bar, volatile LAS unsigned* st) {
    XcdBarrier b; b.bar = bar; b.x = xb_xcc_id(); b.st = st;
    if (threadIdx.x == 0) (void)xb_add(&bar[XB_XCNT(b.x)], 1u);
    return b;
}
__device__ __forceinline__ void xcd_barrier_complete(unsigned* bar, unsigned x, unsigned& nloc, unsigned& nx) {
    const unsigned G = gridDim.x * gridDim.y * gridDim.z;
    unsigned sum, cnt, mine, sp = 0u;
    for (;;) {
        sum = 0u; cnt = 0u; mine = 0u;
#pragma unroll
        for (unsigned j = 0; j < 16; ++j) { const unsigned c = xb_ld(&bar[XB_XCNT(j)]); sum += c; cnt += (c > 0u) ? 1u : 0u; mine = (j == x) ? c : mine; }
        if (sum == G) break;
        __builtin_amdgcn_s_sleep(1);
        if ((++sp & 255u) == 0u) { if (xb_ld(&bar[XB_TMO])) break; if (sp > XB_SPIN_CAP) { atomicAdd(&bar[XB_TMO], 1u); break; } }
    }
    nloc = mine > 0u ? mine : 1u; nx = cnt > 0u ? cnt : 1u;
}

__device__ __forceinline__ void xcd_barrier(const XcdBarrier& b) {
    asm volatile("s_waitcnt vmcnt(0)" ::: "memory");
    __syncthreads();
    if (threadIdx.x == 0) {
        unsigned* bar = b.bar;
        __builtin_amdgcn_s_waitcnt(0);
        unsigned nloc = b.st[0], nx = b.st[1];
        if (nloc == 0u) { xcd_barrier_complete(bar, b.x, nloc, nx); b.st[0] = nloc; b.st[1] = nx; }
        const unsigned old = xb_add(&bar[XB_XSUB(b.x)], 1u);
        const unsigned gen = old / nloc;
        if (old + 1u == (gen + 1u) * nloc) {
            __builtin_amdgcn_fence(__ATOMIC_RELEASE, "agent");
            asm volatile("s_waitcnt vmcnt(0)" ::: "memory");
            const unsigned og = xb_add(&bar[XB_TOP], 1u);
            const unsigned tg = og / nx;
            if (og + 1u == (tg + 1u) * nx) xb_add(&bar[XB_TOPGEN], 1u);
            else XB_SPIN(xb_ld(&bar[XB_TOPGEN]) == tg, bar);
            __builtin_amdgcn_fence(__ATOMIC_ACQUIRE, "agent");
            xb_add(&bar[XB_XGEN(b.x)], 1u);
            asm volatile("s_waitcnt vmcnt(0)" ::: "memory");
        } else {
            XB_SPIN(xb_ld(&bar[XB_XGEN(b.x)]) == gen, bar);
            __builtin_amdgcn_fence(__ATOMIC_ACQUIRE, "agent");
            asm volatile("s_waitcnt vmcnt(0)" ::: "memory");
        }
    }
    __syncthreads();
}


__global__ void __launch_bounds__(NTHR, 2) mk_fwd(Params p, int ph_lo, int ph_hi) {
    extern __shared__ __attribute__((aligned(16))) char smem[];
    __shared__ uint4 s_ctl;
    if (threadIdx.x == 0) s_ctl = make_uint4(0u, 0u, 0u, 0u);
    __syncthreads();
    XcdBarrier xb = xcd_barrier_post((unsigned*)(p.ws + OFF_XBAR), (volatile LAS unsigned*)&s_ctl);
    int* s_item = (int*)&s_ctl + 2;
    for (int ph = ph_lo; ph <= ph_hi; ++ph) {
        run_phase(p, ph, smem, 0, s_item);
#ifdef PROBE_DUP
        if (ph > 0 && ph < N_PHASES - 1) {
            const int s_ = (ph - 1) % PH_PER_LAYER, q_ = (s_ >= 1 && s_ <= 8) ? (s_ - 1) % 4 : -1;
            bool dup = false;
            if ((PROBE_DUP & 1) && (q_ == 0)) dup = true;
            if ((PROBE_DUP & 2) && (s_ == 12)) dup = true;
            if ((PROBE_DUP & 4) && (q_ == 3)) dup = true;
            if ((PROBE_DUP & 8) && (q_ == 2 || s_ == 9)) dup = true;
            if ((PROBE_DUP & 16) && (s_ == 0 || s_ == 11 || q_ == 1 || s_ == 13)) dup = true;
            if (dup) run_phase(p, ph, smem, 100, s_item);
        }
#endif
        if (ph < ph_hi) {
            if (ph_lo < 0) cg::this_grid().sync();
            xcd_barrier(xb);
        }
    }
}

extern "C" void kernel_launch(void* const* d_in, const int* in_sizes, int n_in, void* d_out, int out_size, void* d_ws, size_t ws_size, hipStream_t stream) {
    static int grid = 0;
    if (grid == 0) {
        if (n_in != 33 || ws_size < WS_NEED) { fprintf(stderr, "kernel_launch: n_in %d ws %zu need %zu\n", n_in, ws_size, (size_t)WS_NEED); grid = -1; return; }
        int dev = 0, cus = 0, per_cu = 0;
        hipGetDevice(&dev);
        hipDeviceGetAttribute(&cus, hipDeviceAttributeMultiprocessorCount, dev);
        if (hipFuncSetAttribute((const void*)mk_fwd, hipFuncAttributeMaxDynamicSharedMemorySize, LDS_BYTES) != hipSuccess) { fprintf(stderr, "hipFuncSetAttribute failed\n"); grid = -1; return; }
        if (hipOccupancyMaxActiveBlocksPerMultiprocessor(&per_cu, (const void*)mk_fwd, NTHR, LDS_BYTES) != hipSuccess || per_cu < 1) { fprintf(stderr, "occupancy query failed (%d)\n", per_cu); per_cu = 1; }
        if (per_cu > 2) per_cu = 2;
        grid = cus * per_cu;
        fprintf(stderr, "kernel_launch: grid %d (%d CUs x %d)\n", grid, cus, per_cu);
    }
    if (grid < 0) return;
    Params p{};
    for (int i = 0; i < 33; ++i) p.in[i] = (const float*)d_in[i];
    p.out = (float*)d_out; p.ws = (char*)d_ws;
#if MK_ONE_LAUNCH
    if (hipMemsetAsync((char*)d_ws + OFF_XBAR, 0, XCD_BAR_WORDS * 4, stream) != hipSuccess) { fprintf(stderr, "memset failed\n"); return; }
    int lo = 0, hi = N_PHASES - 1;
    void* args[] = {&p, &lo, &hi};
    hipError_t e = hipLaunchCooperativeKernel((const void*)mk_fwd, dim3(grid), dim3(NTHR), args, LDS_BYTES, stream);
    if (e != hipSuccess) fprintf(stderr, "cooperative launch failed: %s (grid %d)\n", hipGetErrorString(e), grid);
#else
    for (int ph = 0; ph < N_PHASES; ++ph) {
        int lo = ph, hi = ph;
        void* args[] = {&p, &lo, &hi};
        hipError_t e = hipLaunchCooperativeKernel((const void*)mk_fwd, dim3(grid), dim3(NTHR), args, LDS_BYTES, stream);
        if (e != hipSuccess) { fprintf(stderr, "launch %d failed: %s (grid %d)\n", ph, hipGetErrorString(e), grid); break; }
    }
#endif
}
```

```cpp
#include <hip/hip_runtime.h>
#include <hip/hip_cooperative_groups.h>
#include <cstdio>
#include <cstdint>
namespace cg = cooperative_groups;

#ifndef MK_ONE_LAUNCH
#define MK_ONE_LAUNCH 1
#endif

typedef unsigned short bf16_t;
typedef short bf16x8 __attribute__((ext_vector_type(8)));
typedef float f32x4 __attribute__((ext_vector_type(4)));
typedef unsigned u32x4 __attribute__((ext_vector_type(4)));
typedef unsigned u32x2 __attribute__((ext_vector_type(2)));
#define DEV __device__ __forceinline__
#define LAS __attribute__((address_space(3)))

constexpr int D = 1024, NBATCH = 32, SEQ = 2048, CTXL = 256, TT = 2304, T_ALL = NBATCH * TT, DEPTH = 4, DFF = 2816;
constexpr int NCHUNK = 2, CB = NBATCH / NCHUNK, TC = CB * TT;
constexpr int ZN = 2944, ZRW = 1408;
constexpr int NTHR = 256;
constexpr int LDS_BYTES = 73728;
constexpr int GP = 72;
constexpr int CP = 132;
#ifndef PROBE_MIXSEL
#define PROBE_MIXSEL 3
#endif
#ifndef MIXMASK
#define MIXMASK 31
#endif
#ifndef DMQ
#define DMQ 2
#endif

constexpr size_t al256(size_t x) { return (x + 255) & ~(size_t)255; }
constexpr size_t OFF_CTR = 0;
constexpr size_t OFF_LAM = 1024;
constexpr size_t OFF_XBAR = 4096;
constexpr size_t OFF_COS = 32768;
constexpr size_t OFF_SIN = OFF_COS + 2048 * 16 * 4;
constexpr size_t OFF_MOD = OFF_SIN + 2048 * 16 * 4;
constexpr size_t OFF_RSQ = al256(OFF_MOD + (size_t)DEPTH * 33 * 6144 * 4);
constexpr size_t OFF_RSKV = OFF_RSQ + (size_t)TC * 4;
constexpr size_t OFF_XC = al256(OFF_RSKV + (size_t)TC * 4);
constexpr size_t OFF_W = al256(OFF_XC + (size_t)NBATCH * CTXL * D * 4);
constexpr size_t WE_IN = 0;
constexpr size_t WE_OUT = WE_IN + (size_t)ZN * 1024;
constexpr size_t WE_UP = WE_OUT + (size_t)1024 * 1024;
constexpr size_t WE_DOWN = WE_UP + (size_t)5632 * 1024;
constexpr size_t WE_UQ = WE_DOWN + (size_t)1024 * 2816;
constexpr size_t WE_UKV = WE_UQ + (size_t)384 * 256;
constexpr size_t WE_WA = WE_UKV + (size_t)512 * 128;
constexpr size_t WE_G = WE_WA + (size_t)1024 * 64;
constexpr size_t WE_TOTAL = WE_G + (size_t)256 * 64;
constexpr size_t OFF_H = al256(OFF_W + (size_t)DEPTH * WE_TOTAL * 2);
constexpr size_t OFF_SCR = al256(OFF_H + (size_t)T_ALL * 1024 * 2);
constexpr size_t SO_QK = 0;
constexpr size_t SO_ZR = al256(SO_QK + (size_t)TC * 1024 * 2);
constexpr size_t VT_ELEMS = (size_t)CB * 4 * 64 * TT;
constexpr size_t SO_VTNA = al256(SO_ZR + (size_t)TC * ZRW * 2);
constexpr size_t SO_VTD = SO_VTNA + VT_ELEMS * 2;
constexpr size_t SO_VTM = SO_VTD + VT_ELEMS * 2;
constexpr size_t SO_MQ = SO_VTM + VT_ELEMS * 2;
constexpr size_t SO_KN = al256(SO_MQ + (size_t)TC * 384 * 2);
constexpr size_t SO_AWA = al256(SO_KN + (size_t)TC * 256 * 2);
constexpr size_t SO_AG = al256(SO_AWA + (size_t)TC * 64 * 2);
constexpr size_t SO_SC = al256(SO_AG + (size_t)T_ALL * 64 * 2);
constexpr size_t SO_Y = al256(SO_SC + (size_t)T_ALL * 2048 * 2);
constexpr size_t SO_END = al256(SO_Y + (size_t)2 * T_ALL * 256 * 4);
constexpr size_t SO_G = 0;
constexpr size_t SO_E = al256(SO_G + (size_t)T_ALL * DFF * 2);
constexpr size_t SO_END2 = al256(SO_E + (size_t)(T_ALL / 128) * 6 * DFF * 4);
constexpr size_t WS_NEED = OFF_SCR + (SO_END > SO_END2 ? SO_END : SO_END2);

struct Params { const float* in[33]; float* out; char* ws; };

DEV int tid_() { int t = __builtin_amdgcn_workitem_id_x(); asm volatile("" : "+v"(t)); return t; }
DEV float bf2f(bf16_t b) { return __uint_as_float(((unsigned)b) << 16); }
DEV bf16_t f2bf(float f) { unsigned u = __float_as_uint(f); u += 0x7fffu + ((u >> 16) & 1u); return (bf16_t)(u >> 16); }
typedef __bf16 bf16v2_t __attribute__((ext_vector_type(2)));
typedef float f32v2_t __attribute__((ext_vector_type(2)));
DEV unsigned pk2(float a, float b) { const f32v2_t f = {a, b}; return __builtin_bit_cast(unsigned, __builtin_convertvector(f, bf16v2_t)); }
DEV float lo_bf(unsigned u) { return __uint_as_float(u << 16); }
DEV float hi_bf(unsigned u) { return __uint_as_float(u & 0xffff0000u); }
DEV float wave_sum(float v) {
#pragma unroll
    for (int o = 32; o >= 1; o >>= 1) v += __shfl_xor(v, o);
    return v;
}
template <int CTRL> DEV float dppf(float v) { return __builtin_bit_cast(float, __builtin_amdgcn_update_dpp(0, __builtin_bit_cast(int, v), CTRL, 0xf, 0xf, true)); }
DEV float sum16(float v) { v += dppf<0xB1>(v); v += dppf<0x4E>(v); v += dppf<0x124>(v); v += dppf<0x128>(v); return v; }
DEV float max16(float v) { v = fmaxf(v, dppf<0xB1>(v)); v = fmaxf(v, dppf<0x4E>(v)); v = fmaxf(v, dppf<0x124>(v)); v = fmaxf(v, dppf<0x128>(v)); return v; }
DEV float sum32(float v) { v = sum16(v); v += __shfl_xor(v, 16); return v; }
DEV float sigmoidf_(float x) { return __builtin_amdgcn_rcpf(1.f + __expf(-x)); }
DEV float siluf_(float x) { return x * __builtin_amdgcn_rcpf(1.f + __expf(-x)); }

DEV float* xrow(const Params& p, int g) {
    const int b = g / TT, tt = g - b * TT;
    return tt < SEQ ? p.out + ((size_t)b * SEQ + tt) * D : (float*)(p.ws + OFF_XC) + ((size_t)b * CTXL + (tt - SEQ)) * D;
}
DEV const float* xrow_in(const Params& p, int g) {
    const int b = g / TT, tt = g - b * TT;
    return tt < SEQ ? p.in[0] + ((size_t)b * SEQ + tt) * D : p.in[2] + ((size_t)b * CTXL + (tt - SEQ)) * D;
}
DEV const bf16_t* wl(const Params& p, int l, size_t we) { return (const bf16_t*)(p.ws + OFF_W) + (size_t)l * WE_TOTAL + we; }
DEV bf16_t* wlw(const Params& p, int l, size_t we) { return (bf16_t*)(p.ws + OFF_W) + (size_t)l * WE_TOTAL + we; }

template <class Epi>
DEV void gemm_tile(const bf16_t* __restrict__ A, int lda, const bf16_t* __restrict__ Bt, int ldb, int K, int tm, int tn, char* smem, const Epi& epi) {
    const int tid = tid_(), lane = tid & 63, wid = tid >> 6, wr = wid >> 1, wc = wid & 1, fr = lane & 15, fq = lane >> 4;
    bf16_t* As = (bf16_t*)smem;
    bf16_t* Bs = As + 2 * 128 * 64;
    const int lrow = tid >> 3, lcc = (tid & 7) * 8, lsw = (((tid & 7) ^ (lrow & 7)) * 8);
    const bf16_t* Ag = A + (size_t)(tm * 128 + lrow) * lda + lcc;
    const bf16_t* Bg = Bt + (size_t)(tn * 128 + lrow) * ldb + lcc;
    f32x4 acc[4][4];
#pragma unroll
    for (int m = 0; m < 4; ++m)
#pragma unroll
        for (int n = 0; n < 4; ++n) acc[m][n] = (f32x4){0.f, 0.f, 0.f, 0.f};
    const int gsw = (((tid & 7) ^ (lrow & 7)) * 8);
    const bf16_t* Ad = A + (size_t)(tm * 128 + lrow) * lda + gsw;
    const bf16_t* Bd = Bt + (size_t)(tn * 128 + lrow) * ldb + gsw;
    char* Asb = (char*)As; char* Bsb = (char*)Bs;
#define G_DMA(buf_, kt_) do { const int ko_ = (kt_) * 64; \
        _Pragma("unroll") for (int i = 0; i < 4; ++i) { \
            __builtin_amdgcn_global_load_lds((const unsigned*)(Ad + (size_t)(32 * i) * lda + ko_), (LAS unsigned*)(Asb + (buf_) * 16384 + i * 4096 + tid * 16), 16, 0, 0); \
            __builtin_amdgcn_global_load_lds((const unsigned*)(Bd + (size_t)(32 * i) * ldb + ko_), (LAS unsigned*)(Bsb + (buf_) * 16384 + i * 4096 + tid * 16), 16, 0, 0); } } while (0)
#define G_FRAGS(cur_, ks_) const bf16_t* Ac##ks_ = As + (cur_) * 128 * 64 + (wr * 64 + fr) * 64 + ((((ks_) * 4 + fq) ^ (fr & 7)) * 8); const bf16_t* Bc##ks_ = Bs + (cur_) * 128 * 64 + (wc * 64 + fr) * 64 + ((((ks_) * 4 + fq) ^ (fr & 7)) * 8); \
        bf16x8 af##ks_[4], bfv##ks_[4]; \
        _Pragma("unroll") for (int m = 0; m < 4; ++m) af##ks_[m] = *(const bf16x8*)(Ac##ks_ + m * 16 * 64); \
        _Pragma("unroll") for (int n = 0; n < 4; ++n) bfv##ks_[n] = *(const bf16x8*)(Bc##ks_ + n * 16 * 64);
#define G_MMA(ks_) __builtin_amdgcn_s_setprio(1); _Pragma("unroll") for (int m = 0; m < 4; ++m) \
        _Pragma("unroll") for (int n = 0; n < 4; ++n) acc[m][n] = __builtin_amdgcn_mfma_f32_16x16x32_bf16(bfv##ks_[n], af##ks_[m], acc[m][n], 0, 0, 0); __builtin_amdgcn_s_setprio(0);
    const int nk = K >> 6;
    G_DMA(0, 0);
    asm volatile("s_waitcnt vmcnt(0)" ::: "memory");
    __syncthreads();
    for (int kt = 0; kt < nk; ++kt) {
        const int cur = kt & 1;
        if (kt + 1 < nk) G_DMA(cur ^ 1, kt + 1);
        {
            G_FRAGS(cur, 0)
            G_MMA(0)
            G_FRAGS(cur, 1)
            G_MMA(1)
        }
        asm volatile("s_waitcnt vmcnt(0)" ::: "memory");
        __syncthreads();
    }
#undef G_DMA
#undef G_FRAGS
#undef G_MMA
    float* Ct = (float*)smem;
#pragma unroll
    for (int m = 0; m < 4; ++m)
#pragma unroll
        for (int n = 0; n < 4; ++n) *(f32x4*)(Ct + (wr * 64 + m * 16 + fr) * CP + wc * 64 + n * 16 + fq * 4) = acc[m][n];
    __syncthreads();
    epi(tm, tn, Ct);
    __syncthreads();
}

DEV f32x4 rope4(const float* Crow, int c, int o, const float* cosT, const float* sinT, int tt, f32x4 v) {
    const int sub = o >> 3, ti = (sub >> 1) * 8 + (o & 7);
    const f32x4 cs = *(const f32x4*)(cosT + tt * 16 + ti), sn = *(const f32x4*)(sinT + tt * 16 + ti);
    const f32x4 pv = *(const f32x4*)(Crow + ((sub & 1) ? c - 8 : c + 8));
    return (sub & 1) ? v * cs + pv * sn : v * cs - pv * sn;
}

DEV void store_vt(const float* Ct, int c0, bf16_t* vt_head  , int tt0, const float* rowscale) {
    for (int item = tid_(); item < 64 * 16; item += NTHR) {
        const int d = item & 63, rg = item >> 6;
        float v[8];
#pragma unroll
        for (int i = 0; i < 8; ++i) { v[i] = Ct[(rg * 8 + i) * CP + c0 + d]; if (rowscale) v[i] *= rowscale[rg * 8 + i]; }
        u32x4 w; w.x = pk2(v[0], v[1]); w.y = pk2(v[2], v[3]); w.z = pk2(v[4], v[5]); w.w = pk2(v[6], v[7]);
        *(u32x4*)(vt_head + (size_t)d * TT + tt0 + rg * 8) = w;
    }
}

DEV f32x4 rope4v(f32x4 v, f32x4 pv, f32x4 cs, f32x4 sn, int sub) { return (sub & 1) ? v * cs + pv * sn : v * cs - pv * sn; }

struct EpiIn {
    bf16_t* QK; bf16_t* ZR; bf16_t* VtNA; bf16_t* VtD; const float* cosT; const float* sinT;
    DEV void operator()(int tm, int tn, const float* Ct) const {
        const int row0 = tm * 128, bl = row0 / TT, tt0 = row0 - bl * TT; const bool lat = tt0 < SEQ;
        if (tn == 4 || tn == 5 || tn == 10 || tn == 11) {
            bf16_t* Vt = (tn < 6) ? VtNA : VtD; const int hp = (tn & 1) * 2;
            store_vt(Ct, 0, Vt + ((size_t)(bl * 4 + hp) * 64) * TT, tt0, nullptr);
            store_vt(Ct, 64, Vt + ((size_t)(bl * 4 + hp + 1) * 64) * TT, tt0, nullptr);
            return;
        }
        bf16_t* dst; int ds, dc; unsigned ropem = 0;
        if (tn < 4) { dst = QK; ds = 1024; dc = tn * 128; }
        else if (tn < 10) { dst = QK; ds = 1024; dc = 512 + (tn - 6) * 128; ropem = 0xf; }
        else { dst = ZR; ds = ZRW; dc = (tn - 12) * 128; if (tn == 21) ropem = 1; }
        if (!lat) ropem = 0;
        const int tid = tid_(), c = (tid & 31) << 2, rb = tid >> 5;
        const bool rp = (ropem >> (c >> 5)) & 1;
        const int o = c & 31, sub = o >> 3, ti = (sub >> 1) * 8 + (o & 7), pc = (sub & 1) ? c - 8 : c + 8;
        bf16_t* dp = dst + (size_t)row0 * ds + dc + c;
#pragma unroll
        for (int it0 = 0; it0 < 16; it0 += 4) {
            f32x4 cs[4], sn[4];
            if (rp) {
#pragma unroll
                for (int u = 0; u < 4; ++u) { const int r = rb + 8 * (it0 + u); cs[u] = *(const f32x4*)(cosT + (tt0 + r) * 16 + ti); sn[u] = *(const f32x4*)(sinT + (tt0 + r) * 16 + ti); }
            }
#pragma unroll
            for (int u = 0; u < 4; ++u) {
                const int r = rb + 8 * (it0 + u);
                f32x4 v = *(const f32x4*)(Ct + r * CP + c);
                if (rp) v = rope4v(v, *(const f32x4*)(Ct + r * CP + pc), cs[u], sn[u], sub);
                u32x2 w; w.x = pk2(v[0], v[1]); w.y = pk2(v[2], v[3]);
                *(u32x2*)(dp + (size_t)r * ds) = w;
            }
        }
    }
};
struct EpiUQ {
    bf16_t* MQ; const float* rs; const float* cosT; const float* sinT;
    DEV void operator()(int tm, int tn, const float* Ct) const {
        const int row0 = tm * 128, bl = row0 / TT, tt0 = row0 - bl * TT; const bool lat = tt0 < SEQ;
        const int tid = tid_(), c = (tid & 31) << 2, rb = tid >> 5, col = tn * 128 + c, hc = col % 96;
        const bool rp = lat && hc >= 64;
        const int o = rp ? hc - 64 : 0, sub = o >> 3, ti = (sub >> 1) * 8 + (o & 7), pc = (sub & 1) ? c - 8 : c + 8;
#pragma unroll
        for (int it0 = 0; it0 < 16; it0 += 4) {
            f32x4 cs[4], sn[4]; float sc[4];
#pragma unroll
            for (int u = 0; u < 4; ++u) { const int r = rb + 8 * (it0 + u); sc[u] = rs[row0 + r]; if (rp) { cs[u] = *(const f32x4*)(cosT + (tt0 + r) * 16 + ti); sn[u] = *(const f32x4*)(sinT + (tt0 + r) * 16 + ti); } }
#pragma unroll
            for (int u = 0; u < 4; ++u) {
                const int r = rb + 8 * (it0 + u);
                f32x4 v = *(const f32x4*)(Ct + r * CP + c);
                if (rp) v = rope4v(v, *(const f32x4*)(Ct + r * CP + pc), cs[u], sn[u], sub);
                v = v * sc[u];
                u32x2 w; w.x = pk2(v[0], v[1]); w.y = pk2(v[2], v[3]);
                *(u32x2*)(MQ + (size_t)(row0 + r) * 384 + col) = w;
            }
        }
    }
};
struct EpiUKV {
    bf16_t* KN; bf16_t* VtM; const float* rs;
    DEV void operator()(int tm, int tn, const float* Ct) const {
        const int row0 = tm * 128, bl = row0 / TT, tt0 = row0 - bl * TT;
        const int tid = tid_(), c = (tid & 15) << 2, rb = tid >> 4;
        float* rsl = (float*)((char*)Ct + 128 * CP * 4);
        if (tid < 128) rsl[tid] = rs[row0 + tid];
        __syncthreads();
#pragma unroll
        for (int it = 0; it < 8; ++it) {
            const int r = rb + 16 * it;
            const f32x4 v = *(const f32x4*)(Ct + r * CP + c) * rsl[r];
            u32x2 w; w.x = pk2(v[0], v[1]); w.y = pk2(v[2], v[3]);
            *(u32x2*)(KN + (size_t)(row0 + r) * 256 + tn * 64 + c) = w;
        }
        store_vt(Ct, 64, VtM + ((size_t)(bl * 4 + tn) * 64) * TT, tt0, rsl);
    }
};
struct EpiWA {
    bf16_t* SC; const float* w0; const float* a0;
    DEV void operator()(int tm, int tn, const float* Ct) const {
        const int row0 = tm * 128, seg = tn >> 1;
        const int tid = tid_(), c = (tid & 31) << 2, rb = tid >> 5, ch = (tn & 1) * 128 + c, h = ch >> 6, j = ch & 63;
        const f32x4 bias = seg < 2 ? *(const f32x4*)(w0 + seg * 256 + ch) : *(const f32x4*)(a0 + (seg - 2) * 256 + ch);
        bf16_t* dp = SC + (size_t)row0 * 2048 + h * 512 + (4 + seg) * 64 + j;
#pragma unroll 4
        for (int it = 0; it < 16; ++it) {
            const int r = rb + 8 * it;
            const f32x4 v = *(const f32x4*)(Ct + r * CP + c) + bias;
            float o[4];
#pragma unroll
            for (int i = 0; i < 4; ++i) {
                if (seg < 2) o[i] = 0.60653065971f * sigmoidf_(v[i]);
                else o[i] = sigmoidf_(v[i]);
            }
            u32x2 w; w.x = pk2(o[0], o[1]); w.y = pk2(o[2], o[3]);
            *(u32x2*)(dp + (size_t)r * 2048) = w;
        }
    }
};
struct EpiG {
    bf16_t* MIX; const bf16_t* SC; const float* Y; const float* r_k; const float* ln_w; const float* ln_b; int gbase;
    DEV void operator()(int tm, int tn, const float* Ct) const {
        const int row0 = tm * 128;
        const int tid = tid_(), l32 = tid & 31, hh = (tid >> 5) & 1, rb = tid >> 6, h = tn * 2 + hh, j = l32 * 2, ch = h * 64 + j;
        const float rk0 = r_k[ch], rk1 = r_k[ch + 1], lw0 = ln_w[ch], lw1 = ln_w[ch + 1], lb0 = ln_b[ch], lb1 = ln_b[ch + 1];
#pragma unroll
        for (int it0 = 0; it0 < 32; it0 += 4) {
            unsigned yfu[4], ybu[4]; unsigned ur[4], uv[4], uk[4];
#pragma unroll
            for (int u = 0; u < 4; ++u) {
                const size_t row = (size_t)(row0 + rb + 4 * (it0 + u));
                yfu[u] = *(const unsigned*)((const bf16_t*)Y + row * 256 + ch); ybu[u] = *(const unsigned*)((const bf16_t*)Y + ((size_t)T_ALL + row) * 256 + ch);
                const bf16_t* sc = SC + row * 2048 + h * 512 + j;
                ur[u] = *(const unsigned*)(sc); uv[u] = *(const unsigned*)(sc + 64); uk[u] = *(const unsigned*)(sc + 128);
            }
#pragma unroll
            for (int u = 0; u < 4; ++u) {
                const int r = rb + 4 * (it0 + u);
                const float y0 = lo_bf(yfu[u]) + lo_bf(ybu[u]), y1 = hi_bf(yfu[u]) + hi_bf(ybu[u]);
                const float mean = sum32(y0 + y1) * (1.f / 64.f);
                const float d0 = y0 - mean, d1 = y1 - mean;
                const float var = sum32(d0 * d0 + d1 * d1) * (1.f / 64.f);
                const float rstd = rsqrtf(var + 64e-5f);
                const float rk = sum32(lo_bf(ur[u]) * lo_bf(uk[u]) * rk0 + hi_bf(ur[u]) * hi_bf(uk[u]) * rk1);
                const float g0 = Ct[r * CP + hh * 64 + j], g1 = Ct[r * CP + hh * 64 + j + 1];
                const float o0 = (d0 * rstd * lw0 + lb0 + rk * lo_bf(uv[u])) * g0;
                const float o1 = (d1 * rstd * lw1 + lb1 + rk * hi_bf(uv[u])) * g1;
                *(unsigned*)(MIX + (size_t)(row0 + r) * 1024 + 512 + ch) = pk2(o0, o1);
            }
        }
    }
};
struct EpiRes {
    const Params* p; const float* mod; int goff; int from_in;
    DEV void operator()(int tm, int tn, const float* Ct) const {
        const int row0 = tm * 128, b = row0 / TT, tt0 = row0 - b * TT;
        const int tid = tid_(), c = (tid & 31) << 2, rb = tid >> 5;
        const f32x4 g = *(const f32x4*)(mod + (size_t)(tt0 < SEQ ? b : 32) * 6144 + goff + tn * 128 + c);
        float* x0 = xrow(*p, row0) + tn * 128 + c;
        const float* xs = from_in ? xrow_in(*p, row0) + tn * 128 + c : x0;
#pragma unroll
        for (int it0 = 0; it0 < 16; it0 += 8) {
            f32x4 xv[8];
#pragma unroll
            for (int u = 0; u < 8; ++u) xv[u] = *(const f32x4*)(xs + (size_t)(rb + 8 * (it0 + u)) * D);
#pragma unroll
            for (int u = 0; u < 8; ++u) { const int r = rb + 8 * (it0 + u); *(f32x4*)(x0 + (size_t)r * D) = xv[u] + g * *(const f32x4*)(Ct + r * CP + c); }
        }
    }
};
struct EpiUp {
    bf16_t* G; float* E; const float* cw; const float* cb;
    DEV void operator()(int tm, int tn, const float* Ct) const {
        const int row0 = tm * 128, tt0 = row0 % TT;
        const bool first = (tt0 == 0 || tt0 == SEQ), last = (tt0 + 127 == SEQ - 1 || tt0 + 127 == TT - 1);
        const int tid = tid_(), c = (tid & 15) << 2, rb = tid >> 4, j = tn * 64 + c;
        const f32x4 w0 = *(const f32x4*)(cw + j), w1 = *(const f32x4*)(cw + DFF + j), w2 = *(const f32x4*)(cw + 2 * DFF + j), bb = *(const f32x4*)(cb + j);
        const f32x4 z = (f32x4){0.f, 0.f, 0.f, 0.f};
#pragma unroll 2
        for (int it = 0; it < 8; ++it) {
            const int r = rb + 16 * it;
            const f32x4 ac = *(const f32x4*)(Ct + r * CP + c);
            const f32x4 ap = r > 0 ? *(const f32x4*)(Ct + (r - 1) * CP + c) : z;
            const f32x4 an = r < 127 ? *(const f32x4*)(Ct + (r + 1) * CP + c) : z;
            const f32x4 bv = *(const f32x4*)(Ct + r * CP + 64 + c);
            const f32x4 pre = w0 * ap + w1 * ac + w2 * an + bb;
            if ((r == 0 && !first) || (r == 127 && !last)) {
                float* e = E + ((size_t)tm * 6 + (r == 0 ? 0 : 3)) * DFF + j;
                *(f32x4*)(e) = pre; *(f32x4*)(e + DFF) = bv; *(f32x4*)(e + 2 * DFF) = ac;
            } else {
                u32x2 w; w.x = pk2(siluf_(pre[0]) * bv[0], siluf_(pre[1]) * bv[1]); w.y = pk2(siluf_(pre[2]) * bv[2], siluf_(pre[3]) * bv[3]);
                *(u32x2*)(G + (size_t)(row0 + r) * DFF + j) = w;
            }
        }
    }
};

template <class Epi>
DEV void gemm_phase(const bf16_t* A, int lda, const bf16_t* Bt, int ldb, int K, int ntm, int ntn, bool skip_ctx, char* smem, const Epi& epi) {
    if ((gridDim.x & 7) == 0 && (ntm & 7) == 0) {
        const int xcd = blockIdx.x & 7, slot = blockIdx.x >> 3, nper = gridDim.x >> 3, R = ntm >> 3, per = R * ntn;
        const int nfb = ntn >> 3, fullq = nfb * R * 8, w = ntn - nfb * 8;
        for (int q = slot; q < per; q += nper) {
            int tm, tn;
            if (q < fullq) { const int tb = q / (R * 8), r = q - tb * (R * 8); tm = r >> 3; tn = tb * 8 + (r & 7); }
            else { const int q2 = q - fullq; tm = q2 / w; tn = nfb * 8 + (q2 - tm * w); }
            tm += xcd * R;
            if (skip_ctx && ((tm * 128) % TT) >= SEQ) continue;
            gemm_tile(A, lda, Bt, ldb, K, tm, tn, smem, epi);
        }
        return;
    }
    const int total = ntm * ntn;
    for (int t = blockIdx.x; t < total; t += gridDim.x) {
        const int tm = t / ntn, tn = t - tm * ntn;
        if (skip_ctx && ((tm * 128) % TT) >= SEQ) continue;
        gemm_tile(A, lda, Bt, ldb, K, tm, tn, smem, epi);
    }
}

struct AttnArgs {
    const bf16_t* Q; int qs;
    const bf16_t* K; int ks;
    const bf16_t* K2; int k2s;
    const bf16_t* Vt;
    bf16_t* O; int os;
    int nkt; int kstart;
    float sc2;
    int na_r, na_rs; const float* rpb;
    float lam, oscale; const float* subln;
};

DEV unsigned cvt_pk_bf16(float lo, float hi) { return pk2(lo, hi); }
DEV float red_rows_sum(float p) {
    float a = p, b = p;
    asm volatile("s_nop 1\n\tv_permlane16_swap_b32 %0, %1" : "+v"(a), "+v"(b));
    const float q = a + b; a = q; b = q;
    asm volatile("s_nop 1\n\tv_permlane32_swap_b32 %0, %1" : "+v"(a), "+v"(b));
    return a + b;
}
DEV float vmax2(float a, float b) { float r; asm("v_max_f32 %0, %1, %2" : "=v"(r) : "v"(a), "v"(b)); return r; }
DEV float vmax3(float a, float b, float c) { float r; asm("v_max3_f32 %0, %1, %2, %3" : "=v"(r) : "v"(a), "v"(b), "v"(c)); return r; }
DEV float wave_sum_fast(float v) { return red_rows_sum(sum16(v)); }
DEV float red_rows_max(float p) {
    float a = p, b = p;
    asm volatile("s_nop 1\n\tv_permlane16_swap_b32 %0, %1" : "+v"(a), "+v"(b));
    const float q = fmaxf(a, b); a = q; b = q;
    asm volatile("s_nop 1\n\tv_permlane32_swap_b32 %0, %1" : "+v"(a), "+v"(b));
    return fmaxf(a, b);
}
template <int DQK, int NSUB, int MQ, bool NA>
DEV void attn_item(const AttnArgs& a, char* smem) {
    constexpr int KP = DQK + 8, KS = DQK / 32 / NSUB, KCH = DQK / 8, QR = 16 * MQ;
    const int tid = tid_(), lane = tid & 63, wid = tid >> 6, fr = lane & 15, fq = lane >> 4;
    bf16_t* Ksm = (bf16_t*)smem;
    bf16_t* Vsm = Ksm + 2 * 64 * KP;
    float* rpbs = (float*)(Vsm + 2 * 64 * GP);
    if (NA) { for (int i = tid; i < 465; i += NTHR) rpbs[i] = a.rpb[i] * 1.44269504f; }
    const int na_nlo = NA ? (max(16 * wid - 8, 0) >> 4) : 0, na_nhi = NA ? (min(16 * wid + 22, 63) >> 4) : 3;
    bf16x8 qf[MQ][DQK / 32];
#pragma unroll
    for (int mq = 0; mq < MQ; ++mq)
#pragma unroll
        for (int k = 0; k < DQK / 32; ++k) qf[mq][k] = *(const bf16x8*)(a.Q + (size_t)(wid * QR + mq * 16 + fr) * a.qs + k * 32 + fq * 8);
    f32x4 o[NSUB][MQ][4];
    float mrow[NSUB][MQ], lrow[NSUB][MQ];
#pragma unroll
    for (int sb = 0; sb < NSUB; ++sb)
#pragma unroll
        for (int mq = 0; mq < MQ; ++mq) {
            mrow[sb][mq] = -1e30f; lrow[sb][mq] = 0.f;
#pragma unroll
            for (int n = 0; n < 4; ++n) o[sb][mq][n] = (f32x4){0.f, 0.f, 0.f, 0.f};
        }
    constexpr int NKC = (64 * KCH + NTHR - 1) / NTHR;
    u32x4 rk[NKC], rv[2];
#define ATT_TSTART(kt) (NA ? ((kt) < 8 ? (a.na_rs + (kt)) * 64 : SEQ + ((kt) - 8) * 64) : a.kstart + (kt) * 64)
#define ATT_GLOAD(kt) do { const int _t0 = ATT_TSTART(kt); \
        _Pragma("unroll") for (int _i = 0; _i < NKC; ++_i) { const int _q = tid + _i * NTHR; if (_q < 64 * KCH) { const int _r = _q / KCH, _c = _q - _r * KCH; \
            rk[_i] = (_c < 8 || DQK == 64) ? *(const u32x4*)(a.K + (size_t)(_t0 + _r) * a.ks + _c * 8) : *(const u32x4*)(a.K2 + (size_t)(_t0 + _r) * a.k2s + (_c - 8) * 8); } } \
        _Pragma("unroll") for (int _i = 0; _i < 2; ++_i) { const int _q = tid + _i * NTHR, _r = _q >> 3, _c = _q & 7; rv[_i] = *(const u32x4*)(a.Vt + (size_t)_r * TT + _t0 + _c * 8); } } while (0)
#define ATT_LSTORE(buf) do { \
        _Pragma("unroll") for (int _i = 0; _i < NKC; ++_i) { const int _q = tid + _i * NTHR; if (_q < 64 * KCH) { const int _r = _q / KCH, _c = _q - _r * KCH; *(u32x4*)(Ksm + ((buf) * 64 + _r) * KP + _c * 8) = rk[_i]; } } \
        _Pragma("unroll") for (int _i = 0; _i < 2; ++_i) { const int _q = tid + _i * NTHR, _r = _q >> 3, _c = _q & 7; *(u32x4*)(Vsm + ((buf) * 64 + _r) * GP + _c * 8) = rv[_i]; } } while (0)
    ATT_GLOAD(0); ATT_LSTORE(0);
    __syncthreads();
    for (int kt = 0; kt < a.nkt; ++kt) {
        const int cur = kt & 1; const bool more = kt + 1 < a.nkt;
        if (more) ATT_GLOAD(kt + 1);
        const bool natile = NA && kt < 8;
        bf16x8 pb[NSUB][MQ][2];
#pragma unroll
        for (int sb = 0; sb < NSUB; ++sb) {
            f32x4 s[MQ][4];
#pragma unroll
            for (int k = 0; k < KS; ++k) {
                bf16x8 kb[4];
#pragma unroll
                for (int n = 0; n < 4; ++n) kb[n] = *(const bf16x8*)(Ksm + (cur * 64 + n * 16 + fr) * KP + (sb * KS + k) * 32 + fq * 8);
#pragma unroll
                for (int mq = 0; mq < MQ; ++mq)
#pragma unroll
                    for (int n = 0; n < 4; ++n) {
                        if (!natile || (n >= na_nlo && n <= na_nhi)) s[mq][n] = __builtin_amdgcn_mfma_f32_16x16x32_bf16(kb[n], qf[mq][sb * KS + k], k == 0 ? (f32x4){0.f, 0.f, 0.f, 0.f} : s[mq][n], 0, 0, 0);
                        else if (k == 0) s[mq][n] = (f32x4){0.f, 0.f, 0.f, 0.f};
                    }
            }
#pragma unroll
            for (int mq = 0; mq < MQ; ++mq) {
                float mx = -1e30f;
                if (natile) {
                    const int qc = wid * 16 + fr, cst = min(max(qc - 8, 0), 48), ro = a.na_rs + kt - a.na_r + 7;
                    const float* rrow = rpbs + ro * 31 + 15 - qc + fq * 4;
#pragma unroll
                    for (int n = 0; n < 4; ++n) {
                        if (n >= na_nlo && n <= na_nhi) {
#pragma unroll
                            for (int j = 0; j < 4; ++j) {
                                const int kc = n * 16 + fq * 4 + j;
                                const float x = (kc >= cst && kc < cst + 16) ? s[mq][n][j] * a.sc2 + rrow[n * 16 + j] : -1e30f;
                                s[mq][n][j] = x; mx = fmaxf(mx, x);
                            }
                        } else s[mq][n] = (f32x4){-1e30f, -1e30f, -1e30f, -1e30f};
                    }
                } else {
#pragma unroll
                    for (int n = 0; n < 4; ++n) { s[mq][n] = s[mq][n] * a.sc2; mx = fmaxf(fmaxf(mx, fmaxf(s[mq][n][0], s[mq][n][1])), fmaxf(s[mq][n][2], s[mq][n][3])); }
                }
                mx = red_rows_max(mx);
                const float mo = mrow[sb][mq], mn = fmaxf(mo, mx);
                const bool grow = __builtin_amdgcn_ballot_w64(mn > mo) != 0;
                mrow[sb][mq] = mn;
                float rsum = 0.f;
#pragma unroll
                for (int n = 0; n < 4; ++n) {
                    if (!natile || (n >= na_nlo && n <= na_nhi)) {
#pragma unroll
                        for (int j = 0; j < 4; ++j) { const float pv = __builtin_amdgcn_exp2f(s[mq][n][j] - mn); s[mq][n][j] = pv; rsum += pv; }
                    } else s[mq][n] = (f32x4){0.f, 0.f, 0.f, 0.f};
                }
                if (grow) {
                    const float alpha = __builtin_amdgcn_exp2f(mo - mn);
                    lrow[sb][mq] *= alpha;
#pragma unroll
                    for (int n = 0; n < 4; ++n) o[sb][mq][n] *= alpha;
                }
                lrow[sb][mq] += rsum;
#pragma unroll
                for (int k2 = 0; k2 < 2; ++k2) {
                    u32x4 w;
                    w.x = cvt_pk_bf16(s[mq][2 * k2][0], s[mq][2 * k2][1]); w.y = cvt_pk_bf16(s[mq][2 * k2][2], s[mq][2 * k2][3]);
                    w.z = cvt_pk_bf16(s[mq][2 * k2 + 1][0], s[mq][2 * k2 + 1][1]); w.w = cvt_pk_bf16(s[mq][2 * k2 + 1][2], s[mq][2 * k2 + 1][3]);
                    pb[sb][mq][k2] = __builtin_bit_cast(bf16x8, w);
                }
            }
        }
#pragma unroll
        for (int k2 = 0; k2 < 2; ++k2) {
            if (natile && (2 * k2 + 1 < na_nlo || 2 * k2 > na_nhi)) continue;
            bf16x8 va[4];
#pragma unroll
            for (int n = 0; n < 4; ++n) {
                const bf16_t* vp = Vsm + (cur * 64 + n * 16 + fr) * GP + 32 * k2 + fq * 4;
                u32x4 w; const u32x2 lo = *(const u32x2*)(vp), hi = *(const u32x2*)(vp + 16);
                w.x = lo.x; w.y = lo.y; w.z = hi.x; w.w = hi.y;
                va[n] = __builtin_bit_cast(bf16x8, w);
            }
#pragma unroll
            for (int sb = 0; sb < NSUB; ++sb)
#pragma unroll
                for (int mq = 0; mq < MQ; ++mq)
#pragma unroll
                    for (int n = 0; n < 4; ++n) o[sb][mq][n] = __builtin_amdgcn_mfma_f32_16x16x32_bf16(va[n], pb[sb][mq][k2], o[sb][mq][n], 0, 0, 0);
        }
        if (more) ATT_LSTORE(cur ^ 1);
        __syncthreads();
    }
#undef ATT_GLOAD
#undef ATT_LSTORE
#undef ATT_TSTART
#pragma unroll
    for (int mq = 0; mq < MQ; ++mq) {
        f32x4 v[4];
        if (NSUB == 1) {
            const float il = 1.f / red_rows_sum(lrow[0][mq]);
#pragma unroll
            for (int n = 0; n < 4; ++n) v[n] = o[0][mq][n] * il;
        } else {
            const float il0 = 1.f / red_rows_sum(lrow[0][mq]), il1 = a.lam / red_rows_sum(lrow[NSUB - 1][mq]);
            float ss = 0.f;
#pragma unroll
            for (int n = 0; n < 4; ++n) { v[n] = o[0][mq][n] * il0 - o[NSUB - 1][mq][n] * il1; ss += v[n][0] * v[n][0] + v[n][1] * v[n][1] + v[n][2] * v[n][2] + v[n][3] * v[n][3]; }
            ss = red_rows_sum(ss);
            const float rstd = rsqrtf(ss * (1.f / 64.f) + 1e-5f) * a.oscale;
#pragma unroll
            for (int n = 0; n < 4; ++n) v[n] = v[n] * rstd * *(const f32x4*)(a.subln + n * 16 + fq * 4);
        }
        bf16_t* op = a.O + (size_t)(wid * QR + mq * 16 + fr) * a.os + fq * 4;
#pragma unroll
        for (int n = 0; n < 4; ++n) { u32x2 w; w.x = cvt_pk_bf16(v[n][0], v[n][1]); w.y = cvt_pk_bf16(v[n][2], v[n][3]); *(u32x2*)(op + n * 16) = w; }
    }
    __syncthreads();
}

template <int N> DEV float rbc(float x) { return __builtin_bit_cast(float, __builtin_amdgcn_update_dpp(0, __builtin_bit_cast(int, x), 0x150 + N, 0xf, 0xf, true)); }
DEV float red_rows(float p) { return red_rows_sum(p); }
#define REP16(M) M(0) M(1) M(2) M(3) M(4) M(5) M(6) M(7) M(8) M(9) M(10) M(11) M(12) M(13) M(14) M(15)
DEV void scan_item(const bf16_t* SC, float* Y, int bl, int h, int dir, const float* k_a, char* smem) {
    const int tid = tid_(), lane = tid & 63, w = tid >> 6, ch = lane, sq = w;
    float* stg = (float*)smem;
    float* yb = stg + 2 * 16 * 6 * 64;
    const float ka = k_a[h * 64 + ch];
    unsigned short pre[4][6];
    float S[16];
#pragma unroll
    for (int j = 0; j < 16; ++j) S[j] = 0.f;
#define SC_TT(s) (dir == 0 ? ((s) < CTXL ? SEQ + (s) : (s) - CTXL) : ((s) < CTXL ? TT - 1 - (s) : SEQ - 1 - ((s) - CTXL)))
#define SC_GL(chunk) do { _Pragma("unroll") for (int _i = 0; _i < 4; ++_i) { const int _s = (chunk) * 16 + sq + 4 * _i; const int _tt = SC_TT(_s); \
        const bf16_t* _b = SC + ((size_t)(bl * TT + _tt)) * 2048 + h * 512 + ch; \
        pre[_i][0] = _b[0]; pre[_i][1] = _b[64]; pre[_i][2] = _b[128]; pre[_i][3] = _b[192]; pre[_i][4] = _b[(4 + dir) * 64]; pre[_i][5] = _b[(6 + dir) * 64]; } } while (0)
#define SC_ST(buf) do { _Pragma("unroll") for (int _i = 0; _i < 4; ++_i) { const int _st = sq + 4 * _i; \
        const float _r = bf2f(pre[_i][0]), _v = bf2f(pre[_i][1]), _k = bf2f(pre[_i][2]), _kk = bf2f(pre[_i][3]), _e = bf2f(pre[_i][4]), _sg = bf2f(pre[_i][5]); \
        float* _d = stg + (((buf) * 16 + _st) * 6) * 64 + ch; \
        _d[0] = -_kk; _d[64] = __expf(-_e); _d[128] = _kk * _sg; _d[192] = _k * (1.f + (_sg - 1.f) * ka); _d[256] = _r; _d[320] = _v; } } while (0)
    SC_GL(0); SC_ST(0);
    __syncthreads();
    constexpr int NCH = TT / 16;
    const int vrow = w * 16 + (lane & 15);
#define FMAC_BC(acc, x, sv, n) asm("v_fmac_f32_dpp %0, %1, %2 row_newbcast:" #n " row_mask:0xf bank_mask:0xf" : "+v"(acc) : "v"(x), "v"(sv))
#define MUL_BC(dst, x, sv, n) asm("v_mul_f32_dpp %0, %1, %2 row_newbcast:" #n " row_mask:0xf bank_mask:0xf" : "=v"(dst) : "v"(x), "v"(sv))
#define SC_LOAD(st_, A, W, B, K, R, V) do { const float* _dn = d0 + (st_) * 384; A = _dn[lane]; W = _dn[64 + lane]; B = _dn[128 + lane]; K = _dn[192 + lane]; R = _dn[256 + lane]; V = _dn[320 + vrow]; } while (0)
#define SA_(n) if ((n) & 1) FMAC_BC(p1, cA, S[n], n); else FMAC_BC(p0, cA, S[n], n);
#define UP_(n) { float t; MUL_BC(t, cW, S[n], n); FMAC_BC(t, cB, sa, n); FMAC_BC(t, cK, cV, n); S[n] = t; if ((n) & 1) FMAC_BC(y1, cR, t, n); else FMAC_BC(y0, cR, t, n); }
#define SC_STEP(st_, cA, cW, cB, cK, cR, cV) do { float p0 = 0.f, p1 = 0.f; REP16(SA_) const float sa = red_rows(p0 + p1); float y0 = 0.f, y1 = 0.f; REP16(UP_) \
        yb[((st_) * 4 + (lane >> 4)) * 64 + vrow] = y0 + y1; } while (0)
    for (int chunk = 0; chunk < NCH; ++chunk) {
        const int buf = chunk & 1;
        if (chunk + 1 < NCH) SC_GL(chunk + 1);
        const float* d0 = stg + (buf * 16 * 6) * 64;
        float a0, w0, b0, k0, r0, v0, a1, w1, b1, k1, r1, v1;
        SC_LOAD(0, a0, w0, b0, k0, r0, v0);
#pragma unroll 4
        for (int st = 0; st < 16; st += 2) {
            SC_LOAD(st + 1, a1, w1, b1, k1, r1, v1);
#define cA a0
#define cW w0
#define cB b0
#define cK k0
#define cR r0
#define cV v0
            SC_STEP(st, a0, w0, b0, k0, r0, v0);
#undef cA
#undef cW
#undef cB
#undef cK
#undef cR
#undef cV
            if (st + 2 < 16) SC_LOAD(st + 2, a0, w0, b0, k0, r0, v0);
#define cA a1
#define cW w1
#define cB b1
#define cK k1
#define cR r1
#define cV v1
            SC_STEP(st + 1, a1, w1, b1, k1, r1, v1);
#undef cA
#undef cW
#undef cB
#undef cK
#undef cR
#undef cV
        }
        __syncthreads();
#pragma unroll
        for (int i = 0; i < 4; ++i) {
            const int st = sq + 4 * i, s_ = chunk * 16 + st, tt = SC_TT(s_);
            ((bf16_t*)Y)[((size_t)dir * T_ALL + (size_t)bl * TT + tt) * 256 + h * 64 + ch] = f2bf((yb[(st * 4) * 64 + ch] + yb[(st * 4 + 1) * 64 + ch]) + (yb[(st * 4 + 2) * 64 + ch] + yb[(st * 4 + 3) * 64 + ch]));
        }
        if (chunk + 1 < NCH) SC_ST(buf ^ 1);
        __syncthreads();
    }
#undef SC_TT
#undef SC_GL
#undef SC_ST
#undef FMAC_BC
#undef MUL_BC
#undef SC_LOAD
#undef SA_
#undef UP_
#undef SC_STEP
}

DEV void phase_norm(const Params& p, int l, int which, bool skip_ctx) {
    const float* gam = p.in[which ? 5 : 4] + l * D;
    const float* mod = (const float*)(p.ws + OFF_MOD) + (size_t)l * 33 * 6144;
    bf16_t* H = (bf16_t*)(p.ws + OFF_H);
    const int lane = tid_() & 63, wave = blockIdx.x * 4 + (tid_() >> 6), nw = gridDim.x * 4;
    for (int g0 = wave; g0 < T_ALL; g0 += 2 * nw) {
        f32x4 v[2][4]; const float* m[2]; bool act[2];
#pragma unroll
        for (int u = 0; u < 2; ++u) {
            const int g = g0 + u * nw; act[u] = g < T_ALL;
            const int gg = act[u] ? g : g0;
            const int b = gg / TT, tt = gg - b * TT; const bool lat = tt < SEQ;
            if (!lat && skip_ctx) act[u] = false;
            const float* x = (l == 0 && which == 0) ? xrow_in(p, gg) : xrow(p, gg);
            m[u] = mod + (size_t)(lat ? b : 32) * 6144 + (which ? 3072 : 0);
#pragma unroll
            for (int i = 0; i < 4; ++i) v[u][i] = *(const f32x4*)(x + i * 256 + lane * 4);
        }
#pragma unroll
        for (int u = 0; u < 2; ++u) {
            float ss = 0.f;
#pragma unroll
            for (int i = 0; i < 4; ++i) ss += v[u][i][0] * v[u][i][0] + v[u][i][1] * v[u][i][1] + v[u][i][2] * v[u][i][2] + v[u][i][3] * v[u][i][3];
            ss = wave_sum_fast(ss);
            const float rstd = rsqrtf(ss * (1.f / 1024.f) + 1e-6f);
            if (act[u]) {
                const int g = g0 + u * nw;
#pragma unroll
                for (int i = 0; i < 4; ++i) {
                    const int col = i * 256 + lane * 4;
                    const f32x4 g4 = *(const f32x4*)(gam + col), sh = *(const f32x4*)(m[u] + col), sc = *(const f32x4*)(m[u] + 1024 + col);
                    const f32x4 o = v[u][i] * rstd * g4 * (sc + 1.f) + sh;
                    u32x2 w; w.x = pk2(o[0], o[1]); w.y = pk2(o[2], o[3]);
                    *(u32x2*)(H + (size_t)g * 1024 + col) = w;
                }
            }
        }
    }
}

DEV void phase_final(const Params& p) {
    const float* gam = p.in[32];
    const int lane = tid_() & 63, wave = blockIdx.x * 4 + (tid_() >> 6), nw = gridDim.x * 4;
    for (int g = wave; g < NBATCH * SEQ; g += nw) {
        float* x = p.out + (size_t)g * D;
        f32x4 v[4]; float ss = 0.f;
#pragma unroll
        for (int i = 0; i < 4; ++i) { v[i] = *(const f32x4*)(x + i * 256 + lane * 4); ss += v[i][0] * v[i][0] + v[i][1] * v[i][1] + v[i][2] * v[i][2] + v[i][3] * v[i][3]; }
        ss = wave_sum(ss);
        const float rstd = rsqrtf(ss * (1.f / 1024.f) + 1e-6f);
#pragma unroll
        for (int i = 0; i < 4; ++i) { const int col = i * 256 + lane * 4; *(f32x4*)(x + col) = v[i] * rstd * *(const f32x4*)(gam + col); }
    }
}

DEV void phase_prep(const Params& p, int l, int c) {
    char* scr = p.ws + OFF_SCR;
    const bf16_t* ZR = (const bf16_t*)(scr + SO_ZR);
    bf16_t* SC = (bf16_t*)(scr + SO_SC) + (size_t)c * TC * 2048; bf16_t* AWA = (bf16_t*)(scr + SO_AWA); bf16_t* AG = (bf16_t*)(scr + SO_AG) + (size_t)c * TC * 64;
    float* rsq = (float*)(p.ws + OFF_RSQ); float* rskv = (float*)(p.ws + OFF_RSKV);
    const float* mu0 = p.in[15] + (size_t)l * 2 * 896; const float* mu1 = mu0 + 896;
    const int lane = tid_() & 63, wave = blockIdx.x * 4 + (tid_() >> 6), nw = gridDim.x * 4;
    f32x4 m0[3], m1[3];
#pragma unroll
    for (int s3 = 0; s3 < 3; ++s3) { m0[s3] = *(const f32x4*)(mu0 + s3 * 256 + lane * 4); m1[s3] = *(const f32x4*)(mu1 + s3 * 256 + lane * 4); }
    const f32x4 kk4 = *(const f32x4*)(p.in[21] + l * 256 + lane * 4);
    const float mw0 = mu0[768 + lane], mw1 = mu1[768 + lane], mg0 = mu0[832 + lane], mg1 = mu1[832 + lane];
    for (int t0 = wave; t0 < TC; t0 += 2 * nw) {
        u32x2 q[2], c0[2][3], cp[2][3], cn[2][3]; unsigned kv[2]; bf16_t wz[2][3], gz[2][3]; bool act[2], hp[2], hn[2];
#pragma unroll
        for (int u = 0; u < 2; ++u) {
            const int t = t0 + u * nw; act[u] = t < TC;
            const int ts = act[u] ? t : t0, tt = ts % TT;
            hp[u] = !(tt == 0 || tt == SEQ); hn[u] = !(tt == SEQ - 1 || tt == TT - 1);
            const bf16_t* z = ZR + (size_t)ts * ZRW;
            const bf16_t* zp = hp[u] ? z - ZRW : z; const bf16_t* zn = hn[u] ? z + ZRW : z;
            q[u] = *(const u32x2*)(z + 768 + lane * 4); kv[u] = *(const unsigned*)(z + 1024 + lane * 2);
#pragma unroll
            for (int s3 = 0; s3 < 3; ++s3) { const int col = s3 * 256 + lane * 4; c0[u][s3] = *(const u32x2*)(z + col); cp[u][s3] = *(const u32x2*)(zp + col); cn[u][s3] = *(const u32x2*)(zn + col); }
            wz[u][0] = z[1184 + lane]; wz[u][1] = zp[1184 + lane]; wz[u][2] = zn[1184 + lane];
            gz[u][0] = z[1280 + lane]; gz[u][1] = zp[1280 + lane]; gz[u][2] = zn[1280 + lane];
        }
#pragma unroll
        for (int u = 0; u < 2; ++u) {
            const int t = t0 + u * nw;
            const float fp = hp[u] ? 1.f : 0.f, fn = hn[u] ? 1.f : 0.f;
            float s = lo_bf(q[u].x) * lo_bf(q[u].x) + hi_bf(q[u].x) * hi_bf(q[u].x) + lo_bf(q[u].y) * lo_bf(q[u].y) + hi_bf(q[u].y) * hi_bf(q[u].y);
            s = wave_sum_fast(s);
            float s2 = lo_bf(kv[u]) * lo_bf(kv[u]) + hi_bf(kv[u]) * hi_bf(kv[u]);
            s2 = wave_sum_fast(s2);
            float zs[3][4];
#pragma unroll
            for (int s3 = 0; s3 < 3; ++s3) {
                const float zc[4] = {lo_bf(c0[u][s3].x), hi_bf(c0[u][s3].x), lo_bf(c0[u][s3].y), hi_bf(c0[u][s3].y)};
                const float zp[4] = {lo_bf(cp[u][s3].x) * fp, hi_bf(cp[u][s3].x) * fp, lo_bf(cp[u][s3].y) * fp, hi_bf(cp[u][s3].y) * fp};
                const float zn[4] = {lo_bf(cn[u][s3].x) * fn, hi_bf(cn[u][s3].x) * fn, lo_bf(cn[u][s3].y) * fn, hi_bf(cn[u][s3].y) * fn};
#pragma unroll
                for (int i = 0; i < 4; ++i) zs[s3][i] = zc[i] + m0[s3][i] * (zp[i] - zc[i]) + m1[s3][i] * (zn[i] - zc[i]);
            }
            float kk[4]; float ss = 0.f;
#pragma unroll
            for (int i = 0; i < 4; ++i) { kk[i] = zs[1][i] * kk4[i]; ss += kk[i] * kk[i]; }
            ss = sum16(ss);
            const float inv = rsqrtf(fmaxf(ss, 1e-24f));
            float vw, vg;
            { const float zc = bf2f(wz[u][0]), zp = bf2f(wz[u][1]) * fp, zn = bf2f(wz[u][2]) * fn; vw = zc + mw0 * (zp - zc) + mw1 * (zn - zc); }
            { const float zc = bf2f(gz[u][0]), zp = bf2f(gz[u][1]) * fp, zn = bf2f(gz[u][2]) * fn; vg = zc + mg0 * (zp - zc) + mg1 * (zn - zc); }
            if (act[u]) {
                if (lane == 0) { rsq[t] = rsqrtf(s * (1.f / 256.f) + 1e-6f); rskv[t] = rsqrtf(s2 * (1.f / 128.f) + 1e-6f); }
                const int h = lane >> 4, j = (lane & 15) * 4;
                bf16_t* sc = SC + (size_t)t * 2048 + h * 512 + j;
                u32x2 w;
                w.x = pk2(zs[0][0], zs[0][1]); w.y = pk2(zs[0][2], zs[0][3]); *(u32x2*)(sc) = w;
                w.x = pk2(zs[2][0], zs[2][1]); w.y = pk2(zs[2][2], zs[2][3]); *(u32x2*)(sc + 64) = w;
                w.x = pk2(zs[1][0], zs[1][1]); w.y = pk2(zs[1][2], zs[1][3]); *(u32x2*)(sc + 128) = w;
                w.x = pk2(kk[0] * inv, kk[1] * inv); w.y = pk2(kk[2] * inv, kk[3] * inv); *(u32x2*)(sc + 192) = w;
                AWA[(size_t)t * 64 + lane] = f2bf(lane < 32 ? 2.f * sigmoidf_(2.f * vw) - 1.f : vw);
                AG[(size_t)t * 64 + lane] = f2bf(sigmoidf_(vg));
            }
        }
    }
}

DEV void phase_gemm_small(const Params& p, int l, int c, char* smem) {
    char* scr = p.ws + OFF_SCR;
    const bf16_t* ZR = (const bf16_t*)(scr + SO_ZR);
    const float* cosT = (const float*)(p.ws + OFF_COS); const float* sinT = (const float*)(p.ws + OFF_SIN);
    EpiUQ euq{(bf16_t*)(scr + SO_MQ), (const float*)(p.ws + OFF_RSQ), cosT, sinT};
    EpiUKV eukv{(bf16_t*)(scr + SO_KN), (bf16_t*)(scr + SO_VTM), (const float*)(p.ws + OFF_RSKV)};
    EpiWA ewa{(bf16_t*)(scr + SO_SC) + (size_t)c * TC * 2048, p.in[16] + (size_t)l * 512, p.in[18] + (size_t)l * 512};
    constexpr int NTM = TC / 128;
    constexpr int T1 = NTM * 3, T2 = T1 + NTM * 4, T3 = T2 + NTM * 8;
    for (int t = blockIdx.x; t < T3; t += gridDim.x) {
        if (t < T1) { const int tm = t / 3, tn = t - tm * 3; gemm_tile(ZR + 768, ZRW, wl(p, l, WE_UQ), 256, 256, tm, tn, smem, euq); }
        else if (t < T2) { const int u = t - T1, tm = u >> 2, tn = u & 3; gemm_tile(ZR + 1024, ZRW, wl(p, l, WE_UKV), 128, 128, tm, tn, smem, eukv); }
        else { const int u = t - T2, tm = u >> 3, tn = u & 7; gemm_tile((const bf16_t*)(scr + SO_AWA), 64, wl(p, l, WE_WA), 64, 64, tm, tn, smem, ewa); }
    }
}

DEV void phase_mix(const Params& p, int l, int c, int phase_idx, char* smem, int rmask, int* s_item) {
    char* scr = p.ws + OFF_SCR;
    const bf16_t* QK = (const bf16_t*)(scr + SO_QK); const bf16_t* ZR = (const bf16_t*)(scr + SO_ZR);
    const bf16_t* MQ = (const bf16_t*)(scr + SO_MQ); const bf16_t* KN = (const bf16_t*)(scr + SO_KN);
    const bf16_t* VtNA = (const bf16_t*)(scr + SO_VTNA); const bf16_t* VtD = (const bf16_t*)(scr + SO_VTD); const bf16_t* VtM = (const bf16_t*)(scr + SO_VTM);
    bf16_t* MIX = (bf16_t*)(p.ws + OFF_H) + (size_t)c * TC * 1024;
    int* ctr = (int*)(p.ws + OFF_CTR) + phase_idx;
    const bool need_ctx = l < DEPTH - 1;
    const float lam = ((const float*)(p.ws + OFF_LAM))[l];
    const float lam_init = 0.8f - 0.6f * expf(-0.3f * (float)l);
    constexpr int DQ = 64 * DMQ, DLT = SEQ / DQ, DCT = CTXL / DQ;
    const int N_SCAN = (c == NCHUNK - 1) ? NBATCH * 8 : 0; constexpr int N_ML = CB * 64, N_DL = CB * 4 * DLT, N_NL = CB * 128, N_MC = CB * 8, N_DC = CB * 4 * DCT, N_NC = CB * 16;
    const int E0 = N_SCAN, E1 = E0 + N_ML, E2 = E1 + N_DL, E3 = E2 + N_NL, E4 = E3 + N_MC, E5 = E4 + N_DC, E6 = E5 + N_NC;
    const int total = need_ctx ? E6 : E3;
    constexpr float L2E = 1.44269504f;
    if (rmask & 1) for (int it = blockIdx.x; it < N_SCAN; it += gridDim.x) {
        const int bl = it >> 3, h = (it >> 1) & 3, dir = it & 1;
        __builtin_amdgcn_s_setprio(3);
        scan_item((const bf16_t*)(scr + SO_SC), (float*)(scr + SO_Y), bl, h, dir, p.in[22] + l * 256, smem);
        __builtin_amdgcn_s_setprio(0);
    }
    for (;;) {
        if (tid_() == 0) *s_item = E0 + atomicAdd(ctr, 1);
        __syncthreads();
        const int it = __builtin_amdgcn_readfirstlane(*s_item);
        __syncthreads();
        if (it >= total) break;
        if (!(rmask & 2)) continue;
        AttnArgs a{};
        if (it < E0) {
        } else if (it < E1 || (it >= E3 && it < E4)) {
            const bool cx = it >= E3; int bl, h, q0;
            if (!cx) { const int u = it - E0; bl = u >> 6; h = (u >> 4) & 3; q0 = (u & 15) * 128; }
            else { const int u = it - E3; bl = u >> 3; h = (u >> 1) & 3; q0 = SEQ + (u & 1) * 128; }
            const size_t tb = (size_t)bl * TT;
            a.Q = MQ + (tb + q0) * 384 + h * 96; a.qs = 384;
            a.K = KN + tb * 256 + h * 64; a.ks = 256; a.K2 = ZR + tb * ZRW + 1152; a.k2s = ZRW;
            a.Vt = VtM + ((size_t)(bl * 4 + h) * 64) * TT;
            a.O = MIX + (tb + q0) * 1024 + 256 + h * 64; a.os = 1024;
            a.kstart = cx ? SEQ : 0; a.nkt = cx ? 4 : 36; a.sc2 = 0.10206207261596575f * L2E;
            if (MIXMASK & 2) attn_item<96, 1, 2, false>(a, smem);
        } else if (it < E2 || (it >= E4 && it < E5)) {
            const bool cx = it >= E4; int bl, h, q0;
            if (!cx) { const int u = it - E1; bl = u / (4 * DLT); h = (u / DLT) & 3; q0 = (u % DLT) * DQ; }
            else { const int u = it - E4; bl = u / (4 * DCT); h = (u / DCT) & 3; q0 = SEQ + (u % DCT) * DQ; }
            const size_t tb = (size_t)bl * TT;
            a.Q = QK + (tb + q0) * 1024 + 512 + h * 64; a.qs = 1024;
            a.K = QK + tb * 1024 + 768 + h * 64; a.ks = 1024;
            a.Vt = VtD + ((size_t)(bl * 4 + h) * 64) * TT;
            a.O = MIX + (tb + q0) * 1024 + 768 + h * 64; a.os = 1024;
            a.kstart = cx ? SEQ : 0; a.nkt = cx ? 4 : 36; a.sc2 = 0.17677669529663687f * L2E;
            a.lam = lam; a.oscale = 1.f - lam_init; a.subln = p.in[27] + l * 64;
            if (MIXMASK & 4) attn_item<64, 2, DMQ, false>(a, smem);
        } else {
            const bool cx = it >= E5; int bl, h, q0;
            if (!cx) { const int u = it - E2; bl = u >> 7; h = (u >> 5) & 3; const int r = u & 31; q0 = r * 64; a.na_r = r; a.na_rs = min(max(r - 4, 0), 24); }
            else { const int u = it - E5; bl = u >> 4; h = (u >> 2) & 3; q0 = SEQ + (u & 3) * 64; }
            const size_t tb = (size_t)bl * TT;
            a.Q = QK + (tb + q0) * 1024 + h * 64; a.qs = 1024;
            a.K = QK + tb * 1024 + 256 + h * 64; a.ks = 1024;
            a.Vt = VtNA + ((size_t)(bl * 4 + h) * 64) * TT;
            a.O = MIX + (tb + q0) * 1024 + h * 64; a.os = 1024;
            a.sc2 = 0.125f * L2E; a.rpb = p.in[10] + ((size_t)l * 4 + h) * 465;
            if (!cx) { a.nkt = 12; if (MIXMASK & 8) attn_item<64, 1, 1, true>(a, smem); }
            else { a.kstart = SEQ; a.nkt = 4; if (MIXMASK & 16) attn_item<64, 1, 1, false>(a, smem); }
        }
    }
}

DEV void phase_fix(const Params& p, int l) {
    char* scr = p.ws + OFF_SCR;
    bf16_t* G = (bf16_t*)(scr + SO_G); const float* E = (const float*)(scr + SO_E);
    const float* cw = p.in[29] + (size_t)l * 3 * DFF;
    const bool skip_ctx = !(l < DEPTH - 1);
    constexpr int NTM = T_ALL / 128;
    const int total = NTM * (DFF / 4);
    for (int idx = blockIdx.x * NTHR + tid_(); idx < total; idx += gridDim.x * NTHR) {
        const int tm = idx / (DFF / 4), j = (idx - tm * (DFF / 4)) * 4;
        const int row0 = tm * 128, tt0 = row0 % TT;
        if (skip_ctx && tt0 >= SEQ) continue;
        const bool first = (tt0 == 0 || tt0 == SEQ), last = (tt0 + 127 == SEQ - 1 || tt0 + 127 == TT - 1);
        if (!first) {
            const float* e = E + ((size_t)tm * 6) * DFF + j; const float* ep = E + ((size_t)(tm - 1) * 6 + 5) * DFF + j;
            const f32x4 pre = *(const f32x4*)(e) + *(const f32x4*)(cw + j) * *(const f32x4*)(ep), bv = *(const f32x4*)(e + DFF);
            u32x2 w; w.x = pk2(siluf_(pre[0]) * bv[0], siluf_(pre[1]) * bv[1]); w.y = pk2(siluf_(pre[2]) * bv[2], siluf_(pre[3]) * bv[3]);
            *(u32x2*)(G + (size_t)row0 * DFF + j) = w;
        }
        if (!last) {
            const float* e = E + ((size_t)tm * 6 + 3) * DFF + j; const float* en = E + ((size_t)(tm + 1) * 6 + 2) * DFF + j;
            const f32x4 pre = *(const f32x4*)(e) + *(const f32x4*)(cw + 2 * DFF + j) * *(const f32x4*)(en), bv = *(const f32x4*)(e + DFF);
            u32x2 w; w.x = pk2(siluf_(pre[0]) * bv[0], siluf_(pre[1]) * bv[1]); w.y = pk2(siluf_(pre[2]) * bv[2], siluf_(pre[3]) * bv[3]);
            *(u32x2*)(G + (size_t)(row0 + 127) * DFF + j) = w;
        }
    }
}

DEV int cm_in(int n) {
    if (n < 768) return n;
    if (n < 1536) return 2080 + (n - 768);
    if (n < 2304) return 1184 + (n - 1536);
    if (n < 2560) return 768 + (n - 2304);
    if (n < 2688) return 1024 + (n - 2560);
    if (n < 2816) { const int o = n - 2688; return o < 32 ? 1152 + o : (o < 64 ? 1952 + (o - 32) : (o < 96 ? 1984 + (o - 64) : -1)); }
    { const int o = n - 2816; return o < 64 ? 2016 + o : -1; }
}
DEV int cm_up(int n) { const int t = n >> 7, o = n & 127; return o < 64 ? t * 64 + o : DFF + t * 64 + (o - 64); }

template <int MODE>
DEV void conv_unit(const float* src, int lds_, bf16_t* dst, int K, int nt, int kt, float* tile) {
    const int tid = tid_(), a = tid & 63, b = tid >> 6;
    const int n = nt * 64 + a;
    const int col = MODE == 0 ? cm_in(n) : (MODE == 2 ? cm_up(n) : n);
#pragma unroll 4
    for (int i = 0; i < 16; ++i) { const int kl = b + 4 * i; tile[kl * 65 + a] = col >= 0 ? src[(size_t)(kt * 64 + kl) * lds_ + col] : 0.f; }
    __syncthreads();
#pragma unroll 4
    for (int i = 0; i < 16; ++i) { const int nl = b + 4 * i; dst[(size_t)(nt * 64 + nl) * K + kt * 64 + a] = f2bf(tile[a * 65 + nl]); }
    __syncthreads();
}

DEV void phase_prologue(const Params& p, char* smem) {
    const int tid = tid_(), gtid = blockIdx.x * NTHR + tid, gsz = gridDim.x * NTHR;
    if (blockIdx.x == 0) {
        int* ctr = (int*)(p.ws + OFF_CTR); ctr[tid] = 0;
        if (tid < DEPTH) {
            const float* lp = p.in[26] + tid * 128; float s0 = 0.f, s1 = 0.f;
            for (int i = 0; i < 32; ++i) { s0 += lp[i] * lp[32 + i]; s1 += lp[64 + i] * lp[96 + i]; }
            ((float*)(p.ws + OFF_LAM))[tid] = expf(s0) - expf(s1) + (0.8f - 0.6f * expf(-0.3f * (float)tid));
        }
    }
    for (int i = gtid; i < 2048 * 16; i += gsz) {
        const int tt = i >> 4, f = i & 15; const float pos = (float)(f < 8 ? tt / 64 : tt % 64);
        const float freq = powf(10000.f, -(float)(f & 7) / 8.f); const float ang = pos * freq;
        ((float*)(p.ws + OFF_COS))[i] = cosf(ang); ((float*)(p.ws + OFF_SIN))[i] = sinf(ang);
    }
    for (int i = gtid; i < DEPTH * 245760; i += gsz) {
        const int l = i / 245760; int e = i - l * 245760;
        if (e < 98304) { const int n = e >> 8, k = e & 255; wlw(p, l, WE_UQ)[e] = f2bf(p.in[13][((size_t)l * 256 + k) * 384 + n] * p.in[11][l * 256 + k]); }
        else if ((e -= 98304) < 65536) { const int n = e >> 7, k = e & 127; wlw(p, l, WE_UKV)[e] = f2bf(p.in[14][((size_t)l * 128 + k) * 512 + n] * p.in[12][l * 128 + k]); }
        else if ((e -= 65536) < 65536) { const int n = e >> 6, k = e & 63, seg = n >> 8, ch = n & 255; float v = 0.f;
            if (seg < 2) { if (k < 32) v = p.in[17][(((size_t)l * 2 + seg) * 32 + k) * 256 + ch]; }
            else { if (k >= 32) v = p.in[19][(((size_t)l * 2 + (seg - 2)) * 32 + (k - 32)) * 256 + ch]; }
            wlw(p, l, WE_WA)[e] = f2bf(v); }
        else { e -= 65536; const int n = e >> 6, k = e & 63; wlw(p, l, WE_G)[e] = f2bf(p.in[20][((size_t)l * 64 + k) * 256 + n]); }
    }
    {
        constexpr int U_IN = (ZN / 64) * 16, U_OUT = 16 * 16, U_UP = 88 * 16, U_DN = 16 * 44, U_L = U_IN + U_OUT + U_UP + U_DN;
        float* tile = (float*)smem;
        for (int u = blockIdx.x; u < DEPTH * U_L; u += gridDim.x) {
            const int l = u / U_L; int e = u - l * U_L;
            if (e < U_IN) conv_unit<0>(p.in[8] + (size_t)l * 1024 * 2848, 2848, wlw(p, l, WE_IN), 1024, e >> 4, e & 15, tile);
            else if ((e -= U_IN) < U_OUT) conv_unit<1>(p.in[9] + (size_t)l * 1024 * 1024, 1024, wlw(p, l, WE_OUT), 1024, e >> 4, e & 15, tile);
            else if ((e -= U_OUT) < U_UP) conv_unit<2>(p.in[28] + (size_t)l * 1024 * 5632, 5632, wlw(p, l, WE_UP), 1024, e >> 4, e & 15, tile);
            else { e -= U_UP; conv_unit<1>(p.in[31] + (size_t)l * 2816 * 1024, 1024, wlw(p, l, WE_DOWN), 2816, e / 44, e % 44, tile); }
        }
    }
    {
        float* Ssm = (float*)smem;
        float* red = Ssm + 33 * 128;
        const int lane = tid & 63, w = tid >> 6;
        for (int u = blockIdx.x; u < DEPTH * 96; u += gridDim.x) {
            const int l = u / 96, n0 = (u - l * 96) * 64;
            const float* W = p.in[6] + (size_t)l * 1024 * 6144 + n0 + lane;
            float acc[33];
#pragma unroll
            for (int r = 0; r < 33; ++r) acc[r] = 0.f;
            for (int kc = 0; kc < 8; ++kc) {
                __syncthreads();
                for (int i = tid; i < 33 * 128; i += NTHR) { const int r = i >> 7, k = kc * 128 + (i & 127); const float cv = r < 32 ? p.in[1][r * 1024 + k] : p.in[3][k]; Ssm[i] = siluf_(cv); }
                __syncthreads();
                for (int kk = 0; kk < 32; ++kk) {
                    const int kl = w * 32 + kk; const float wv = W[(size_t)(kc * 128 + kl) * 6144];
#pragma unroll
                    for (int r = 0; r < 33; ++r) acc[r] += Ssm[r * 128 + kl] * wv;
                }
            }
#pragma unroll
            for (int r = 0; r < 33; ++r) red[(w * 33 + r) * 64 + lane] = acc[r];
            __syncthreads();
            for (int i = tid; i < 33 * 64; i += NTHR) {
                const int r = i >> 6, n = i & 63;
                const float v = red[(0 * 33 + r) * 64 + n] + red[(1 * 33 + r) * 64 + n] + red[(2 * 33 + r) * 64 + n] + red[(3 * 33 + r) * 64 + n];
                ((float*)(p.ws + OFF_MOD))[((size_t)l * 33 + r) * 6144 + n0 + n] = v + p.in[7][(size_t)l * 6144 + n0 + n];
            }
            __syncthreads();
        }
    }
}

constexpr int PH_PER_LAYER = 15, N_PHASES = 2 + DEPTH * PH_PER_LAYER;

DEV void run_phase(const Params& p, int ph, char* smem, int ctr_off, int* s_item) {
    if (ph == 0) { phase_prologue(p, smem); return; }
    if (ph == N_PHASES - 1) { phase_final(p); return; }
    const int l = (ph - 1) / PH_PER_LAYER, s = (ph - 1) % PH_PER_LAYER;
    const bool last_layer = (l == DEPTH - 1);
    char* scr = p.ws + OFF_SCR;
    const float* mod = (const float*)(p.ws + OFF_MOD) + (size_t)l * 33 * 6144;
    const bf16_t* H = (const bf16_t*)(p.ws + OFF_H);
    if (s == 0) { phase_norm(p, l, 0, false); return; }
    if (s >= 1 && s <= 8) {
        const int c = (s - 1) / 4, q = (s - 1) % 4;
        if (q == 0) {
            EpiIn e{(bf16_t*)(scr + SO_QK), (bf16_t*)(scr + SO_ZR), (bf16_t*)(scr + SO_VTNA), (bf16_t*)(scr + SO_VTD), (const float*)(p.ws + OFF_COS), (const float*)(p.ws + OFF_SIN)};
            gemm_phase(H + (size_t)c * TC * 1024, 1024, wl(p, l, WE_IN), 1024, 1024, TC / 128, ZN / 128, false, smem, e);
        } else if (q == 1) phase_prep(p, l, c);
        else if (q == 2) phase_gemm_small(p, l, c, smem);
        else phase_mix(p, l, c, ph + ctr_off, smem, ctr_off ? PROBE_MIXSEL : 3, s_item);
        return;
    }
    if (s == 9) {
        EpiG e{(bf16_t*)(p.ws + OFF_H), (const bf16_t*)(scr + SO_SC), (const float*)(scr + SO_Y), p.in[23] + l * 256, p.in[24] + l * 256, p.in[25] + l * 256, 0};
        gemm_phase((const bf16_t*)(scr + SO_AG), 64, wl(p, l, WE_G), 64, 64, T_ALL / 128, 2, last_layer, smem, e);
        return;
    }
    if (s == 10) { EpiRes e{&p, mod, 2048, l == 0 ? 1 : 0}; gemm_phase(H, 1024, wl(p, l, WE_OUT), 1024, 1024, T_ALL / 128, 8, last_layer, smem, e); return; }
    if (s == 11) { phase_norm(p, l, 1, last_layer); return; }
    if (s == 12) { EpiUp e{(bf16_t*)(scr + SO_G), (float*)(scr + SO_E), p.in[29] + (size_t)l * 3 * DFF, p.in[30] + (size_t)l * DFF};
                   gemm_phase(H, 1024, wl(p, l, WE_UP), 1024, 1024, T_ALL / 128, 44, last_layer, smem, e); return; }
    if (s == 13) { phase_fix(p, l); return; }
    { EpiRes e{&p, mod, 5120, 0}; gemm_phase((const bf16_t*)(scr + SO_G), DFF, wl(p, l, WE_DOWN), DFF, DFF, T_ALL / 128, 8, last_layer, smem, e); }
}

#define XB_TMO      128
#define XB_XCNT(j)  (256  + 64 * (j))
#define XB_XSUB(j)  (1280 + 64 * (j))
#define XB_XGEN(j)  (2304 + 64 * (j))
#define XB_TOP      3328
#define XB_TOPGEN   3392
#define XCD_BAR_WORDS 3456
#define XB_SPIN_CAP (1u << 18)

__device__ __forceinline__ unsigned xb_ld(unsigned* p)              { return __hip_atomic_load(p, __ATOMIC_RELAXED, __HIP_MEMORY_SCOPE_AGENT); }
__device__ __forceinline__ unsigned xb_add(unsigned* p, unsigned v) { return __hip_atomic_fetch_add(p, v, __ATOMIC_RELAXED, __HIP_MEMORY_SCOPE_AGENT); }
__device__ __forceinline__ unsigned xb_xcc_id() { return (unsigned)__builtin_amdgcn_s_getreg((3 << 11) | 20) & 0xFu; }
#define XB_SPIN(cond, bar) do { unsigned _sp = 0; while (cond) { __builtin_amdgcn_s_sleep(1); \
    if ((++_sp & 255u) == 0u) { if (xb_ld(&(bar)[XB_TMO])) break; if (_sp > XB_SPIN_CAP) { atomicAdd(&(bar)[XB_TMO], 1u); break; } } } } while (0)

struct XcdBarrier {
    unsigned* bar; unsigned x;
    volatile LAS unsigned* st;
};

__device__ __forceinline__ XcdBarrier xcd_barrier_post(unsigned* bar, volatile LAS unsigned* st) {
    XcdBarrier b; b.bar = bar; b.x = xb_xcc_id(); b.st = st;
    if (threadIdx.x == 0) (void)xb_add(&bar[XB_XCNT(b.x)], 1u);
    return b;
}
__device__ __forceinline__ void xcd_barrier_complete(unsigned* bar, unsigned x, unsigned& nloc, unsigned& nx) {
    const unsigned G = gridDim.x * gridDim.y * gridDim.z;
    unsigned sum, cnt, mine, sp = 0u;
    for (;;) {
        sum = 0u; cnt = 0u; mine = 0u;
#pragma unroll
        for (unsigned j = 0; j < 16; ++j) { const unsigned c = xb_ld(&bar[XB_XCNT(j)]); sum += c; cnt += (c > 0u) ? 1u : 0u; mine = (j == x) ? c : mine; }
        if (sum == G) break;
        __builtin_amdgcn_s_sleep(1);
        if ((++sp & 255u) == 0u) { if (xb_ld(&bar[XB_TMO])) break; if (sp > XB_SPIN_CAP) { atomicAdd(&bar[XB_TMO], 1u); break; } }
    }
    nloc = mine > 0u ? mine : 1u; nx = cnt > 0u ? cnt : 1u;
}

__device__ __forceinline__ void xcd_barrier(const XcdBarrier& b) {
    asm volatile("s_waitcnt vmcnt(0)" ::: "memory");
    __syncthreads();
    if (threadIdx.x == 0) {
        unsigned* bar = b.bar;
        __builtin_amdgcn_s_waitcnt(0);
        unsigned nloc = b.st[0], nx = b.st[1];
        if (nloc == 0u) { xcd_barrier_complete(bar, b.x, nloc, nx); b.st[0] = nloc; b.st[1] = nx; }
        const unsigned old = xb_add(&bar[XB_XSUB(b.x)], 1u);
        const unsigned gen = old / nloc;
        if (old + 1u == (gen + 1u) * nloc) {
            __builtin_amdgcn_fence(__ATOMIC_RELEASE, "agent");
            asm volatile("s_waitcnt vmcnt(0)" ::: "memory");
            const unsigned og = xb_add(&bar[XB_TOP], 1u);
            const unsigned tg = og / nx;
            if (og + 1u == (tg + 1u) * nx) xb_add(&bar[XB_TOPGEN], 1u);
            else XB_SPIN(xb_ld(&bar[XB_TOPGEN]) == tg, bar);
            __builtin_amdgcn_fence(__ATOMIC_ACQUIRE, "agent");
            xb_add(&bar[XB_XGEN(b.x)], 1u);
            asm volatile("s_waitcnt vmcnt(0)" ::: "memory");
        } else {
            XB_SPIN(xb_ld(&bar[XB_XGEN(b.x)]) == gen, bar);
            __builtin_amdgcn_fence(__ATOMIC_ACQUIRE, "agent");
            asm volatile("s_waitcnt vmcnt(0)" ::: "memory");
        }
    }
    __syncthreads();
}


__global__ void __launch_bounds__(NTHR, 2) mk_fwd(Params p, int ph_lo, int ph_hi) {
    extern __shared__ __attribute__((aligned(16))) char smem[];
    __shared__ uint4 s_ctl;
    if (threadIdx.x == 0) s_ctl = make_uint4(0u, 0u, 0u, 0u);
    __syncthreads();
    XcdBarrier xb = xcd_barrier_post((unsigned*)(p.ws + OFF_XBAR), (volatile LAS unsigned*)&s_ctl);
    int* s_item = (int*)&s_ctl + 2;
    for (int ph = ph_lo; ph <= ph_hi; ++ph) {
        run_phase(p, ph, smem, 0, s_item);
#ifdef PROBE_DUP
        if (ph > 0 && ph < N_PHASES - 1) {
            const int s_ = (ph - 1) % PH_PER_LAYER, q_ = (s_ >= 1 && s_ <= 8) ? (s_ - 1) % 4 : -1;
            bool dup = false;
            if ((PROBE_DUP & 1) && (q_ == 0)) dup = true;
            if ((PROBE_DUP & 2) && (s_ == 12)) dup = true;
            if ((PROBE_DUP & 4) && (q_ == 3)) dup = true;
            if ((PROBE_DUP & 8) && (q_ == 2 || s_ == 9)) dup = true;
            if ((PROBE_DUP & 16) && (s_ == 0 || s_ == 11 || q_ == 1 || s_ == 13)) dup = true;
            if (dup) run_phase(p, ph, smem, 100, s_item);
        }
#endif
        if (ph < ph_hi) {
            if (ph_lo < 0) cg::this_grid().sync();
            xcd_barrier(xb);
        }
    }
}

extern "C" void kernel_launch(void* const* d_in, const int* in_sizes, int n_in, void* d_out, int out_size, void* d_ws, size_t ws_size, hipStream_t stream) {
    static int grid = 0;
    if (grid == 0) {
        if (n_in != 33 || ws_size < WS_NEED) { fprintf(stderr, "kernel_launch: n_in %d ws %zu need %zu\n", n_in, ws_size, (size_t)WS_NEED); grid = -1; return; }
        int dev = 0, cus = 0, per_cu = 0;
        hipGetDevice(&dev);
        hipDeviceGetAttribute(&cus, hipDeviceAttributeMultiprocessorCount, dev);
        if (hipFuncSetAttribute((const void*)mk_fwd, hipFuncAttributeMaxDynamicSharedMemorySize, LDS_BYTES) != hipSuccess) { fprintf(stderr, "hipFuncSetAttribute failed\n"); grid = -1; return; }
        if (hipOccupancyMaxActiveBlocksPerMultiprocessor(&per_cu, (const void*)mk_fwd, NTHR, LDS_BYTES) != hipSuccess || per_cu < 1) { fprintf(stderr, "occupancy query failed (%d)\n", per_cu); per_cu = 1; }
        if (per_cu > 2) per_cu = 2;
        grid = cus * per_cu;
        fprintf(stderr, "kernel_launch: grid %d (%d CUs x %d)\n", grid, cus, per_cu);
    }
    if (grid < 0) return;
    Params p{};
    for (int i = 0; i < 33; ++i) p.in[i] = (const float*)d_in[i];
    p.out = (float*)d_out; p.ws = (char*)d_ws;
#if MK_ONE_LAUNCH
    if (hipMemsetAsync((char*)d_ws + OFF_XBAR, 0, XCD_BAR_WORDS * 4, stream) != hipSuccess) { fprintf(stderr, "memset failed\n"); return; }
    int lo = 0, hi = N_PHASES - 1;
    void* args[] = {&p, &lo, &hi};
    hipError_t e = hipLaunchCooperativeKernel((const void*)mk_fwd, dim3(grid), dim3(NTHR), args, LDS_BYTES, stream);
    if (e != hipSuccess) fprintf(stderr, "cooperative launch failed: %s (grid %d)\n", hipGetErrorString(e), grid);
#else
    for (int ph = 0; ph < N_PHASES; ++ph) {
        int lo = ph, hi = ph;
        void* args[] = {&p, &lo, &hi};
        hipError_t e = hipLaunchCooperativeKernel((const void*)mk_fwd, dim3(grid), dim3(NTHR), args, LDS_BYTES, stream);
        if (e != hipSuccess) { fprintf(stderr, "launch %d failed: %s (grid %d)\n", ph, hipGetErrorString(e), grid); break; }
    }
#endif
}
```

```cpp
#include <hip/hip_runtime.h>
#include <hip/hip_cooperative_groups.h>
#include <cstdio>
#include <cstdint>
namespace cg = cooperative_groups;

#ifndef MK_ONE_LAUNCH
#define MK_ONE_LAUNCH 1
#endif

typedef unsigned short bf16_t;
typedef short bf16x8 __attribute__((ext_vector_type(8)));
typedef float f32x4 __attribute__((ext_vector_type(4)));
typedef unsigned u32x4 __attribute__((ext_vector_type(4)));
typedef unsigned u32x2 __attribute__((ext_vector_type(2)));
#define DEV __device__ __forceinline__
#define LAS __attribute__((address_space(3)))

constexpr int D = 1024, NBATCH = 32, SEQ = 2048, CTXL = 256, TT = 2304, T_ALL = NBATCH * TT, DEPTH = 4, DFF = 2816;
constexpr int NCHUNK = 2, CB = NBATCH / NCHUNK, TC = CB * TT;
constexpr int ZN = 2944, ZRW = 1408;
constexpr int NTHR = 256;
constexpr int LDS_BYTES = 73728;
constexpr int GP = 72;
constexpr int CP = 132;
#ifndef PROBE_MIXSEL
#define PROBE_MIXSEL 3
#endif
#ifndef MIXMASK
#define MIXMASK 31
#endif
#ifndef DMQ
#define DMQ 2
#endif

constexpr size_t al256(size_t x) { return (x + 255) & ~(size_t)255; }
constexpr size_t OFF_CTR = 0;
constexpr size_t OFF_LAM = 1024;
constexpr size_t OFF_XBAR = 4096;
constexpr size_t OFF_COS = 32768;
constexpr size_t OFF_SIN = OFF_COS + 2048 * 16 * 4;
constexpr size_t OFF_MOD = OFF_SIN + 2048 * 16 * 4;
constexpr size_t OFF_RSQ = al256(OFF_MOD + (size_t)DEPTH * 33 * 6144 * 4);
constexpr size_t OFF_RSKV = OFF_RSQ + (size_t)TC * 4;
constexpr size_t OFF_XC = al256(OFF_RSKV + (size_t)TC * 4);
constexpr size_t OFF_W = al256(OFF_XC + (size_t)NBATCH * CTXL * D * 4);
constexpr size_t WE_IN = 0;
constexpr size_t WE_OUT = WE_IN + (size_t)ZN * 1024;
constexpr size_t WE_UP = WE_OUT + (size_t)1024 * 1024;
constexpr size_t WE_DOWN = WE_UP + (size_t)5632 * 1024;
constexpr size_t WE_UQ = WE_DOWN + (size_t)1024 * 2816;
constexpr size_t WE_UKV = WE_UQ + (size_t)384 * 256;
constexpr size_t WE_WA = WE_UKV + (size_t)512 * 128;
constexpr size_t WE_G = WE_WA + (size_t)1024 * 64;
constexpr size_t WE_TOTAL = WE_G + (size_t)256 * 64;
constexpr size_t OFF_H = al256(OFF_W + (size_t)DEPTH * WE_TOTAL * 2);
constexpr size_t OFF_SCR = al256(OFF_H + (size_t)T_ALL * 1024 * 2);
constexpr size_t SO_QK = 0;
constexpr size_t SO_ZR = al256(SO_QK + (size_t)TC * 1024 * 2);
constexpr size_t VT_ELEMS = (size_t)CB * 4 * 64 * TT;
constexpr size_t SO_VTNA = al256(SO_ZR + (size_t)TC * ZRW * 2);
constexpr size_t SO_VTD = SO_VTNA + VT_ELEMS * 2;
constexpr size_t SO_VTM = SO_VTD + VT_ELEMS * 2;
constexpr size_t SO_MQ = SO_VTM + VT_ELEMS * 2;
constexpr size_t SO_KN = al256(SO_MQ + (size_t)TC * 384 * 2);
constexpr size_t SO_AWA = al256(SO_KN + (size_t)TC * 256 * 2);
constexpr size_t SO_AG = al256(SO_AWA + (size_t)TC * 64 * 2);
constexpr size_t SO_SC = al256(SO_AG + (size_t)T_ALL * 64 * 2);
constexpr size_t SO_Y = al256(SO_SC + (size_t)T_ALL * 2048 * 2);
constexpr size_t SO_END = al256(SO_Y + (size_t)2 * T_ALL * 256 * 4);
constexpr size_t SO_G = 0;
constexpr size_t SO_E = al256(SO_G + (size_t)T_ALL * DFF * 2);
constexpr size_t SO_END2 = al256(SO_E + (size_t)(T_ALL / 128) * 6 * DFF * 4);
constexpr size_t WS_NEED = OFF_SCR + (SO_END > SO_END2 ? SO_END : SO_END2);

struct Params { const float* in[33]; float* out; char* ws; };

DEV int tid_() { int t = __builtin_amdgcn_workitem_id_x(); asm volatile("" : "+v"(t)); return t; }
DEV float bf2f(bf16_t b) { return __uint_as_float(((unsigned)b) << 16); }
DEV bf16_t f2bf(float f) { unsigned u = __float_as_uint(f); u += 0x7fffu + ((u >> 16) & 1u); return (bf16_t)(u >> 16); }
typedef __bf16 bf16v2_t __attribute__((ext_vector_type(2)));
typedef float f32v2_t __attribute__((ext_vector_type(2)));
DEV unsigned pk2(float a, float b) { const f32v2_t f = {a, b}; return __builtin_bit_cast(unsigned, __builtin_convertvector(f, bf16v2_t)); }
DEV float lo_bf(unsigned u) { return __uint_as_float(u << 16); }
DEV float hi_bf(unsigned u) { return __uint_as_float(u & 0xffff0000u); }
DEV float wave_sum(float v) {
#pragma unroll
    for (int o = 32; o >= 1; o >>= 1) v += __shfl_xor(v, o);
    return v;
}
template <int CTRL> DEV float dppf(float v) { return __builtin_bit_cast(float, __builtin_amdgcn_update_dpp(0, __builtin_bit_cast(int, v), CTRL, 0xf, 0xf, true)); }
DEV float sum16(float v) { v += dppf<0xB1>(v); v += dppf<0x4E>(v); v += dppf<0x124>(v); v += dppf<0x128>(v); return v; }
DEV float max16(float v) { v = fmaxf(v, dppf<0xB1>(v)); v = fmaxf(v, dppf<0x4E>(v)); v = fmaxf(v, dppf<0x124>(v)); v = fmaxf(v, dppf<0x128>(v)); return v; }
DEV float sum32(float v) { v = sum16(v); v += __shfl_xor(v, 16); return v; }
DEV float sigmoidf_(float x) { return __builtin_amdgcn_rcpf(1.f + __expf(-x)); }
DEV float siluf_(float x) { return x * __builtin_amdgcn_rcpf(1.f + __expf(-x)); }

DEV float* xrow(const Params& p, int g) {
    const int b = g / TT, tt = g - b * TT;
    return tt < SEQ ? p.out + ((size_t)b * SEQ + tt) * D : (float*)(p.ws + OFF_XC) + ((size_t)b * CTXL + (tt - SEQ)) * D;
}
DEV const float* xrow_in(const Params& p, int g) {
    const int b = g / TT, tt = g - b * TT;
    return tt < SEQ ? p.in[0] + ((size_t)b * SEQ + tt) * D : p.in[2] + ((size_t)b * CTXL + (tt - SEQ)) * D;
}
DEV const bf16_t* wl(const Params& p, int l, size_t we) { return (const bf16_t*)(p.ws + OFF_W) + (size_t)l * WE_TOTAL + we; }
DEV bf16_t* wlw(const Params& p, int l, size_t we) { return (bf16_t*)(p.ws + OFF_W) + (size_t)l * WE_TOTAL + we; }

template <class Epi>
DEV void gemm_tile(const bf16_t* __restrict__ A, int lda, const bf16_t* __restrict__ Bt, int ldb, int K, int tm, int tn, char* smem, const Epi& epi) {
    const int tid = tid_(), lane = tid & 63, wid = tid >> 6, wr = wid >> 1, wc = wid & 1, fr = lane & 15, fq = lane >> 4;
    bf16_t* As = (bf16_t*)smem;
    bf16_t* Bs = As + 2 * 128 * 64;
    const int lrow = tid >> 3, lcc = (tid & 7) * 8, lsw = (((tid & 7) ^ (lrow & 7)) * 8);
    const bf16_t* Ag = A + (size_t)(tm * 128 + lrow) * lda + lcc;
    const bf16_t* Bg = Bt + (size_t)(tn * 128 + lrow) * ldb + lcc;
    f32x4 acc[4][4];
#pragma unroll
    for (int m = 0; m < 4; ++m)
#pragma unroll
        for (int n = 0; n < 4; ++n) acc[m][n] = (f32x4){0.f, 0.f, 0.f, 0.f};
    const int gsw = (((tid & 7) ^ (lrow & 7)) * 8);
    const bf16_t* Ad = A + (size_t)(tm * 128 + lrow) * lda + gsw;
    const bf16_t* Bd = Bt + (size_t)(tn * 128 + lrow) * ldb + gsw;
    char* Asb = (char*)As; char* Bsb = (char*)Bs;
#define G_DMA(buf_, kt_) do { const int ko_ = (kt_) * 64; \
        _Pragma("unroll") for (int i = 0; i < 4; ++i) { \
            __builtin_amdgcn_global_load_lds((const unsigned*)(Ad + (size_t)(32 * i) * lda + ko_), (LAS unsigned*)(Asb + (buf_) * 16384 + i * 4096 + tid * 16), 16, 0, 0); \
            __builtin_amdgcn_global_load_lds((const unsigned*)(Bd + (size_t)(32 * i) * ldb + ko_), (LAS unsigned*)(Bsb + (buf_) * 16384 + i * 4096 + tid * 16), 16, 0, 0); } } while (0)
#define G_FRAGS(cur_, ks_) const bf16_t* Ac##ks_ = As + (cur_) * 128 * 64 + (wr * 64 + fr) * 64 + ((((ks_) * 4 + fq) ^ (fr & 7)) * 8); const bf16_t* Bc##ks_ = Bs + (cur_) * 128 * 64 + (wc * 64 + fr) * 64 + ((((ks_) * 4 + fq) ^ (fr & 7)) * 8); \
        bf16x8 af##ks_[4], bfv##ks_[4]; \
        _Pragma("unroll") for (int m = 0; m < 4; ++m) af##ks_[m] = *(const bf16x8*)(Ac##ks_ + m * 16 * 64); \
        _Pragma("unroll") for (int n = 0; n < 4; ++n) bfv##ks_[n] = *(const bf16x8*)(Bc##ks_ + n * 16 * 64);
#define G_MMA(ks_) __builtin_amdgcn_s_setprio(1); _Pragma("unroll") for (int m = 0; m < 4; ++m) \
        _Pragma("unroll") for (int n = 0; n < 4; ++n) acc[m][n] = __builtin_amdgcn_mfma_f32_16x16x32_bf16(bfv##ks_[n], af##ks_[m], acc[m][n], 0, 0, 0); __builtin_amdgcn_s_setprio(0);
    const int nk = K >> 6;
    G_DMA(0, 0);
    asm volatile("s_waitcnt vmcnt(0)" ::: "memory");
    __syncthreads();
    for (int kt = 0; kt < nk; ++kt) {
        const int cur = kt & 1;
        if (kt + 1 < nk) G_DMA(cur ^ 1, kt + 1);
        {
            G_FRAGS(cur, 0)
            G_MMA(0)
            G_FRAGS(cur, 1)
            G_MMA(1)
        }
        asm volatile("s_waitcnt vmcnt(0)" ::: "memory");
        __syncthreads();
    }
#undef G_DMA
#undef G_FRAGS
#undef G_MMA
    float* Ct = (float*)smem;
#pragma unroll
    for (int m = 0; m < 4; ++m)
#pragma unroll
        for (int n = 0; n < 4; ++n) *(f32x4*)(Ct + (wr * 64 + m * 16 + fr) * CP + wc * 64 + n * 16 + fq * 4) = acc[m][n];
    __syncthreads();
    epi(tm, tn, Ct);
    __syncthreads();
}

DEV f32x4 rope4(const float* Crow, int c, int o, const float* cosT, const float* sinT, int tt, f32x4 v) {
    const int sub = o >> 3, ti = (sub >> 1) * 8 + (o & 7);
    const f32x4 cs = *(const f32x4*)(cosT + tt * 16 + ti), sn = *(const f32x4*)(sinT + tt * 16 + ti);
    const f32x4 pv = *(const f32x4*)(Crow + ((sub & 1) ? c - 8 : c + 8));
    return (sub & 1) ? v * cs + pv * sn : v * cs - pv * sn;
}

DEV void store_vt(const float* Ct, int c0, bf16_t* vt_head  , int tt0, const float* rowscale) {
    for (int item = tid_(); item < 64 * 16; item += NTHR) {
        const int d = item & 63, rg = item >> 6;
        float v[8];
#pragma unroll
        for (int i = 0; i < 8; ++i) { v[i] = Ct[(rg * 8 + i) * CP + c0 + d]; if (rowscale) v[i] *= rowscale[rg * 8 + i]; }
        u32x4 w; w.x = pk2(v[0], v[1]); w.y = pk2(v[2], v[3]); w.z = pk2(v[4], v[5]); w.w = pk2(v[6], v[7]);
        *(u32x4*)(vt_head + (size_t)d * TT + tt0 + rg * 8) = w;
    }
}

DEV f32x4 rope4v(f32x4 v, f32x4 pv, f32x4 cs, f32x4 sn, int sub) { return (sub & 1) ? v * cs + pv * sn : v * cs - pv * sn; }

struct EpiIn {
    bf16_t* QK; bf16_t* ZR; bf16_t* VtNA; bf16_t* VtD; const float* cosT; const float* sinT;
    DEV void operator()(int tm, int tn, const float* Ct) const {
        const int row0 = tm * 128, bl = row0 / TT, tt0 = row0 - bl * TT; const bool lat = tt0 < SEQ;
        if (tn == 4 || tn == 5 || tn == 10 || tn == 11) {
            bf16_t* Vt = (tn < 6) ? VtNA : VtD; const int hp = (tn & 1) * 2;
            store_vt(Ct, 0, Vt + ((size_t)(bl * 4 + hp) * 64) * TT, tt0, nullptr);
            store_vt(Ct, 64, Vt + ((size_t)(bl * 4 + hp + 1) * 64) * TT, tt0, nullptr);
            return;
        }
        bf16_t* dst; int ds, dc; unsigned ropem = 0;
        if (tn < 4) { dst = QK; ds = 1024; dc = tn * 128; }
        else if (tn < 10) { dst = QK; ds = 1024; dc = 512 + (tn - 6) * 128; ropem = 0xf; }
        else { dst = ZR; ds = ZRW; dc = (tn - 12) * 128; if (tn == 21) ropem = 1; }
        if (!lat) ropem = 0;
        const int tid = tid_(), c = (tid & 31) << 2, rb = tid >> 5;
        const bool rp = (ropem >> (c >> 5)) & 1;
        const int o = c & 31, sub = o >> 3, ti = (sub >> 1) * 8 + (o & 7), pc = (sub & 1) ? c - 8 : c + 8;
        bf16_t* dp = dst + (size_t)row0 * ds + dc + c;
#pragma unroll
        for (int it0 = 0; it0 < 16; it0 += 4) {
            f32x4 cs[4], sn[4];
            if (rp) {
#pragma unroll
                for (int u = 0; u < 4; ++u) { const int r = rb + 8 * (it0 + u); cs[u] = *(const f32x4*)(cosT + (tt0 + r) * 16 + ti); sn[u] = *(const f32x4*)(sinT + (tt0 + r) * 16 + ti); }
            }
#pragma unroll
            for (int u = 0; u < 4; ++u) {
                const int r = rb + 8 * (it0 + u);
                f32x4 v = *(const f32x4*)(Ct + r * CP + c);
                if (rp) v = rope4v(v, *(const f32x4*)(Ct + r * CP + pc), cs[u], sn[u], sub);
                u32x2 w; w.x = pk2(v[0], v[1]); w.y = pk2(v[2], v[3]);
                *(u32x2*)(dp + (size_t)r * ds) = w;
            }
        }
    }
};
struct EpiUQ {
    bf16_t* MQ; const float* rs; const float* cosT; const float* sinT;
    DEV void operator()(int tm, int tn, const float* Ct) const {
        const int row0 = tm * 128, bl = row0 / TT, tt0 = row0 - bl * TT; const bool lat = tt0 < SEQ;
        const int tid = tid_(), c = (tid & 31) << 2, rb = tid >> 5, col = tn * 128 + c, hc = col % 96;
        const bool rp = lat && hc >= 64;
        const int o = rp ? hc - 64 : 0, sub = o >> 3, ti = (sub >> 1) * 8 + (o & 7), pc = (sub & 1) ? c - 8 : c + 8;
#pragma unroll
        for (int it0 = 0; it0 < 16; it0 += 4) {
            f32x4 cs[4], sn[4]; float sc[4];
#pragma unroll
            for (int u = 0; u < 4; ++u) { const int r = rb + 8 * (it0 + u); sc[u] = rs[row0 + r]; if (rp) { cs[u] = *(const f32x4*)(cosT + (tt0 + r) * 16 + ti); sn[u] = *(const f32x4*)(sinT + (tt0 + r) * 16 + ti); } }
#pragma unroll
            for (int u = 0; u < 4; ++u) {
                const int r = rb + 8 * (it0 + u);
                f32x4 v = *(const f32x4*)(Ct + r * CP + c);
                if (rp) v = rope4v(v, *(const f32x4*)(Ct + r * CP + pc), cs[u], sn[u], sub);
                v = v * sc[u];
                u32x2 w; w.x = pk2(v[0], v[1]); w.y = pk2(v[2], v[3]);
                *(u32x2*)(MQ + (size_t)(row0 + r) * 384 + col) = w;
            }
        }
    }
};
struct EpiUKV {
    bf16_t* KN; bf16_t* VtM; const float* rs;
    DEV void operator()(int tm, int tn, const float* Ct) const {
        const int row0 = tm * 128, bl = row0 / TT, tt0 = row0 - bl * TT;
        const int tid = tid_(), c = (tid & 15) << 2, rb = tid >> 4;
        float* rsl = (float*)((char*)Ct + 128 * CP * 4);
        if (tid < 128) rsl[tid] = rs[row0 + tid];
        __syncthreads();
#pragma unroll
        for (int it = 0; it < 8; ++it) {
            const int r = rb + 16 * it;
            const f32x4 v = *(const f32x4*)(Ct + r * CP + c) * rsl[r];
            u32x2 w; w.x = pk2(v[0], v[1]); w.y = pk2(v[2], v[3]);
            *(u32x2*)(KN + (size_t)(row0 + r) * 256 + tn * 64 + c) = w;
        }
        store_vt(Ct, 64, VtM + ((size_t)(bl * 4 + tn) * 64) * TT, tt0, rsl);
    }
};
struct EpiWA {
    bf16_t* SC; const float* w0; const float* a0;
    DEV void operator()(int tm, int tn, const float* Ct) const {
        const int row0 = tm * 128, seg = tn >> 1;
        const int tid = tid_(), c = (tid & 31) << 2, rb = tid >> 5, ch = (tn & 1) * 128 + c, h = ch >> 6, j = ch & 63;
        const f32x4 bias = seg < 2 ? *(const f32x4*)(w0 + seg * 256 + ch) : *(const f32x4*)(a0 + (seg - 2) * 256 + ch);
        bf16_t* dp = SC + (size_t)row0 * 2048 + h * 512 + (4 + seg) * 64 + j;
#pragma unroll 4
        for (int it = 0; it < 16; ++it) {
            const int r = rb + 8 * it;
            const f32x4 v = *(const f32x4*)(Ct + r * CP + c) + bias;
            float o[4];
#pragma unroll
            for (int i = 0; i < 4; ++i) {
                if (seg < 2) o[i] = 0.60653065971f * sigmoidf_(v[i]);
                else o[i] = sigmoidf_(v[i]);
            }
            u32x2 w; w.x = pk2(o[0], o[1]); w.y = pk2(o[2], o[3]);
            *(u32x2*)(dp + (size_t)r * 2048) = w;
        }
    }
};
struct EpiG {
    bf16_t* MIX; const bf16_t* SC; const float* Y; const float* r_k; const float* ln_w; const float* ln_b; int gbase;
    DEV void operator()(int tm, int tn, const float* Ct) const {
        const int row0 = tm * 128;
        const int tid = tid_(), l32 = tid & 31, hh = (tid >> 5) & 1, rb = tid >> 6, h = tn * 2 + hh, j = l32 * 2, ch = h * 64 + j;
        const float rk0 = r_k[ch], rk1 = r_k[ch + 1], lw0 = ln_w[ch], lw1 = ln_w[ch + 1], lb0 = ln_b[ch], lb1 = ln_b[ch + 1];
#pragma unroll
        for (int it0 = 0; it0 < 32; it0 += 4) {
            unsigned yfu[4], ybu[4]; unsigned ur[4], uv[4], uk[4];
#pragma unroll
            for (int u = 0; u < 4; ++u) {
                const size_t row = (size_t)(row0 + rb + 4 * (it0 + u));
                yfu[u] = *(const unsigned*)((const bf16_t*)Y + row * 256 + ch); ybu[u] = *(const unsigned*)((const bf16_t*)Y + ((size_t)T_ALL + row) * 256 + ch);
                const bf16_t* sc = SC + row * 2048 + h * 512 + j;
                ur[u] = *(const unsigned*)(sc); uv[u] = *(const unsigned*)(sc + 64); uk[u] = *(const unsigned*)(sc + 128);
            }
#pragma unroll
            for (int u = 0; u < 4; ++u) {
                const int r = rb + 4 * (it0 + u);
                const float y0 = lo_bf(yfu[u]) + lo_bf(ybu[u]), y1 = hi_bf(yfu[u]) + hi_bf(ybu[u]);
                const float mean = sum32(y0 + y1) * (1.f / 64.f);
                const float d0 = y0 - mean, d1 = y1 - mean;
                const float var = sum32(d0 * d0 + d1 * d1) * (1.f / 64.f);
                const float rstd = rsqrtf(var + 64e-5f);
                const float rk = sum32(lo_bf(ur[u]) * lo_bf(uk[u]) * rk0 + hi_bf(ur[u]) * hi_bf(uk[u]) * rk1);
                const float g0 = Ct[r * CP + hh * 64 + j], g1 = Ct[r * CP + hh * 64 + j + 1];
                const float o0 = (d0 * rstd * lw0 + lb0 + rk * lo_bf(uv[u])) * g0;
                const float o1 = (d1 * rstd * lw1 + lb1 + rk * hi_bf(uv[u])) * g1;
                *(unsigned*)(MIX + (size_t)(row0 + r) * 1024 + 512 + ch) = pk2(o0, o1);
            }
        }
    }
};
struct EpiRes {
    const Params* p; const float* mod; int goff; int from_in;
    DEV void operator()(int tm, int tn, const float* Ct) const {
        const int row0 = tm * 128, b = row0 / TT, tt0 = row0 - b * TT;
        const int tid = tid_(), c = (tid & 31) << 2, rb = tid >> 5;
        const f32x4 g = *(const f32x4*)(mod + (size_t)(tt0 < SEQ ? b : 32) * 6144 + goff + tn * 128 + c);
        float* x0 = xrow(*p, row0) + tn * 128 + c;
        const float* xs = from_in ? xrow_in(*p, row0) + tn * 128 + c : x0;
#pragma unroll
        for (int it0 = 0; it0 < 16; it0 += 8) {
            f32x4 xv[8];
#pragma unroll
            for (int u = 0; u < 8; ++u) xv[u] = *(const f32x4*)(xs + (size_t)(rb + 8 * (it0 + u)) * D);
#pragma unroll
            for (int u = 0; u < 8; ++u) { const int r = rb + 8 * (it0 + u); *(f32x4*)(x0 + (size_t)r * D) = xv[u] + g * *(const f32x4*)(Ct + r * CP + c); }
        }
    }
};
struct EpiUp {
    bf16_t* G; float* E; const float* cw; const float* cb;
    DEV void operator()(int tm, int tn, const float* Ct) const {
        const int row0 = tm * 128, tt0 = row0 % TT;
        const bool first = (tt0 == 0 || tt0 == SEQ), last = (tt0 + 127 == SEQ - 1 || tt0 + 127 == TT - 1);
        const int tid = tid_(), c = (tid & 15) << 2, rb = tid >> 4, j = tn * 64 + c;
        const f32x4 w0 = *(const f32x4*)(cw + j), w1 = *(const f32x4*)(cw + DFF + j), w2 = *(const f32x4*)(cw + 2 * DFF + j), bb = *(const f32x4*)(cb + j);
        const f32x4 z = (f32x4){0.f, 0.f, 0.f, 0.f};
#pragma unroll 2
        for (int it = 0; it < 8; ++it) {
            const int r = rb + 16 * it;
            const f32x4 ac = *(const f32x4*)(Ct + r * CP + c);
            const f32x4 ap = r > 0 ? *(const f32x4*)(Ct + (r - 1) * CP + c) : z;
            const f32x4 an = r < 127 ? *(const f32x4*)(Ct + (r + 1) * CP + c) : z;
            const f32x4 bv = *(const f32x4*)(Ct + r * CP + 64 + c);
            const f32x4 pre = w0 * ap + w1 * ac + w2 * an + bb;
            if ((r == 0 && !first) || (r == 127 && !last)) {
                float* e = E + ((size_t)tm * 6 + (r == 0 ? 0 : 3)) * DFF + j;
                *(f32x4*)(e) = pre; *(f32x4*)(e + DFF) = bv; *(f32x4*)(e + 2 * DFF) = ac;
            } else {
                u32x2 w; w.x = pk2(siluf_(pre[0]) * bv[0], siluf_(pre[1]) * bv[1]); w.y = pk2(siluf_(pre[2]) * bv[2], siluf_(pre[3]) * bv[3]);
                *(u32x2*)(G + (size_t)(row0 + r) * DFF + j) = w;
            }
        }
    }
};

template <class Epi>
DEV void gemm_phase(const bf16_t* A, int lda, const bf16_t* Bt, int ldb, int K, int ntm, int ntn, bool skip_ctx, char* smem, const Epi& epi) {
    if ((gridDim.x & 7) == 0 && (ntm & 7) == 0) {
        const int xcd = blockIdx.x & 7, slot = blockIdx.x >> 3, nper = gridDim.x >> 3, R = ntm >> 3, per = R * ntn;
        const int nfb = ntn >> 3, fullq = nfb * R * 8, w = ntn - nfb * 8;
        for (int q = slot; q < per; q += nper) {
            int tm, tn;
            if (q < fullq) { const int tb = q / (R * 8), r = q - tb * (R * 8); tm = r >> 3; tn = tb * 8 + (r & 7); }
            else { const int q2 = q - fullq; tm = q2 / w; tn = nfb * 8 + (q2 - tm * w); }
            tm += xcd * R;
            if (skip_ctx && ((tm * 128) % TT) >= SEQ) continue;
            gemm_tile(A, lda, Bt, ldb, K, tm, tn, smem, epi);
        }
        return;
    }
    const int total = ntm * ntn;
    for (int t = blockIdx.x; t < total; t += gridDim.x) {
        const int tm = t / ntn, tn = t - tm * ntn;
        if (skip_ctx && ((tm * 128) % TT) >= SEQ) continue;
        gemm_tile(A, lda, Bt, ldb, K, tm, tn, smem, epi);
    }
}

struct AttnArgs {
    const bf16_t* Q; int qs;
    const bf16_t* K; int ks;
    const bf16_t* K2; int k2s;
    const bf16_t* Vt;
    bf16_t* O; int os;
    int nkt; int kstart;
    float sc2;
    int na_r, na_rs; const float* rpb;
    float lam, oscale; const float* subln;
};

DEV unsigned cvt_pk_bf16(float lo, float hi) { return pk2(lo, hi); }
DEV float red_rows_sum(float p) {
    float a = p, b = p;
    asm volatile("s_nop 1\n\tv_permlane16_swap_b32 %0, %1" : "+v"(a), "+v"(b));
    const float q = a + b; a = q; b = q;
    asm volatile("s_nop 1\n\tv_permlane32_swap_b32 %0, %1" : "+v"(a), "+v"(b));
    return a + b;
}
DEV float vmax2(float a, float b) { float r; asm("v_max_f32 %0, %1, %2" : "=v"(r) : "v"(a), "v"(b)); return r; }
DEV float vmax3(float a, float b, float c) { float r; asm("v_max3_f32 %0, %1, %2, %3" : "=v"(r) : "v"(a), "v"(b), "v"(c)); return r; }
DEV float wave_sum_fast(float v) { return red_rows_sum(sum16(v)); }
DEV float red_rows_max(float p) {
    float a = p, b = p;
    asm volatile("s_nop 1\n\tv_permlane16_swap_b32 %0, %1" : "+v"(a), "+v"(b));
    const float q = fmaxf(a, b); a = q; b = q;
    asm volatile("s_nop 1\n\tv_permlane32_swap_b32 %0, %1" : "+v"(a), "+v"(b));
    return fmaxf(a, b);
}
template <int DQK, int NSUB, int MQ, bool NA>
DEV void attn_item(const AttnArgs& a, char* smem) {
    constexpr int KP = DQK + 8, KS = DQK / 32 / NSUB, KCH = DQK / 8, QR = 16 * MQ;
    const int tid = tid_(), lane = tid & 63, wid = tid >> 6, fr = lane & 15, fq = lane >> 4;
    bf16_t* Ksm = (bf16_t*)smem;
    bf16_t* Vsm = Ksm + 2 * 64 * KP;
    float* rpbs = (float*)(Vsm + 2 * 64 * GP);
    if (NA) { for (int i = tid; i < 465; i += NTHR) rpbs[i] = a.rpb[i] * 1.44269504f; }
    const int na_nlo = NA ? (max(16 * wid - 8, 0) >> 4) : 0, na_nhi = NA ? (min(16 * wid + 22, 63) >> 4) : 3;
    bf16x8 qf[MQ][DQK / 32];
#pragma unroll
    for (int mq = 0; mq < MQ; ++mq)
#pragma unroll
        for (int k = 0; k < DQK / 32; ++k) qf[mq][k] = *(const bf16x8*)(a.Q + (size_t)(wid * QR + mq * 16 + fr) * a.qs + k * 32 + fq * 8);
    f32x4 o[NSUB][MQ][4];
    float mrow[NSUB][MQ], lrow[NSUB][MQ];
#pragma unroll
    for (int sb = 0; sb < NSUB; ++sb)
#pragma unroll
        for (int mq = 0; mq < MQ; ++mq) {
            mrow[sb][mq] = -1e30f; lrow[sb][mq] = 0.f;
#pragma unroll
            for (int n = 0; n < 4; ++n) o[sb][mq][n] = (f32x4){0.f, 0.f, 0.f, 0.f};
        }
    constexpr int NKC = (64 * KCH + NTHR - 1) / NTHR;
    u32x4 rk[NKC], rv[2];
#define ATT_TSTART(kt) (NA ? ((kt) < 8 ? (a.na_rs + (kt)) * 64 : SEQ + ((kt) - 8) * 64) : a.kstart + (kt) * 64)
#define ATT_GLOAD(kt) do { const int _t0 = ATT_TSTART(kt); \
        _Pragma("unroll") for (int _i = 0; _i < NKC; ++_i) { const int _q = tid + _i * NTHR; if (_q < 64 * KCH) { const int _r = _q / KCH, _c = _q - _r * KCH; \
            rk[_i] = (_c < 8 || DQK == 64) ? *(const u32x4*)(a.K + (size_t)(_t0 + _r) * a.ks + _c * 8) : *(const u32x4*)(a.K2 + (size_t)(_t0 + _r) * a.k2s + (_c - 8) * 8); } } \
        _Pragma("unroll") for (int _i = 0; _i < 2; ++_i) { const int _q = tid + _i * NTHR, _r = _q >> 3, _c = _q & 7; rv[_i] = *(const u32x4*)(a.Vt + (size_t)_r * TT + _t0 + _c * 8); } } while (0)
#define ATT_LSTORE(buf) do { \
        _Pragma("unroll") for (int _i = 0; _i < NKC; ++_i) { const int _q = tid + _i * NTHR; if (_q < 64 * KCH) { const int _r = _q / KCH, _c = _q - _r * KCH; *(u32x4*)(Ksm + ((buf) * 64 + _r) * KP + _c * 8) = rk[_i]; } } \
        _Pragma("unroll") for (int _i = 0; _i < 2; ++_i) { const int _q = tid + _i * NTHR, _r = _q >> 3, _c = _q & 7; *(u32x4*)(Vsm + ((buf) * 64 + _r) * GP + _c * 8) = rv[_i]; } } while (0)
    ATT_GLOAD(0); ATT_LSTORE(0);
    __syncthreads();
    for (int kt = 0; kt < a.nkt; ++kt) {
        const int cur = kt & 1; const bool more = kt + 1 < a.nkt;
        if (more) ATT_GLOAD(kt + 1);
        const bool natile = NA && kt < 8;
        bf16x8 pb[NSUB][MQ][2];
#pragma unroll
        for (int sb = 0; sb < NSUB; ++sb) {
            f32x4 s[MQ][4];
#pragma unroll
            for (int k = 0; k < KS; ++k) {
                bf16x8 kb[4];
#pragma unroll
                for (int n = 0; n < 4; ++n) kb[n] = *(const bf16x8*)(Ksm + (cur * 64 + n * 16 + fr) * KP + (sb * KS + k) * 32 + fq * 8);
#pragma unroll
                for (int mq = 0; mq < MQ; ++mq)
#pragma unroll
                    for (int n = 0; n < 4; ++n) {
                        if (!natile || (n >= na_nlo && n <= na_nhi)) s[mq][n] = __builtin_amdgcn_mfma_f32_16x16x32_bf16(kb[n], qf[mq][sb * KS + k], k == 0 ? (f32x4){0.f, 0.f, 0.f, 0.f} : s[mq][n], 0, 0, 0);
                        else if (k == 0) s[mq][n] = (f32x4){0.f, 0.f, 0.f, 0.f};
                    }
            }
#pragma unroll
            for (int mq = 0; mq < MQ; ++mq) {
                float mx = -1e30f;
                if (natile) {
                    const int qc = wid * 16 + fr, cst = min(max(qc - 8, 0), 48), ro = a.na_rs + kt - a.na_r + 7;
                    const float* rrow = rpbs + ro * 31 + 15 - qc + fq * 4;
#pragma unroll
                    for (int n = 0; n < 4; ++n) {
                        if (n >= na_nlo && n <= na_nhi) {
#pragma unroll
                            for (int j = 0; j < 4; ++j) {
                                const int kc = n * 16 + fq * 4 + j;
                                const float x = (kc >= cst && kc < cst + 16) ? s[mq][n][j] * a.sc2 + rrow[n * 16 + j] : -1e30f;
                                s[mq][n][j] = x; mx = fmaxf(mx, x);
                            }
                        } else s[mq][n] = (f32x4){-1e30f, -1e30f, -1e30f, -1e30f};
                    }
                } else {
#pragma unroll
                    for (int n = 0; n < 4; ++n) { s[mq][n] = s[mq][n] * a.sc2; mx = fmaxf(fmaxf(mx, fmaxf(s[mq][n][0], s[mq][n][1])), fmaxf(s[mq][n][2], s[mq][n][3])); }
                }
                mx = red_rows_max(mx);
                const float mo = mrow[sb][mq], mn = fmaxf(mo, mx);
                const bool grow = __builtin_amdgcn_ballot_w64(mn > mo) != 0;
                mrow[sb][mq] = mn;
                float rsum = 0.f;
#pragma unroll
                for (int n = 0; n < 4; ++n) {
                    if (!natile || (n >= na_nlo && n <= na_nhi)) {
#pragma unroll
                        for (int j = 0; j < 4; ++j) { const float pv = __builtin_amdgcn_exp2f(s[mq][n][j] - mn); s[mq][n][j] = pv; rsum += pv; }
                    } else s[mq][n] = (f32x4){0.f, 0.f, 0.f, 0.f};
                }
                if (grow) {
                    const float alpha = __builtin_amdgcn_exp2f(mo - mn);
                    lrow[sb][mq] *= alpha;
#pragma unroll
                    for (int n = 0; n < 4; ++n) o[sb][mq][n] *= alpha;
                }
                lrow[sb][mq] += rsum;
#pragma unroll
                for (int k2 = 0; k2 < 2; ++k2) {
                    u32x4 w;
                    w.x = cvt_pk_bf16(s[mq][2 * k2][0], s[mq][2 * k2][1]); w.y = cvt_pk_bf16(s[mq][2 * k2][2], s[mq][2 * k2][3]);
                    w.z = cvt_pk_bf16(s[mq][2 * k2 + 1][0], s[mq][2 * k2 + 1][1]); w.w = cvt_pk_bf16(s[mq][2 * k2 + 1][2], s[mq][2 * k2 + 1][3]);
                    pb[sb][mq][k2] = __builtin_bit_cast(bf16x8, w);
                }
            }
        }
#pragma unroll
        for (int k2 = 0; k2 < 2; ++k2) {
            if (natile && (2 * k2 + 1 < na_nlo || 2 * k2 > na_nhi)) continue;
            bf16x8 va[4];
#pragma unroll
            for (int n = 0; n < 4; ++n) {
                const bf16_t* vp = Vsm + (cur * 64 + n * 16 + fr) * GP + 32 * k2 + fq * 4;
                u32x4 w; const u32x2 lo = *(const u32x2*)(vp), hi = *(const u32x2*)(vp + 16);
                w.x = lo.x; w.y = lo.y; w.z = hi.x; w.w = hi.y;
                va[n] = __builtin_bit_cast(bf16x8, w);
            }
#pragma unroll
            for (int sb = 0; sb < NSUB; ++sb)
#pragma unroll
                for (int mq = 0; mq < MQ; ++mq)
#pragma unroll
                    for (int n = 0; n < 4; ++n) o[sb][mq][n] = __builtin_amdgcn_mfma_f32_16x16x32_bf16(va[n], pb[sb][mq][k2], o[sb][mq][n], 0, 0, 0);
        }
        if (more) ATT_LSTORE(cur ^ 1);
        __syncthreads();
    }
#undef ATT_GLOAD
#undef ATT_LSTORE
#undef ATT_TSTART
#pragma unroll
    for (int mq = 0; mq < MQ; ++mq) {
        f32x4 v[4];
        if (NSUB == 1) {
            const float il = 1.f / red_rows_sum(lrow[0][mq]);
#pragma unroll
            for (int n = 0; n < 4; ++n) v[n] = o[0][mq][n] * il;
        } else {
            const float il0 = 1.f / red_rows_sum(lrow[0][mq]), il1 = a.lam / red_rows_sum(lrow[NSUB - 1][mq]);
            float ss = 0.f;
#pragma unroll
            for (int n = 0; n < 4; ++n) { v[n] = o[0][mq][n] * il0 - o[NSUB - 1][mq][n] * il1; ss += v[n][0] * v[n][0] + v[n][1] * v[n][1] + v[n][2] * v[n][2] + v[n][3] * v[n][3]; }
            ss = red_rows_sum(ss);
            const float rstd = rsqrtf(ss * (1.f / 64.f) + 1e-5f) * a.oscale;
#pragma unroll
            for (int n = 0; n < 4; ++n) v[n] = v[n] * rstd * *(const f32x4*)(a.subln + n * 16 + fq * 4);
        }
        bf16_t* op = a.O + (size_t)(wid * QR + mq * 16 + fr) * a.os + fq * 4;
#pragma unroll
        for (int n = 0; n < 4; ++n) { u32x2 w; w.x = cvt_pk_bf16(v[n][0], v[n][1]); w.y = cvt_pk_bf16(v[n][2], v[n][3]); *(u32x2*)(op + n * 16) = w; }
    }
    __syncthreads();
}

template <int N> DEV float rbc(float x) { return __builtin_bit_cast(float, __builtin_amdgcn_update_dpp(0, __builtin_bit_cast(int, x), 0x150 + N, 0xf, 0xf, true)); }
DEV float red_rows(float p) { return red_rows_sum(p); }
#define REP16(M) M(0) M(1) M(2) M(3) M(4) M(5) M(6) M(7) M(8) M(9) M(10) M(11) M(12) M(13) M(14) M(15)
DEV void scan_item(const bf16_t* SC, float* Y, int bl, int h, int dir, const float* k_a, char* smem) {
    const int tid = tid_(), lane = tid & 63, w = tid >> 6, ch = lane, sq = w;
    float* stg = (float*)smem;
    float* yb = stg + 2 * 16 * 6 * 64;
    const float ka = k_a[h * 64 + ch];
    unsigned short pre[4][6];
    float S[16];
#pragma unroll
    for (int j = 0; j < 16; ++j) S[j] = 0.f;
#define SC_TT(s) (dir == 0 ? ((s) < CTXL ? SEQ + (s) : (s) - CTXL) : ((s) < CTXL ? TT - 1 - (s) : SEQ - 1 - ((s) - CTXL)))
#define SC_GL(chunk) do { _Pragma("unroll") for (int _i = 0; _i < 4; ++_i) { const int _s = (chunk) * 16 + sq + 4 * _i; const int _tt = SC_TT(_s); \
        const bf16_t* _b = SC + ((size_t)(bl * TT + _tt)) * 2048 + h * 512 + ch; \
        pre[_i][0] = _b[0]; pre[_i][1] = _b[64]; pre[_i][2] = _b[128]; pre[_i][3] = _b[192]; pre[_i][4] = _b[(4 + dir) * 64]; pre[_i][5] = _b[(6 + dir) * 64]; } } while (0)
#define SC_ST(buf) do { _Pragma("unroll") for (int _i = 0; _i < 4; ++_i) { const int _st = sq + 4 * _i; \
        const float _r = bf2f(pre[_i][0]), _v = bf2f(pre[_i][1]), _k = bf2f(pre[_i][2]), _kk = bf2f(pre[_i][3]), _e = bf2f(pre[_i][4]), _sg = bf2f(pre[_i][5]); \
        float* _d = stg + (((buf) * 16 + _st) * 6) * 64 + ch; \
        _d[0] = -_kk; _d[64] = __expf(-_e); _d[128] = _kk * _sg; _d[192] = _k * (1.f + (_sg - 1.f) * ka); _d[256] = _r; _d[320] = _v; } } while (0)
    SC_GL(0); SC_ST(0);
    __syncthreads();
    constexpr int NCH = TT / 16;
    const int vrow = w * 16 + (lane & 15);
#define FMAC_BC(acc, x, sv, n) asm("v_fmac_f32_dpp %0, %1, %2 row_newbcast:" #n " row_mask:0xf bank_mask:0xf" : "+v"(acc) : "v"(x), "v"(sv))
#define MUL_BC(dst, x, sv, n) asm("v_mul_f32_dpp %0, %1, %2 row_newbcast:" #n " row_mask:0xf bank_mask:0xf" : "=v"(dst) : "v"(x), "v"(sv))
#define SC_LOAD(st_, A, W, B, K, R, V) do { const float* _dn = d0 + (st_) * 384; A = _dn[lane]; W = _dn[64 + lane]; B = _dn[128 + lane]; K = _dn[192 + lane]; R = _dn[256 + lane]; V = _dn[320 + vrow]; } while (0)
#define SA_(n) if ((n) & 1) FMAC_BC(p1, cA, S[n], n); else FMAC_BC(p0, cA, S[n], n);
#define UP_(n) { float t; MUL_BC(t, cW, S[n], n); FMAC_BC(t, cB, sa, n); FMAC_BC(t, cK, cV, n); S[n] = t; if ((n) & 1) FMAC_BC(y1, cR, t, n); else FMAC_BC(y0, cR, t, n); }
#define SC_STEP(st_, cA, cW, cB, cK, cR, cV) do { float p0 = 0.f, p1 = 0.f; REP16(SA_) const float sa = red_rows(p0 + p1); float y0 = 0.f, y1 = 0.f; REP16(UP_) \
        yb[((st_) * 4 + (lane >> 4)) * 64 + vrow] = y0 + y1; } while (0)
    for (int chunk = 0; chunk < NCH; ++chunk) {
        const int buf = chunk & 1;
        if (chunk + 1 < NCH) SC_GL(chunk + 1);
        const float* d0 = stg + (buf * 16 * 6) * 64;
        float a0, w0, b0, k0, r0, v0, a1, w1, b1, k1, r1, v1;
        SC_LOAD(0, a0, w0, b0, k0, r0, v0);
#pragma unroll
        for (int st = 0; st < 16; st += 2) {
            SC_LOAD(st + 1, a1, w1, b1, k1, r1, v1);
#define cA a0
#define cW w0
#define cB b0
#define cK k0
#define cR r0
#define cV v0
            SC_STEP(st, a0, w0, b0, k0, r0, v0);
#undef cA
#undef cW
#undef cB
#undef cK
#undef cR
#undef cV
            if (st + 2 < 16) SC_LOAD(st + 2, a0, w0, b0, k0, r0, v0);
#define cA a1
#define cW w1
#define cB b1
#define cK k1
#define cR r1
#define cV v1
            SC_STEP(st + 1, a1, w1, b1, k1, r1, v1);
#undef cA
#undef cW
#undef cB
#undef cK
#undef cR
#undef cV
        }
        __syncthreads();
#pragma unroll
        for (int i = 0; i < 4; ++i) {
            const int st = sq + 4 * i, s_ = chunk * 16 + st, tt = SC_TT(s_);
            ((bf16_t*)Y)[((size_t)dir * T_ALL + (size_t)bl * TT + tt) * 256 + h * 64 + ch] = f2bf((yb[(st * 4) * 64 + ch] + yb[(st * 4 + 1) * 64 + ch]) + (yb[(st * 4 + 2) * 64 + ch] + yb[(st * 4 + 3) * 64 + ch]));
        }
        if (chunk + 1 < NCH) SC_ST(buf ^ 1);
        __syncthreads();
    }
#undef SC_TT
#undef SC_GL
#undef SC_ST
#undef FMAC_BC
#undef MUL_BC
#undef SC_LOAD
#undef SA_
#undef UP_
#undef SC_STEP
}

DEV void phase_norm(const Params& p, int l, int which, bool skip_ctx) {
    const float* gam = p.in[which ? 5 : 4] + l * D;
    const float* mod = (const float*)(p.ws + OFF_MOD) + (size_t)l * 33 * 6144;
    bf16_t* H = (bf16_t*)(p.ws + OFF_H);
    const int lane = tid_() & 63, wave = blockIdx.x * 4 + (tid_() >> 6), nw = gridDim.x * 4;
    for (int g0 = wave; g0 < T_ALL; g0 += 2 * nw) {
        f32x4 v[2][4]; const float* m[2]; bool act[2];
#pragma unroll
        for (int u = 0; u < 2; ++u) {
            const int g = g0 + u * nw; act[u] = g < T_ALL;
            const int gg = act[u] ? g : g0;
            const int b = gg / TT, tt = gg - b * TT; const bool lat = tt < SEQ;
            if (!lat && skip_ctx) act[u] = false;
            const float* x = (l == 0 && which == 0) ? xrow_in(p, gg) : xrow(p, gg);
            m[u] = mod + (size_t)(lat ? b : 32) * 6144 + (which ? 3072 : 0);
#pragma unroll
            for (int i = 0; i < 4; ++i) v[u][i] = *(const f32x4*)(x + i * 256 + lane * 4);
        }
#pragma unroll
        for (int u = 0; u < 2; ++u) {
            float ss = 0.f;
#pragma unroll
            for (int i = 0; i < 4; ++i) ss += v[u][i][0] * v[u][i][0] + v[u][i][1] * v[u][i][1] + v[u][i][2] * v[u][i][2] + v[u][i][3] * v[u][i][3];
            ss = wave_sum_fast(ss);
            const float rstd = rsqrtf(ss * (1.f / 1024.f) + 1e-6f);
            if (act[u]) {
                const int g = g0 + u * nw;
#pragma unroll
                for (int i = 0; i < 4; ++i) {
                    const int col = i * 256 + lane * 4;
                    const f32x4 g4 = *(const f32x4*)(gam + col), sh = *(const f32x4*)(m[u] + col), sc = *(const f32x4*)(m[u] + 1024 + col);
                    const f32x4 o = v[u][i] * rstd * g4 * (sc + 1.f) + sh;
                    u32x2 w; w.x = pk2(o[0], o[1]); w.y = pk2(o[2], o[3]);
                    *(u32x2*)(H + (size_t)g * 1024 + col) = w;
                }
            }
        }
    }
}

DEV void phase_final(const Params& p) {
    const float* gam = p.in[32];
    const int lane = tid_() & 63, wave = blockIdx.x * 4 + (tid_() >> 6), nw = gridDim.x * 4;
    for (int g = wave; g < NBATCH * SEQ; g += nw) {
        float* x = p.out + (size_t)g * D;
        f32x4 v[4]; float ss = 0.f;
#pragma unroll
        for (int i = 0; i < 4; ++i) { v[i] = *(const f32x4*)(x + i * 256 + lane * 4); ss += v[i][0] * v[i][0] + v[i][1] * v[i][1] + v[i][2] * v[i][2] + v[i][3] * v[i][3]; }
        ss = wave_sum(ss);
        const float rstd = rsqrtf(ss * (1.f / 1024.f) + 1e-6f);
#pragma unroll
        for (int i = 0; i < 4; ++i) { const int col = i * 256 + lane * 4; *(f32x4*)(x + col) = v[i] * rstd * *(const f32x4*)(gam + col); }
    }
}

DEV void phase_prep(const Params& p, int l, int c) {
    char* scr = p.ws + OFF_SCR;
    const bf16_t* ZR = (const bf16_t*)(scr + SO_ZR);
    bf16_t* SC = (bf16_t*)(scr + SO_SC) + (size_t)c * TC * 2048; bf16_t* AWA = (bf16_t*)(scr + SO_AWA); bf16_t* AG = (bf16_t*)(scr + SO_AG) + (size_t)c * TC * 64;
    float* rsq = (float*)(p.ws + OFF_RSQ); float* rskv = (float*)(p.ws + OFF_RSKV);
    const float* mu0 = p.in[15] + (size_t)l * 2 * 896; const float* mu1 = mu0 + 896;
    const int lane = tid_() & 63, wave = blockIdx.x * 4 + (tid_() >> 6), nw = gridDim.x * 4;
    f32x4 m0[3], m1[3];
#pragma unroll
    for (int s3 = 0; s3 < 3; ++s3) { m0[s3] = *(const f32x4*)(mu0 + s3 * 256 + lane * 4); m1[s3] = *(const f32x4*)(mu1 + s3 * 256 + lane * 4); }
    const f32x4 kk4 = *(const f32x4*)(p.in[21] + l * 256 + lane * 4);
    const float mw0 = mu0[768 + lane], mw1 = mu1[768 + lane], mg0 = mu0[832 + lane], mg1 = mu1[832 + lane];
    for (int t0 = wave; t0 < TC; t0 += 2 * nw) {
        u32x2 q[2], c0[2][3], cp[2][3], cn[2][3]; unsigned kv[2]; bf16_t wz[2][3], gz[2][3]; bool act[2], hp[2], hn[2];
#pragma unroll
        for (int u = 0; u < 2; ++u) {
            const int t = t0 + u * nw; act[u] = t < TC;
            const int ts = act[u] ? t : t0, tt = ts % TT;
            hp[u] = !(tt == 0 || tt == SEQ); hn[u] = !(tt == SEQ - 1 || tt == TT - 1);
            const bf16_t* z = ZR + (size_t)ts * ZRW;
            const bf16_t* zp = hp[u] ? z - ZRW : z; const bf16_t* zn = hn[u] ? z + ZRW : z;
            q[u] = *(const u32x2*)(z + 768 + lane * 4); kv[u] = *(const unsigned*)(z + 1024 + lane * 2);
#pragma unroll
            for (int s3 = 0; s3 < 3; ++s3) { const int col = s3 * 256 + lane * 4; c0[u][s3] = *(const u32x2*)(z + col); cp[u][s3] = *(const u32x2*)(zp + col); cn[u][s3] = *(const u32x2*)(zn + col); }
            wz[u][0] = z[1184 + lane]; wz[u][1] = zp[1184 + lane]; wz[u][2] = zn[1184 + lane];
            gz[u][0] = z[1280 + lane]; gz[u][1] = zp[1280 + lane]; gz[u][2] = zn[1280 + lane];
        }
#pragma unroll
        for (int u = 0; u < 2; ++u) {
            const int t = t0 + u * nw;
            const float fp = hp[u] ? 1.f : 0.f, fn = hn[u] ? 1.f : 0.f;
            float s = lo_bf(q[u].x) * lo_bf(q[u].x) + hi_bf(q[u].x) * hi_bf(q[u].x) + lo_bf(q[u].y) * lo_bf(q[u].y) + hi_bf(q[u].y) * hi_bf(q[u].y);
            s = wave_sum_fast(s);
            float s2 = lo_bf(kv[u]) * lo_bf(kv[u]) + hi_bf(kv[u]) * hi_bf(kv[u]);
            s2 = wave_sum_fast(s2);
            float zs[3][4];
#pragma unroll
            for (int s3 = 0; s3 < 3; ++s3) {
                const float zc[4] = {lo_bf(c0[u][s3].x), hi_bf(c0[u][s3].x), lo_bf(c0[u][s3].y), hi_bf(c0[u][s3].y)};
                const float zp[4] = {lo_bf(cp[u][s3].x) * fp, hi_bf(cp[u][s3].x) * fp, lo_bf(cp[u][s3].y) * fp, hi_bf(cp[u][s3].y) * fp};
                const float zn[4] = {lo_bf(cn[u][s3].x) * fn, hi_bf(cn[u][s3].x) * fn, lo_bf(cn[u][s3].y) * fn, hi_bf(cn[u][s3].y) * fn};
#pragma unroll
                for (int i = 0; i < 4; ++i) zs[s3][i] = zc[i] + m0[s3][i] * (zp[i] - zc[i]) + m1[s3][i] * (zn[i] - zc[i]);
            }
            float kk[4]; float ss = 0.f;
#pragma unroll
            for (int i = 0; i < 4; ++i) { kk[i] = zs[1][i] * kk4[i]; ss += kk[i] * kk[i]; }
            ss = sum16(ss);
            const float inv = rsqrtf(fmaxf(ss, 1e-24f));
            float vw, vg;
            { const float zc = bf2f(wz[u][0]), zp = bf2f(wz[u][1]) * fp, zn = bf2f(wz[u][2]) * fn; vw = zc + mw0 * (zp - zc) + mw1 * (zn - zc); }
            { const float zc = bf2f(gz[u][0]), zp = bf2f(gz[u][1]) * fp, zn = bf2f(gz[u][2]) * fn; vg = zc + mg0 * (zp - zc) + mg1 * (zn - zc); }
            if (act[u]) {
                if (lane == 0) { rsq[t] = rsqrtf(s * (1.f / 256.f) + 1e-6f); rskv[t] = rsqrtf(s2 * (1.f / 128.f) + 1e-6f); }
                const int h = lane >> 4, j = (lane & 15) * 4;
                bf16_t* sc = SC + (size_t)t * 2048 + h * 512 + j;
                u32x2 w;
                w.x = pk2(zs[0][0], zs[0][1]); w.y = pk2(zs[0][2], zs[0][3]); *(u32x2*)(sc) = w;
                w.x = pk2(zs[2][0], zs[2][1]); w.y = pk2(zs[2][2], zs[2][3]); *(u32x2*)(sc + 64) = w;
                w.x = pk2(zs[1][0], zs[1][1]); w.y = pk2(zs[1][2], zs[1][3]); *(u32x2*)(sc + 128) = w;
                w.x = pk2(kk[0] * inv, kk[1] * inv); w.y = pk2(kk[2] * inv, kk[3] * inv); *(u32x2*)(sc + 192) = w;
                AWA[(size_t)t * 64 + lane] = f2bf(lane < 32 ? 2.f * sigmoidf_(2.f * vw) - 1.f : vw);
                AG[(size_t)t * 64 + lane] = f2bf(sigmoidf_(vg));
            }
        }
    }
}

DEV void phase_gemm_small(const Params& p, int l, int c, char* smem) {
    char* scr = p.ws + OFF_SCR;
    const bf16_t* ZR = (const bf16_t*)(scr + SO_ZR);
    const float* cosT = (const float*)(p.ws + OFF_COS); const float* sinT = (const float*)(p.ws + OFF_SIN);
    EpiUQ euq{(bf16_t*)(scr + SO_MQ), (const float*)(p.ws + OFF_RSQ), cosT, sinT};
    EpiUKV eukv{(bf16_t*)(scr + SO_KN), (bf16_t*)(scr + SO_VTM), (const float*)(p.ws + OFF_RSKV)};
    EpiWA ewa{(bf16_t*)(scr + SO_SC) + (size_t)c * TC * 2048, p.in[16] + (size_t)l * 512, p.in[18] + (size_t)l * 512};
    constexpr int NTM = TC / 128;
    constexpr int T1 = NTM * 3, T2 = T1 + NTM * 4, T3 = T2 + NTM * 8;
    for (int t = blockIdx.x; t < T3; t += gridDim.x) {
        if (t < T1) { const int tm = t / 3, tn = t - tm * 3; gemm_tile(ZR + 768, ZRW, wl(p, l, WE_UQ), 256, 256, tm, tn, smem, euq); }
        else if (t < T2) { const int u = t - T1, tm = u >> 2, tn = u & 3; gemm_tile(ZR + 1024, ZRW, wl(p, l, WE_UKV), 128, 128, tm, tn, smem, eukv); }
        else { const int u = t - T2, tm = u >> 3, tn = u & 7; gemm_tile((const bf16_t*)(scr + SO_AWA), 64, wl(p, l, WE_WA), 64, 64, tm, tn, smem, ewa); }
    }
}

DEV void phase_mix(const Params& p, int l, int c, int phase_idx, char* smem, int rmask, int* s_item) {
    char* scr = p.ws + OFF_SCR;
    const bf16_t* QK = (const bf16_t*)(scr + SO_QK); const bf16_t* ZR = (const bf16_t*)(scr + SO_ZR);
    const bf16_t* MQ = (const bf16_t*)(scr + SO_MQ); const bf16_t* KN = (const bf16_t*)(scr + SO_KN);
    const bf16_t* VtNA = (const bf16_t*)(scr + SO_VTNA); const bf16_t* VtD = (const bf16_t*)(scr + SO_VTD); const bf16_t* VtM = (const bf16_t*)(scr + SO_VTM);
    bf16_t* MIX = (bf16_t*)(p.ws + OFF_H) + (size_t)c * TC * 1024;
    int* ctr = (int*)(p.ws + OFF_CTR) + phase_idx;
    const bool need_ctx = l < DEPTH - 1;
    const float lam = ((const float*)(p.ws + OFF_LAM))[l];
    const float lam_init = 0.8f - 0.6f * expf(-0.3f * (float)l);
    constexpr int DQ = 64 * DMQ, DLT = SEQ / DQ, DCT = CTXL / DQ;
    const int N_SCAN = (c == NCHUNK - 1) ? NBATCH * 8 : 0; constexpr int N_ML = CB * 64, N_DL = CB * 4 * DLT, N_NL = CB * 128, N_MC = CB * 8, N_DC = CB * 4 * DCT, N_NC = CB * 16;
    const int E0 = N_SCAN, E1 = E0 + N_ML, E2 = E1 + N_DL, E3 = E2 + N_NL, E4 = E3 + N_MC, E5 = E4 + N_DC, E6 = E5 + N_NC;
    const int total = need_ctx ? E6 : E3;
    constexpr float L2E = 1.44269504f;
    if (rmask & 1) for (int it = blockIdx.x; it < N_SCAN; it += gridDim.x) {
        const int bl = it >> 3, h = (it >> 1) & 3, dir = it & 1;
        __builtin_amdgcn_s_setprio(3);
        scan_item((const bf16_t*)(scr + SO_SC), (float*)(scr + SO_Y), bl, h, dir, p.in[22] + l * 256, smem);
        __builtin_amdgcn_s_setprio(0);
    }
    for (;;) {
        if (tid_() == 0) *s_item = E0 + atomicAdd(ctr, 1);
        __syncthreads();
        const int it = __builtin_amdgcn_readfirstlane(*s_item);
        __syncthreads();
        if (it >= total) break;
        if (!(rmask & 2)) continue;
        AttnArgs a{};
        if (it < E0) {
        } else if (it < E1 || (it >= E3 && it < E4)) {
            const bool cx = it >= E3; int bl, h, q0;
            if (!cx) { const int u = it - E0; bl = u >> 6; h = (u >> 4) & 3; q0 = (u & 15) * 128; }
            else { const int u = it - E3; bl = u >> 3; h = (u >> 1) & 3; q0 = SEQ + (u & 1) * 128; }
            const size_t tb = (size_t)bl * TT;
            a.Q = MQ + (tb + q0) * 384 + h * 96; a.qs = 384;
            a.K = KN + tb * 256 + h * 64; a.ks = 256; a.K2 = ZR + tb * ZRW + 1152; a.k2s = ZRW;
            a.Vt = VtM + ((size_t)(bl * 4 + h) * 64) * TT;
            a.O = MIX + (tb + q0) * 1024 + 256 + h * 64; a.os = 1024;
            a.kstart = cx ? SEQ : 0; a.nkt = cx ? 4 : 36; a.sc2 = 0.10206207261596575f * L2E;
            if (MIXMASK & 2) attn_item<96, 1, 2, false>(a, smem);
        } else if (it < E2 || (it >= E4 && it < E5)) {
            const bool cx = it >= E4; int bl, h, q0;
            if (!cx) { const int u = it - E1; bl = u / (4 * DLT); h = (u / DLT) & 3; q0 = (u % DLT) * DQ; }
            else { const int u = it - E4; bl = u / (4 * DCT); h = (u / DCT) & 3; q0 = SEQ + (u % DCT) * DQ; }
            const size_t tb = (size_t)bl * TT;
            a.Q = QK + (tb + q0) * 1024 + 512 + h * 64; a.qs = 1024;
            a.K = QK + tb * 1024 + 768 + h * 64; a.ks = 1024;
            a.Vt = VtD + ((size_t)(bl * 4 + h) * 64) * TT;
            a.O = MIX + (tb + q0) * 1024 + 768 + h * 64; a.os = 1024;
            a.kstart = cx ? SEQ : 0; a.nkt = cx ? 4 : 36; a.sc2 = 0.17677669529663687f * L2E;
            a.lam = lam; a.oscale = 1.f - lam_init; a.subln = p.in[27] + l * 64;
            if (MIXMASK & 4) attn_item<64, 2, DMQ, false>(a, smem);
        } else {
            const bool cx = it >= E5; int bl, h, q0;
            if (!cx) { const int u = it - E2; bl = u >> 7; h = (u >> 5) & 3; const int r = u & 31; q0 = r * 64; a.na_r = r; a.na_rs = min(max(r - 4, 0), 24); }
            else { const int u = it - E5; bl = u >> 4; h = (u >> 2) & 3; q0 = SEQ + (u & 3) * 64; }
            const size_t tb = (size_t)bl * TT;
            a.Q = QK + (tb + q0) * 1024 + h * 64; a.qs = 1024;
            a.K = QK + tb * 1024 + 256 + h * 64; a.ks = 1024;
            a.Vt = VtNA + ((size_t)(bl * 4 + h) * 64) * TT;
            a.O = MIX + (tb + q0) * 1024 + h * 64; a.os = 1024;
            a.sc2 = 0.125f * L2E; a.rpb = p.in[10] + ((size_t)l * 4 + h) * 465;
            if (!cx) { a.nkt = 12; if (MIXMASK & 8) attn_item<64, 1, 1, true>(a, smem); }
            else { a.kstart = SEQ; a.nkt = 4; if (MIXMASK & 16) attn_item<64, 1, 1, false>(a, smem); }
        }
    }
}

DEV void phase_fix(const Params& p, int l) {
    char* scr = p.ws + OFF_SCR;
    bf16_t* G = (bf16_t*)(scr + SO_G); const float* E = (const float*)(scr + SO_E);
    const float* cw = p.in[29] + (size_t)l * 3 * DFF;
    const bool skip_ctx = !(l < DEPTH - 1);
    constexpr int NTM = T_ALL / 128;
    const int total = NTM * (DFF / 4);
    for (int idx = blockIdx.x * NTHR + tid_(); idx < total; idx += gridDim.x * NTHR) {
        const int tm = idx / (DFF / 4), j = (idx - tm * (DFF / 4)) * 4;
        const int row0 = tm * 128, tt0 = row0 % TT;
        if (skip_ctx && tt0 >= SEQ) continue;
        const bool first = (tt0 == 0 || tt0 == SEQ), last = (tt0 + 127 == SEQ - 1 || tt0 + 127 == TT - 1);
        if (!first) {
            const float* e = E + ((size_t)tm * 6) * DFF + j; const float* ep = E + ((size_t)(tm - 1) * 6 + 5) * DFF + j;
            const f32x4 pre = *(const f32x4*)(e) + *(const f32x4*)(cw + j) * *(const f32x4*)(ep), bv = *(const f32x4*)(e + DFF);
            u32x2 w; w.x = pk2(siluf_(pre[0]) * bv[0], siluf_(pre[1]) * bv[1]); w.y = pk2(siluf_(pre[2]) * bv[2], siluf_(pre[3]) * bv[3]);
            *(u32x2*)(G + (size_t)row0 * DFF + j) = w;
        }
        if (!last) {
            const float* e = E + ((size_t)tm * 6 + 3) * DFF + j; const float* en = E + ((size_t)(tm + 1) * 6 + 2) * DFF + j;
            const f32x4 pre = *(const f32x4*)(e) + *(const f32x4*)(cw + 2 * DFF + j) * *(const f32x4*)(en), bv = *(const f32x4*)(e + DFF);
            u32x2 w; w.x = pk2(siluf_(pre[0]) * bv[0], siluf_(pre[1]) * bv[1]); w.y = pk2(siluf_(pre[2]) * bv[2], siluf_(pre[3]) * bv[3]);
            *(u32x2*)(G + (size_t)(row0 + 127) * DFF + j) = w;
        }
    }
}

DEV int cm_in(int n) {
    if (n < 768) return n;
    if (n < 1536) return 2080 + (n - 768);
    if (n < 2304) return 1184 + (n - 1536);
    if (n < 2560) return 768 + (n - 2304);
    if (n < 2688) return 1024 + (n - 2560);
    if (n < 2816) { const int o = n - 2688; return o < 32 ? 1152 + o : (o < 64 ? 1952 + (o - 32) : (o < 96 ? 1984 + (o - 64) : -1)); }
    { const int o = n - 2816; return o < 64 ? 2016 + o : -1; }
}
DEV int cm_up(int n) { const int t = n >> 7, o = n & 127; return o < 64 ? t * 64 + o : DFF + t * 64 + (o - 64); }

template <int MODE>
DEV void conv_unit(const float* src, int lds_, bf16_t* dst, int K, int nt, int kt, float* tile) {
    const int tid = tid_(), a = tid & 63, b = tid >> 6;
    const int n = nt * 64 + a;
    const int col = MODE == 0 ? cm_in(n) : (MODE == 2 ? cm_up(n) : n);
#pragma unroll 4
    for (int i = 0; i < 16; ++i) { const int kl = b + 4 * i; tile[kl * 65 + a] = col >= 0 ? src[(size_t)(kt * 64 + kl) * lds_ + col] : 0.f; }
    __syncthreads();
#pragma unroll 4
    for (int i = 0; i < 16; ++i) { const int nl = b + 4 * i; dst[(size_t)(nt * 64 + nl) * K + kt * 64 + a] = f2bf(tile[a * 65 + nl]); }
    __syncthreads();
}

DEV void phase_prologue(const Params& p, char* smem) {
    const int tid = tid_(), gtid = blockIdx.x * NTHR + tid, gsz = gridDim.x * NTHR;
    if (blockIdx.x == 0) {
        int* ctr = (int*)(p.ws + OFF_CTR); ctr[tid] = 0;
        if (tid < DEPTH) {
            const float* lp = p.in[26] + tid * 128; float s0 = 0.f, s1 = 0.f;
            for (int i = 0; i < 32; ++i) { s0 += lp[i] * lp[32 + i]; s1 += lp[64 + i] * lp[96 + i]; }
            ((float*)(p.ws + OFF_LAM))[tid] = expf(s0) - expf(s1) + (0.8f - 0.6f * expf(-0.3f * (float)tid));
        }
    }
    for (int i = gtid; i < 2048 * 16; i += gsz) {
        const int tt = i >> 4, f = i & 15; const float pos = (float)(f < 8 ? tt / 64 : tt % 64);
        const float freq = powf(10000.f, -(float)(f & 7) / 8.f); const float ang = pos * freq;
        ((float*)(p.ws + OFF_COS))[i] = cosf(ang); ((float*)(p.ws + OFF_SIN))[i] = sinf(ang);
    }
    for (int i = gtid; i < DEPTH * 245760; i += gsz) {
        const int l = i / 245760; int e = i - l * 245760;
        if (e < 98304) { const int n = e >> 8, k = e & 255; wlw(p, l, WE_UQ)[e] = f2bf(p.in[13][((size_t)l * 256 + k) * 384 + n] * p.in[11][l * 256 + k]); }
        else if ((e -= 98304) < 65536) { const int n = e >> 7, k = e & 127; wlw(p, l, WE_UKV)[e] = f2bf(p.in[14][((size_t)l * 128 + k) * 512 + n] * p.in[12][l * 128 + k]); }
        else if ((e -= 65536) < 65536) { const int n = e >> 6, k = e & 63, seg = n >> 8, ch = n & 255; float v = 0.f;
            if (seg < 2) { if (k < 32) v = p.in[17][(((size_t)l * 2 + seg) * 32 + k) * 256 + ch]; }
            else { if (k >= 32) v = p.in[19][(((size_t)l * 2 + (seg - 2)) * 32 + (k - 32)) * 256 + ch]; }
            wlw(p, l, WE_WA)[e] = f2bf(v); }
        else { e -= 65536; const int n = e >> 6, k = e & 63; wlw(p, l, WE_G)[e] = f2bf(p.in[20][((size_t)l * 64 + k) * 256 + n]); }
    }
    {
        constexpr int U_IN = (ZN / 64) * 16, U_OUT = 16 * 16, U_UP = 88 * 16, U_DN = 16 * 44, U_L = U_IN + U_OUT + U_UP + U_DN;
        float* tile = (float*)smem;
        for (int u = blockIdx.x; u < DEPTH * U_L; u += gridDim.x) {
            const int l = u / U_L; int e = u - l * U_L;
            if (e < U_IN) conv_unit<0>(p.in[8] + (size_t)l * 1024 * 2848, 2848, wlw(p, l, WE_IN), 1024, e >> 4, e & 15, tile);
            else if ((e -= U_IN) < U_OUT) conv_unit<1>(p.in[9] + (size_t)l * 1024 * 1024, 1024, wlw(p, l, WE_OUT), 1024, e >> 4, e & 15, tile);
            else if ((e -= U_OUT) < U_UP) conv_unit<2>(p.in[28] + (size_t)l * 1024 * 5632, 5632, wlw(p, l, WE_UP), 1024, e >> 4, e & 15, tile);
            else { e -= U_UP; conv_unit<1>(p.in[31] + (size_t)l * 2816 * 1024, 1024, wlw(p, l, WE_DOWN), 2816, e / 44, e % 44, tile); }
        }
    }
    {
        float* Ssm = (float*)smem;
        float* red = Ssm + 33 * 128;
        const int lane = tid & 63, w = tid >> 6;
        for (int u = blockIdx.x; u < DEPTH * 96; u += gridDim.x) {
            const int l = u / 96, n0 = (u - l * 96) * 64;
            const float* W = p.in[6] + (size_t)l * 1024 * 6144 + n0 + lane;
            float acc[33];
#pragma unroll
            for (int r = 0; r < 33; ++r) acc[r] = 0.f;
            for (int kc = 0; kc < 8; ++kc) {
                __syncthreads();
                for (int i = tid; i < 33 * 128; i += NTHR) { const int r = i >> 7, k = kc * 128 + (i & 127); const float cv = r < 32 ? p.in[1][r * 1024 + k] : p.in[3][k]; Ssm[i] = siluf_(cv); }
                __syncthreads();
                for (int kk = 0; kk < 32; ++kk) {
                    const int kl = w * 32 + kk; const float wv = W[(size_t)(kc * 128 + kl) * 6144];
#pragma unroll
                    for (int r = 0; r < 33; ++r) acc[r] += Ssm[r * 128 + kl] * wv;
                }
            }
#pragma unroll
            for (int r = 0; r < 33; ++r) red[(w * 33 + r) * 64 + lane] = acc[r];
            __syncthreads();
            for (int i = tid; i < 33 * 64; i += NTHR) {
                const int r = i >> 6, n = i & 63;
                const float v = red[(0 * 33 + r) * 64 + n] + red[(1 * 33 + r) * 64 + n] + red[(2 * 33 + r) * 64 + n] + red[(3 * 33 + r) * 64 + n];
                ((float*)(p.ws + OFF_MOD))[((size_t)l * 33 + r) * 6144 + n0 + n] = v + p.in[7][(size_t)l * 6144 + n0 + n];
            }
            __syncthreads();
        }
    }
}

constexpr int PH_PER_LAYER = 15, N_PHASES = 2 + DEPTH * PH_PER_LAYER;

DEV void run_phase(const Params& p, int ph, char* smem, int ctr_off, int* s_item) {
    if (ph == 0) { phase_prologue(p, smem); return; }
    if (ph == N_PHASES - 1) { phase_final(p); return; }
    const int l = (ph - 1) / PH_PER_LAYER, s = (ph - 1) % PH_PER_LAYER;
    const bool last_layer = (l == DEPTH - 1);
    char* scr = p.ws + OFF_SCR;
    const float* mod = (const float*)(p.ws + OFF_MOD) + (size_t)l * 33 * 6144;
    const bf16_t* H = (const bf16_t*)(p.ws + OFF_H);
    if (s == 0) { phase_norm(p, l, 0, false); return; }
    if (s >= 1 && s <= 8) {
        const int c = (s - 1) / 4, q = (s - 1) % 4;
        if (q == 0) {
            EpiIn e{(bf16_t*)(scr + SO_QK), (bf16_t*)(scr + SO_ZR), (bf16_t*)(scr + SO_VTNA), (bf16_t*)(scr + SO_VTD), (const float*)(p.ws + OFF_COS), (const float*)(p.ws + OFF_SIN)};
            gemm_phase(H + (size_t)c * TC * 1024, 1024, wl(p, l, WE_IN), 1024, 1024, TC / 128, ZN / 128, false, smem, e);
        } else if (q == 1) phase_prep(p, l, c);
        else if (q == 2) phase_gemm_small(p, l, c, smem);
        else phase_mix(p, l, c, ph + ctr_off, smem, ctr_off ? PROBE_MIXSEL : 3, s_item);
        return;
    }
    if (s == 9) {
        EpiG e{(bf16_t*)(p.ws + OFF_H), (const bf16_t*)(scr + SO_SC), (const float*)(scr + SO_Y), p.in[23] + l * 256, p.in[24] + l * 256, p.in[25] + l * 256, 0};
        gemm_phase((const bf16_t*)(scr + SO_AG), 64, wl(p, l, WE_G), 64, 64, T_ALL / 128, 2, last_layer, smem, e);
        return;
    }
    if (s == 10) { EpiRes e{&p, mod, 2048, l == 0 ? 1 : 0}; gemm_phase(H, 1024, wl(p, l, WE_OUT), 1024, 1024, T_ALL / 128, 8, last_layer, smem, e); return; }
    if (s == 11) { phase_norm(p, l, 1, last_layer); return; }
    if (s == 12) { EpiUp e{(bf16_t*)(scr + SO_G), (float*)(scr + SO_E), p.in[29] + (size_t)l * 3 * DFF, p.in[30] + (size_t)l * DFF};
                   gemm_phase(H, 1024, wl(p, l, WE_UP), 1024, 1024, T_ALL / 128, 44, last_layer, smem, e); return; }
    if (s == 13) { phase_fix(p, l); return; }
    { EpiRes e{&p, mod, 5120, 0}; gemm_phase((const bf16_t*)(scr + SO_G), DFF, wl(p, l, WE_DOWN), DFF, DFF, T_ALL / 128, 8, last_layer, smem, e); }
}

#define XB_TMO      128
#define XB_XCNT(j)  (256  + 64 * (j))
#define XB_XSUB(j)  (1280 + 64 * (j))
#define XB_XGEN(j)  (2304 + 64 * (j))
#define XB_TOP      3328
#define XB_TOPGEN   3392
#define XCD_BAR_WORDS 3456
#define XB_SPIN_CAP (1u << 18)

__device__ __forceinline__ unsigned xb_ld(unsigned* p)              { return __hip_atomic_load(p, __ATOMIC_RELAXED, __HIP_MEMORY_SCOPE_AGENT); }
__device__ __forceinline__ unsigned xb_add(unsigned* p, unsigned v) { return __hip_atomic_fetch_add(p, v, __ATOMIC_RELAXED, __HIP_MEMORY_SCOPE_AGENT); }
__device__ __forceinline__ unsigned xb_xcc_id() { return (unsigned)__builtin_amdgcn_s_getreg((3 << 11) | 20) & 0xFu; }
#define XB_SPIN(cond, bar) do { unsigned _sp = 0; while (cond) { __builtin_amdgcn_s_sleep(1); \
    if ((++_sp & 255u) == 0u) { if (xb_ld(&(bar)[XB_TMO])) break; if (_sp > XB_SPIN_CAP) { atomicAdd(&(bar)[XB_TMO], 1u); break; } } } } while (0)

struct XcdBarrier {
    unsigned* bar; unsigned x;
    volatile LAS unsigned* st;
};

__device__ __forceinline__ XcdBarrier xcd_barrier_post(unsigned* bar, volatile LAS unsigned* st) {
    XcdBarrier b; b.bar = bar; b.x = xb_xcc_id(); b.st = st;
    if (threadIdx.x == 0) (void)xb_add(&bar[XB_XCNT(b.x)], 1u);
    return b;
}
__device__ __forceinline__ void xcd_barrier_complete(unsigned* bar, unsigned x, unsigned& nloc, unsigned& nx) {
    const unsigned G = gridDim.x * gridDim.y * gridDim.z;
    unsigned sum, cnt, mine, sp = 0u;
    for (;;) {
        sum = 0u; cnt = 0u; mine = 0u;
#pragma unroll
        for (unsigned j = 0; j < 16; ++j) { const unsigned c = xb_ld(&bar[XB_XCNT(j)]); sum += c; cnt += (c > 0u) ? 1u : 0u; mine = (j == x) ? c : mine; }
        if (sum == G) break;
        __builtin_amdgcn_s_sleep(1);
        if ((++sp & 255u) == 0u) { if (xb_ld(&bar[XB_TMO])) break; if (sp > XB_SPIN_CAP) { atomicAdd(&bar[XB_TMO], 1u); break; } }
    }
    nloc = mine > 0u ? mine : 1u; nx = cnt > 0u ? cnt : 1u;
}

__device__ __forceinline__ void xcd_barrier(const XcdBarrier& b) {
    asm volatile("s_waitcnt vmcnt(0)" ::: "memory");
    __syncthreads();
    if (threadIdx.x == 0) {
        unsigned* bar = b.bar;
        __builtin_amdgcn_s_waitcnt(0);
        unsigned nloc = b.st[0], nx = b.st[1];
        if (nloc == 0u) { xcd_barrier_complete(bar, b.x, nloc, nx); b.st[0] = nloc; b.st[1] = nx; }
        const unsigned old = xb_add(&bar[XB_XSUB(b.x)], 1u);
        const unsigned gen = old / nloc;
        if (old + 1u == (gen + 1u) * nloc) {
            __builtin_amdgcn_fence(__ATOMIC_RELEASE, "agent");
            asm volatile("s_waitcnt vmcnt(0)" ::: "memory");
            const unsigned og = xb_add(&bar[XB_TOP], 1u);
            const unsigned tg = og / nx;
            if (og + 1u == (tg + 1u) * nx) xb_add(&bar[XB_TOPGEN], 1u);
            else XB_SPIN(xb_ld(&bar[XB_TOPGEN]) == tg, bar);
            __builtin_amdgcn_fence(__ATOMIC_ACQUIRE, "agent");
            xb_add(&bar[XB_XGEN(b.x)], 1u);
            asm volatile("s_waitcnt vmcnt(0)" ::: "memory");
        } else {
            XB_SPIN(xb_ld(&bar[XB_XGEN(b.x)]) == gen, bar);
            __builtin_amdgcn_fence(__ATOMIC_ACQUIRE, "agent");
            asm volatile("s_waitcnt vmcnt(0)" ::: "memory");
        }
    }
    __syncthreads();
}


__global__ void __launch_bounds__(NTHR, 2) mk_fwd(Params p, int ph_lo, int ph_hi) {
    extern __shared__ __attribute__((aligned(16))) char smem[];
    __shared__ uint4 s_ctl;
    if (threadIdx.x == 0) s_ctl = make_uint4(0u, 0u, 0u, 0u);
    __syncthreads();
    XcdBarrier xb = xcd_barrier_post((unsigned*)(p.ws + OFF_XBAR), (volatile LAS unsigned*)&s_ctl);
    int* s_item = (int*)&s_ctl + 2;
    for (int ph = ph_lo; ph <= ph_hi; ++ph) {
        run_phase(p, ph, smem, 0, s_item);
#ifdef PROBE_DUP
        if (ph > 0 && ph < N_PHASES - 1) {
            const int s_ = (ph - 1) % PH_PER_LAYER, q_ = (s_ >= 1 && s_ <= 8) ? (s_ - 1) % 4 : -1;
            bool dup = false;
            if ((PROBE_DUP & 1) && (q_ == 0)) dup = true;
            if ((PROBE_DUP & 2) && (s_ == 12)) dup = true;
            if ((PROBE_DUP & 4) && (q_ == 3)) dup = true;
            if ((PROBE_DUP & 8) && (q_ == 2 || s_ == 9)) dup = true;
            if ((PROBE_DUP & 16) && (s_ == 0 || s_ == 11 || q_ == 1 || s_ == 13)) dup = true;
            if (dup) run_phase(p, ph, smem, 100, s_item);
        }
#endif
        if (ph < ph_hi) {
            if (ph_lo < 0) cg::this_grid().sync();
            xcd_barrier(xb);
        }
    }
}

extern "C" void kernel_launch(void* const* d_in, const int* in_sizes, int n_in, void* d_out, int out_size, void* d_ws, size_t ws_size, hipStream_t stream) {
    static int grid = 0;
    if (grid == 0) {
        if (n_in != 33 || ws_size < WS_NEED) { fprintf(stderr, "kernel_launch: n_in %d ws %zu need %zu\n", n_in, ws_size, (size_t)WS_NEED); grid = -1; return; }
        int dev = 0, cus = 0, per_cu = 0;
        hipGetDevice(&dev);
        hipDeviceGetAttribute(&cus, hipDeviceAttributeMultiprocessorCount, dev);
        if (hipFuncSetAttribute((const void*)mk_fwd, hipFuncAttributeMaxDynamicSharedMemorySize, LDS_BYTES) != hipSuccess) { fprintf(stderr, "hipFuncSetAttribute failed\n"); grid = -1; return; }
        if (hipOccupancyMaxActiveBlocksPerMultiprocessor(&per_cu, (const void*)mk_fwd, NTHR, LDS_BYTES) != hipSuccess || per_cu < 1) { fprintf(stderr, "occupancy query failed (%d)\n", per_cu); per_cu = 1; }
        if (per_cu > 2) per_cu = 2;
        grid = cus * per_cu;
        fprintf(stderr, "kernel_launch: grid %d (%d CUs x %d)\n", grid, cus, per_cu);
    }
    if (grid < 0) return;
    Params p{};
    for (int i = 0; i < 33; ++i) p.in[i] = (const float*)d_in[i];
    p.out = (float*)d_out; p.ws = (char*)d_ws;
#if MK_ONE_LAUNCH
    if (hipMemsetAsync((char*)d_ws + OFF_XBAR, 0, XCD_BAR_WORDS * 4, stream) != hipSuccess) { fprintf(stderr, "memset failed\n"); return; }
    int lo = 0, hi = N_PHASES - 1;
    void* args[] = {&p, &lo, &hi};
    hipError_t e = hipLaunchCooperativeKernel((const void*)mk_fwd, dim3(grid), dim3(NTHR), args, LDS_BYTES, stream);
    if (e != hipSuccess) fprintf(stderr, "cooperative launch failed: %s (grid %d)\n", hipGetErrorString(e), grid);
#else
    for (int ph = 0; ph < N_PHASES; ++ph) {
        int lo = ph, hi = ph;
        void* args[] = {&p, &lo, &hi};
        hipError_t e = hipLaunchCooperativeKernel((const void*)mk_fwd, dim3(grid), dim3(NTHR), args, LDS_BYTES, stream);
        if (e != hipSuccess) { fprintf(stderr, "launch %d failed: %s (grid %d)\n", ph, hipGetErrorString(e), grid); break; }
    }
#endif
}
```

```cpp
#include <hip/hip_runtime.h>
#include <hip/hip_cooperative_groups.h>
#include <cstdio>
#include <cstdint>
namespace cg = cooperative_groups;

#ifndef MK_ONE_LAUNCH
#define MK_ONE_LAUNCH 1
#endif

typedef unsigned short bf16_t;
typedef short bf16x8 __attribute__((ext_vector_type(8)));
typedef float f32x4 __attribute__((ext_vector_type(4)));
typedef unsigned u32x4 __attribute__((ext_vector_type(4)));
typedef unsigned u32x2 __attribute__((ext_vector_type(2)));
#define DEV __device__ __forceinline__
#define LAS __attribute__((address_space(3)))

constexpr int D = 1024, NBATCH = 32, SEQ = 2048, CTXL = 256, TT = 2304, T_ALL = NBATCH * TT, DEPTH = 4, DFF = 2816;
constexpr int NCHUNK = 2, CB = NBATCH / NCHUNK, TC = CB * TT;
constexpr int ZN = 2944, ZRW = 1408;
constexpr int NTHR = 256;
constexpr int LDS_BYTES = 73728;
constexpr int GP = 72;
constexpr int CP = 132;
#ifndef PROBE_MIXSEL
#define PROBE_MIXSEL 3
#endif
#ifndef MIXMASK
#define MIXMASK 31
#endif
#ifndef DMQ
#define DMQ 2
#endif

constexpr size_t al256(size_t x) { return (x + 255) & ~(size_t)255; }
constexpr size_t OFF_CTR = 0;
constexpr size_t OFF_LAM = 1024;
constexpr size_t OFF_XBAR = 4096;
constexpr size_t OFF_COS = 32768;
constexpr size_t OFF_SIN = OFF_COS + 2048 * 16 * 4;
constexpr size_t OFF_MOD = OFF_SIN + 2048 * 16 * 4;
constexpr size_t OFF_RSQ = al256(OFF_MOD + (size_t)DEPTH * 33 * 6144 * 4);
constexpr size_t OFF_RSKV = OFF_RSQ + (size_t)TC * 4;
constexpr size_t OFF_XC = al256(OFF_RSKV + (size_t)TC * 4);
constexpr size_t OFF_W = al256(OFF_XC + (size_t)NBATCH * CTXL * D * 4);
constexpr size_t WE_IN = 0;
constexpr size_t WE_OUT = WE_IN + (size_t)ZN * 1024;
constexpr size_t WE_UP = WE_OUT + (size_t)1024 * 1024;
constexpr size_t WE_DOWN = WE_UP + (size_t)5632 * 1024;
constexpr size_t WE_UQ = WE_DOWN + (size_t)1024 * 2816;
constexpr size_t WE_UKV = WE_UQ + (size_t)384 * 256;
constexpr size_t WE_WA = WE_UKV + (size_t)512 * 128;
constexpr size_t WE_G = WE_WA + (size_t)1024 * 64;
constexpr size_t WE_TOTAL = WE_G + (size_t)256 * 64;
constexpr size_t OFF_H = al256(OFF_W + (size_t)DEPTH * WE_TOTAL * 2);
constexpr size_t OFF_SCR = al256(OFF_H + (size_t)T_ALL * 1024 * 2);
constexpr size_t SO_QK = 0;
constexpr size_t SO_ZR = al256(SO_QK + (size_t)TC * 1024 * 2);
constexpr size_t VT_ELEMS = (size_t)CB * 4 * 64 * TT;
constexpr size_t SO_VTNA = al256(SO_ZR + (size_t)TC * ZRW * 2);
constexpr size_t SO_VTD = SO_VTNA + VT_ELEMS * 2;
constexpr size_t SO_VTM = SO_VTD + VT_ELEMS * 2;
constexpr size_t SO_MQ = SO_VTM + VT_ELEMS * 2;
constexpr size_t SO_KN = al256(SO_MQ + (size_t)TC * 384 * 2);
constexpr size_t SO_AWA = al256(SO_KN + (size_t)TC * 256 * 2);
constexpr size_t SO_AG = al256(SO_AWA + (size_t)TC * 64 * 2);
constexpr size_t SO_SC = al256(SO_AG + (size_t)T_ALL * 64 * 2);
constexpr size_t SO_Y = al256(SO_SC + (size_t)T_ALL * 2048 * 2);
constexpr size_t SO_END = al256(SO_Y + (size_t)2 * T_ALL * 256 * 4);
constexpr size_t SO_G = 0;
constexpr size_t SO_E = al256(SO_G + (size_t)T_ALL * DFF * 2);
constexpr size_t SO_END2 = al256(SO_E + (size_t)(T_ALL / 128) * 6 * DFF * 4);
constexpr size_t WS_NEED = OFF_SCR + (SO_END > SO_END2 ? SO_END : SO_END2);

struct Params { const float* in[33]; float* out; char* ws; };

DEV int tid_() { int t = __builtin_amdgcn_workitem_id_x(); asm volatile("" : "+v"(t)); return t; }
DEV float bf2f(bf16_t b) { return __uint_as_float(((unsigned)b) << 16); }
DEV bf16_t f2bf(float f) { unsigned u = __float_as_uint(f); u += 0x7fffu + ((u >> 16) & 1u); return (bf16_t)(u >> 16); }
typedef __bf16 bf16v2_t __attribute__((ext_vector_type(2)));
typedef float f32v2_t __attribute__((ext_vector_type(2)));
DEV unsigned pk2(float a, float b) { const f32v2_t f = {a, b}; return __builtin_bit_cast(unsigned, __builtin_convertvector(f, bf16v2_t)); }
DEV float lo_bf(unsigned u) { return __uint_as_float(u << 16); }
DEV float hi_bf(unsigned u) { return __uint_as_float(u & 0xffff0000u); }
DEV float wave_sum(float v) {
#pragma unroll
    for (int o = 32; o >= 1; o >>= 1) v += __shfl_xor(v, o);
    return v;
}
template <int CTRL> DEV float dppf(float v) { return __builtin_bit_cast(float, __builtin_amdgcn_update_dpp(0, __builtin_bit_cast(int, v), CTRL, 0xf, 0xf, true)); }
DEV float sum16(float v) { v += dppf<0xB1>(v); v += dppf<0x4E>(v); v += dppf<0x124>(v); v += dppf<0x128>(v); return v; }
DEV float max16(float v) { v = fmaxf(v, dppf<0xB1>(v)); v = fmaxf(v, dppf<0x4E>(v)); v = fmaxf(v, dppf<0x124>(v)); v = fmaxf(v, dppf<0x128>(v)); return v; }
DEV float sum32(float v) { v = sum16(v); v += __shfl_xor(v, 16); return v; }
DEV float sigmoidf_(float x) { return __builtin_amdgcn_rcpf(1.f + __expf(-x)); }
DEV float siluf_(float x) { return x * __builtin_amdgcn_rcpf(1.f + __expf(-x)); }

DEV float* xrow(const Params& p, int g) {
    const int b = g / TT, tt = g - b * TT;
    return tt < SEQ ? p.out + ((size_t)b * SEQ + tt) * D : (float*)(p.ws + OFF_XC) + ((size_t)b * CTXL + (tt - SEQ)) * D;
}
DEV const float* xrow_in(const Params& p, int g) {
    const int b = g / TT, tt = g - b * TT;
    return tt < SEQ ? p.in[0] + ((size_t)b * SEQ + tt) * D : p.in[2] + ((size_t)b * CTXL + (tt - SEQ)) * D;
}
DEV const bf16_t* wl(const Params& p, int l, size_t we) { return (const bf16_t*)(p.ws + OFF_W) + (size_t)l * WE_TOTAL + we; }
DEV bf16_t* wlw(const Params& p, int l, size_t we) { return (bf16_t*)(p.ws + OFF_W) + (size_t)l * WE_TOTAL + we; }

template <class Epi>
DEV void gemm_tile(const bf16_t* __restrict__ A, int lda, const bf16_t* __restrict__ Bt, int ldb, int K, int tm, int tn, char* smem, const Epi& epi) {
    const int tid = tid_(), lane = tid & 63, wid = tid >> 6, wr = wid >> 1, wc = wid & 1, fr = lane & 15, fq = lane >> 4;
    bf16_t* As = (bf16_t*)smem;
    bf16_t* Bs = As + 2 * 128 * 64;
    const int lrow = tid >> 3, lcc = (tid & 7) * 8, lsw = (((tid & 7) ^ (lrow & 7)) * 8);
    const bf16_t* Ag = A + (size_t)(tm * 128 + lrow) * lda + lcc;
    const bf16_t* Bg = Bt + (size_t)(tn * 128 + lrow) * ldb + lcc;
    f32x4 acc[4][4];
#pragma unroll
    for (int m = 0; m < 4; ++m)
#pragma unroll
        for (int n = 0; n < 4; ++n) acc[m][n] = (f32x4){0.f, 0.f, 0.f, 0.f};
    const int gsw = (((tid & 7) ^ (lrow & 7)) * 8);
    const bf16_t* Ad = A + (size_t)(tm * 128 + lrow) * lda + gsw;
    const bf16_t* Bd = Bt + (size_t)(tn * 128 + lrow) * ldb + gsw;
    char* Asb = (char*)As; char* Bsb = (char*)Bs;
#define G_DMA(buf_, kt_) do { const int ko_ = (kt_) * 64; \
        _Pragma("unroll") for (int i = 0; i < 4; ++i) { \
            __builtin_amdgcn_global_load_lds((const unsigned*)(Ad + (size_t)(32 * i) * lda + ko_), (LAS unsigned*)(Asb + (buf_) * 16384 + i * 4096 + tid * 16), 16, 0, 0); \
            __builtin_amdgcn_global_load_lds((const unsigned*)(Bd + (size_t)(32 * i) * ldb + ko_), (LAS unsigned*)(Bsb + (buf_) * 16384 + i * 4096 + tid * 16), 16, 0, 0); } } while (0)
#define G_FRAGS(cur_, ks_) const bf16_t* Ac##ks_ = As + (cur_) * 128 * 64 + (wr * 64 + fr) * 64 + ((((ks_) * 4 + fq) ^ (fr & 7)) * 8); const bf16_t* Bc##ks_ = Bs + (cur_) * 128 * 64 + (wc * 64 + fr) * 64 + ((((ks_) * 4 + fq) ^ (fr & 7)) * 8); \
        bf16x8 af##ks_[4], bfv##ks_[4]; \
        _Pragma("unroll") for (int m = 0; m < 4; ++m) af##ks_[m] = *(const bf16x8*)(Ac##ks_ + m * 16 * 64); \
        _Pragma("unroll") for (int n = 0; n < 4; ++n) bfv##ks_[n] = *(const bf16x8*)(Bc##ks_ + n * 16 * 64);
#define G_MMA(ks_) __builtin_amdgcn_s_setprio(1); _Pragma("unroll") for (int m = 0; m < 4; ++m) \
        _Pragma("unroll") for (int n = 0; n < 4; ++n) acc[m][n] = __builtin_amdgcn_mfma_f32_16x16x32_bf16(bfv##ks_[n], af##ks_[m], acc[m][n], 0, 0, 0); __builtin_amdgcn_s_setprio(0);
    const int nk = K >> 6;
    G_DMA(0, 0);
    asm volatile("s_waitcnt vmcnt(0)" ::: "memory");
    __syncthreads();
#pragma unroll 2
    for (int kt = 0; kt < nk; ++kt) {
        const int cur = kt & 1;
        if (kt + 1 < nk) G_DMA(cur ^ 1, kt + 1);
        {
            G_FRAGS(cur, 0)
            G_MMA(0)
            G_FRAGS(cur, 1)
            G_MMA(1)
        }
        asm volatile("s_waitcnt vmcnt(0)" ::: "memory");
        __syncthreads();
    }
#undef G_DMA
#undef G_FRAGS
#undef G_MMA
    float* Ct = (float*)smem;
#pragma unroll
    for (int m = 0; m < 4; ++m)
#pragma unroll
        for (int n = 0; n < 4; ++n) *(f32x4*)(Ct + (wr * 64 + m * 16 + fr) * CP + wc * 64 + n * 16 + fq * 4) = acc[m][n];
    __syncthreads();
    epi(tm, tn, Ct);
    __syncthreads();
}

DEV f32x4 rope4(const float* Crow, int c, int o, const float* cosT, const float* sinT, int tt, f32x4 v) {
    const int sub = o >> 3, ti = (sub >> 1) * 8 + (o & 7);
    const f32x4 cs = *(const f32x4*)(cosT + tt * 16 + ti), sn = *(const f32x4*)(sinT + tt * 16 + ti);
    const f32x4 pv = *(const f32x4*)(Crow + ((sub & 1) ? c - 8 : c + 8));
    return (sub & 1) ? v * cs + pv * sn : v * cs - pv * sn;
}

DEV void store_vt(const float* Ct, int c0, bf16_t* vt_head  , int tt0, const float* rowscale) {
    for (int item = tid_(); item < 64 * 16; item += NTHR) {
        const int d = item & 63, rg = item >> 6;
        float v[8];
#pragma unroll
        for (int i = 0; i < 8; ++i) { v[i] = Ct[(rg * 8 + i) * CP + c0 + d]; if (rowscale) v[i] *= rowscale[rg * 8 + i]; }
        u32x4 w; w.x = pk2(v[0], v[1]); w.y = pk2(v[2], v[3]); w.z = pk2(v[4], v[5]); w.w = pk2(v[6], v[7]);
        *(u32x4*)(vt_head + (size_t)d * TT + tt0 + rg * 8) = w;
    }
}

DEV f32x4 rope4v(f32x4 v, f32x4 pv, f32x4 cs, f32x4 sn, int sub) { return (sub & 1) ? v * cs + pv * sn : v * cs - pv * sn; }

struct EpiIn {
    bf16_t* QK; bf16_t* ZR; bf16_t* VtNA; bf16_t* VtD; const float* cosT; const float* sinT;
    DEV void operator()(int tm, int tn, const float* Ct) const {
        const int row0 = tm * 128, bl = row0 / TT, tt0 = row0 - bl * TT; const bool lat = tt0 < SEQ;
        if (tn == 4 || tn == 5 || tn == 10 || tn == 11) {
            bf16_t* Vt = (tn < 6) ? VtNA : VtD; const int hp = (tn & 1) * 2;
            store_vt(Ct, 0, Vt + ((size_t)(bl * 4 + hp) * 64) * TT, tt0, nullptr);
            store_vt(Ct, 64, Vt + ((size_t)(bl * 4 + hp + 1) * 64) * TT, tt0, nullptr);
            return;
        }
        bf16_t* dst; int ds, dc; unsigned ropem = 0;
        if (tn < 4) { dst = QK; ds = 1024; dc = tn * 128; }
        else if (tn < 10) { dst = QK; ds = 1024; dc = 512 + (tn - 6) * 128; ropem = 0xf; }
        else { dst = ZR; ds = ZRW; dc = (tn - 12) * 128; if (tn == 21) ropem = 1; }
        if (!lat) ropem = 0;
        const int tid = tid_(), c = (tid & 31) << 2, rb = tid >> 5;
        const bool rp = (ropem >> (c >> 5)) & 1;
        const int o = c & 31, sub = o >> 3, ti = (sub >> 1) * 8 + (o & 7), pc = (sub & 1) ? c - 8 : c + 8;
        bf16_t* dp = dst + (size_t)row0 * ds + dc + c;
#pragma unroll
        for (int it0 = 0; it0 < 16; it0 += 4) {
            f32x4 cs[4], sn[4];
            if (rp) {
#pragma unroll
                for (int u = 0; u < 4; ++u) { const int r = rb + 8 * (it0 + u); cs[u] = *(const f32x4*)(cosT + (tt0 + r) * 16 + ti); sn[u] = *(const f32x4*)(sinT + (tt0 + r) * 16 + ti); }
            }
#pragma unroll
            for (int u = 0; u < 4; ++u) {
                const int r = rb + 8 * (it0 + u);
                f32x4 v = *(const f32x4*)(Ct + r * CP + c);
                if (rp) v = rope4v(v, *(const f32x4*)(Ct + r * CP + pc), cs[u], sn[u], sub);
                u32x2 w; w.x = pk2(v[0], v[1]); w.y = pk2(v[2], v[3]);
                *(u32x2*)(dp + (size_t)r * ds) = w;
            }
        }
    }
};
struct EpiUQ {
    bf16_t* MQ; const float* rs; const float* cosT; const float* sinT;
    DEV void operator()(int tm, int tn, const float* Ct) const {
        const int row0 = tm * 128, bl = row0 / TT, tt0 = row0 - bl * TT; const bool lat = tt0 < SEQ;
        const int tid = tid_(), c = (tid & 31) << 2, rb = tid >> 5, col = tn * 128 + c, hc = col % 96;
        const bool rp = lat && hc >= 64;
        const int o = rp ? hc - 64 : 0, sub = o >> 3, ti = (sub >> 1) * 8 + (o & 7), pc = (sub & 1) ? c - 8 : c + 8;
#pragma unroll
        for (int it0 = 0; it0 < 16; it0 += 4) {
            f32x4 cs[4], sn[4]; float sc[4];
#pragma unroll
            for (int u = 0; u < 4; ++u) { const int r = rb + 8 * (it0 + u); sc[u] = rs[row0 + r]; if (rp) { cs[u] = *(const f32x4*)(cosT + (tt0 + r) * 16 + ti); sn[u] = *(const f32x4*)(sinT + (tt0 + r) * 16 + ti); } }
#pragma unroll
            for (int u = 0; u < 4; ++u) {
                const int r = rb + 8 * (it0 + u);
                f32x4 v = *(const f32x4*)(Ct + r * CP + c);
                if (rp) v = rope4v(v, *(const f32x4*)(Ct + r * CP + pc), cs[u], sn[u], sub);
                v = v * sc[u];
                u32x2 w; w.x = pk2(v[0], v[1]); w.y = pk2(v[2], v[3]);
                *(u32x2*)(MQ + (size_t)(row0 + r) * 384 + col) = w;
            }
        }
    }
};
struct EpiUKV {
    bf16_t* KN; bf16_t* VtM; const float* rs;
    DEV void operator()(int tm, int tn, const float* Ct) const {
        const int row0 = tm * 128, bl = row0 / TT, tt0 = row0 - bl * TT;
        const int tid = tid_(), c = (tid & 15) << 2, rb = tid >> 4;
        float* rsl = (float*)((char*)Ct + 128 * CP * 4);
        if (tid < 128) rsl[tid] = rs[row0 + tid];
        __syncthreads();
#pragma unroll
        for (int it = 0; it < 8; ++it) {
            const int r = rb + 16 * it;
            const f32x4 v = *(const f32x4*)(Ct + r * CP + c) * rsl[r];
            u32x2 w; w.x = pk2(v[0], v[1]); w.y = pk2(v[2], v[3]);
            *(u32x2*)(KN + (size_t)(row0 + r) * 256 + tn * 64 + c) = w;
        }
        store_vt(Ct, 64, VtM + ((size_t)(bl * 4 + tn) * 64) * TT, tt0, rsl);
    }
};
struct EpiWA {
    bf16_t* SC; const float* w0; const float* a0;
    DEV void operator()(int tm, int tn, const float* Ct) const {
        const int row0 = tm * 128, seg = tn >> 1;
        const int tid = tid_(), c = (tid & 31) << 2, rb = tid >> 5, ch = (tn & 1) * 128 + c, h = ch >> 6, j = ch & 63;
        const f32x4 bias = seg < 2 ? *(const f32x4*)(w0 + seg * 256 + ch) : *(const f32x4*)(a0 + (seg - 2) * 256 + ch);
        bf16_t* dp = SC + (size_t)row0 * 2048 + h * 512 + (4 + seg) * 64 + j;
#pragma unroll 4
        for (int it = 0; it < 16; ++it) {
            const int r = rb + 8 * it;
            const f32x4 v = *(const f32x4*)(Ct + r * CP + c) + bias;
            float o[4];
#pragma unroll
            for (int i = 0; i < 4; ++i) {
                if (seg < 2) o[i] = 0.60653065971f * sigmoidf_(v[i]);
                else o[i] = sigmoidf_(v[i]);
            }
            u32x2 w; w.x = pk2(o[0], o[1]); w.y = pk2(o[2], o[3]);
            *(u32x2*)(dp + (size_t)r * 2048) = w;
        }
    }
};
struct EpiG {
    bf16_t* MIX; const bf16_t* SC; const float* Y; const float* r_k; const float* ln_w; const float* ln_b; int gbase;
    DEV void operator()(int tm, int tn, const float* Ct) const {
        const int row0 = tm * 128;
        const int tid = tid_(), l32 = tid & 31, hh = (tid >> 5) & 1, rb = tid >> 6, h = tn * 2 + hh, j = l32 * 2, ch = h * 64 + j;
        const float rk0 = r_k[ch], rk1 = r_k[ch + 1], lw0 = ln_w[ch], lw1 = ln_w[ch + 1], lb0 = ln_b[ch], lb1 = ln_b[ch + 1];
#pragma unroll
        for (int it0 = 0; it0 < 32; it0 += 4) {
            unsigned yfu[4], ybu[4]; unsigned ur[4], uv[4], uk[4];
#pragma unroll
            for (int u = 0; u < 4; ++u) {
                const size_t row = (size_t)(row0 + rb + 4 * (it0 + u));
                yfu[u] = *(const unsigned*)((const bf16_t*)Y + row * 256 + ch); ybu[u] = *(const unsigned*)((const bf16_t*)Y + ((size_t)T_ALL + row) * 256 + ch);
                const bf16_t* sc = SC + row * 2048 + h * 512 + j;
                ur[u] = *(const unsigned*)(sc); uv[u] = *(const unsigned*)(sc + 64); uk[u] = *(const unsigned*)(sc + 128);
            }
#pragma unroll
            for (int u = 0; u < 4; ++u) {
                const int r = rb + 4 * (it0 + u);
                const float y0 = lo_bf(yfu[u]) + lo_bf(ybu[u]), y1 = hi_bf(yfu[u]) + hi_bf(ybu[u]);
                const float mean = sum32(y0 + y1) * (1.f / 64.f);
                const float d0 = y0 - mean, d1 = y1 - mean;
                const float var = sum32(d0 * d0 + d1 * d1) * (1.f / 64.f);
                const float rstd = rsqrtf(var + 64e-5f);
                const float rk = sum32(lo_bf(ur[u]) * lo_bf(uk[u]) * rk0 + hi_bf(ur[u]) * hi_bf(uk[u]) * rk1);
                const float g0 = Ct[r * CP + hh * 64 + j], g1 = Ct[r * CP + hh * 64 + j + 1];
                const float o0 = (d0 * rstd * lw0 + lb0 + rk * lo_bf(uv[u])) * g0;
                const float o1 = (d1 * rstd * lw1 + lb1 + rk * hi_bf(uv[u])) * g1;
                *(unsigned*)(MIX + (size_t)(row0 + r) * 1024 + 512 + ch) = pk2(o0, o1);
            }
        }
    }
};
struct EpiRes {
    const Params* p; const float* mod; int goff; int from_in;
    DEV void operator()(int tm, int tn, const float* Ct) const {
        const int row0 = tm * 128, b = row0 / TT, tt0 = row0 - b * TT;
        const int tid = tid_(), c = (tid & 31) << 2, rb = tid >> 5;
        const f32x4 g = *(const f32x4*)(mod + (size_t)(tt0 < SEQ ? b : 32) * 6144 + goff + tn * 128 + c);
        float* x0 = xrow(*p, row0) + tn * 128 + c;
        const float* xs = from_in ? xrow_in(*p, row0) + tn * 128 + c : x0;
#pragma unroll
        for (int it0 = 0; it0 < 16; it0 += 8) {
            f32x4 xv[8];
#pragma unroll
            for (int u = 0; u < 8; ++u) xv[u] = *(const f32x4*)(xs + (size_t)(rb + 8 * (it0 + u)) * D);
#pragma unroll
            for (int u = 0; u < 8; ++u) { const int r = rb + 8 * (it0 + u); *(f32x4*)(x0 + (size_t)r * D) = xv[u] + g * *(const f32x4*)(Ct + r * CP + c); }
        }
    }
};
struct EpiUp {
    bf16_t* G; float* E; const float* cw; const float* cb;
    DEV void operator()(int tm, int tn, const float* Ct) const {
        const int row0 = tm * 128, tt0 = row0 % TT;
        const bool first = (tt0 == 0 || tt0 == SEQ), last = (tt0 + 127 == SEQ - 1 || tt0 + 127 == TT - 1);
        const int tid = tid_(), c = (tid & 15) << 2, rb = tid >> 4, j = tn * 64 + c;
        const f32x4 w0 = *(const f32x4*)(cw + j), w1 = *(const f32x4*)(cw + DFF + j), w2 = *(const f32x4*)(cw + 2 * DFF + j), bb = *(const f32x4*)(cb + j);
        const f32x4 z = (f32x4){0.f, 0.f, 0.f, 0.f};
#pragma unroll 2
        for (int it = 0; it < 8; ++it) {
            const int r = rb + 16 * it;
            const f32x4 ac = *(const f32x4*)(Ct + r * CP + c);
            const f32x4 ap = r > 0 ? *(const f32x4*)(Ct + (r - 1) * CP + c) : z;
            const f32x4 an = r < 127 ? *(const f32x4*)(Ct + (r + 1) * CP + c) : z;
            const f32x4 bv = *(const f32x4*)(Ct + r * CP + 64 + c);
            const f32x4 pre = w0 * ap + w1 * ac + w2 * an + bb;
            if ((r == 0 && !first) || (r == 127 && !last)) {
                float* e = E + ((size_t)tm * 6 + (r == 0 ? 0 : 3)) * DFF + j;
                *(f32x4*)(e) = pre; *(f32x4*)(e + DFF) = bv; *(f32x4*)(e + 2 * DFF) = ac;
            } else {
                u32x2 w; w.x = pk2(siluf_(pre[0]) * bv[0], siluf_(pre[1]) * bv[1]); w.y = pk2(siluf_(pre[2]) * bv[2], siluf_(pre[3]) * bv[3]);
                *(u32x2*)(G + (size_t)(row0 + r) * DFF + j) = w;
            }
        }
    }
};

template <class Epi>
DEV void gemm_phase(const bf16_t* A, int lda, const bf16_t* Bt, int ldb, int K, int ntm, int ntn, bool skip_ctx, char* smem, const Epi& epi) {
    if ((gridDim.x & 7) == 0 && (ntm & 7) == 0) {
        const int xcd = blockIdx.x & 7, slot = blockIdx.x >> 3, nper = gridDim.x >> 3, R = ntm >> 3, per = R * ntn;
        const int nfb = ntn >> 3, fullq = nfb * R * 8, w = ntn - nfb * 8;
        for (int q = slot; q < per; q += nper) {
            int tm, tn;
            if (q < fullq) { const int tb = q / (R * 8), r = q - tb * (R * 8); tm = r >> 3; tn = tb * 8 + (r & 7); }
            else { const int q2 = q - fullq; tm = q2 / w; tn = nfb * 8 + (q2 - tm * w); }
            tm += xcd * R;
            if (skip_ctx && ((tm * 128) % TT) >= SEQ) continue;
            gemm_tile(A, lda, Bt, ldb, K, tm, tn, smem, epi);
        }
        return;
    }
    const int total = ntm * ntn;
    for (int t = blockIdx.x; t < total; t += gridDim.x) {
        const int tm = t / ntn, tn = t - tm * ntn;
        if (skip_ctx && ((tm * 128) % TT) >= SEQ) continue;
        gemm_tile(A, lda, Bt, ldb, K, tm, tn, smem, epi);
    }
}

struct AttnArgs {
    const bf16_t* Q; int qs;
    const bf16_t* K; int ks;
    const bf16_t* K2; int k2s;
    const bf16_t* Vt;
    bf16_t* O; int os;
    int nkt; int kstart;
    float sc2;
    int na_r, na_rs; const float* rpb;
    float lam, oscale; const float* subln;
};

DEV unsigned cvt_pk_bf16(float lo, float hi) { return pk2(lo, hi); }
DEV float red_rows_sum(float p) {
    float a = p, b = p;
    asm volatile("s_nop 1\n\tv_permlane16_swap_b32 %0, %1" : "+v"(a), "+v"(b));
    const float q = a + b; a = q; b = q;
    asm volatile("s_nop 1\n\tv_permlane32_swap_b32 %0, %1" : "+v"(a), "+v"(b));
    return a + b;
}
DEV float vmax2(float a, float b) { float r; asm("v_max_f32 %0, %1, %2" : "=v"(r) : "v"(a), "v"(b)); return r; }
DEV float vmax3(float a, float b, float c) { float r; asm("v_max3_f32 %0, %1, %2, %3" : "=v"(r) : "v"(a), "v"(b), "v"(c)); return r; }
DEV float wave_sum_fast(float v) { return red_rows_sum(sum16(v)); }
DEV float red_rows_max(float p) {
    float a = p, b = p;
    asm volatile("s_nop 1\n\tv_permlane16_swap_b32 %0, %1" : "+v"(a), "+v"(b));
    const float q = fmaxf(a, b); a = q; b = q;
    asm volatile("s_nop 1\n\tv_permlane32_swap_b32 %0, %1" : "+v"(a), "+v"(b));
    return fmaxf(a, b);
}
template <int DQK, int NSUB, int MQ, bool NA>
DEV void attn_item(const AttnArgs& a, char* smem) {
    constexpr int KP = DQK + 8, KS = DQK / 32 / NSUB, KCH = DQK / 8, QR = 16 * MQ;
    const int tid = tid_(), lane = tid & 63, wid = tid >> 6, fr = lane & 15, fq = lane >> 4;
    bf16_t* Ksm = (bf16_t*)smem;
    bf16_t* Vsm = Ksm + 2 * 64 * KP;
    float* rpbs = (float*)(Vsm + 2 * 64 * GP);
    if (NA) { for (int i = tid; i < 465; i += NTHR) rpbs[i] = a.rpb[i] * 1.44269504f; }
    const int na_nlo = NA ? (max(16 * wid - 8, 0) >> 4) : 0, na_nhi = NA ? (min(16 * wid + 22, 63) >> 4) : 3;
    bf16x8 qf[MQ][DQK / 32];
#pragma unroll
    for (int mq = 0; mq < MQ; ++mq)
#pragma unroll
        for (int k = 0; k < DQK / 32; ++k) qf[mq][k] = *(const bf16x8*)(a.Q + (size_t)(wid * QR + mq * 16 + fr) * a.qs + k * 32 + fq * 8);
    f32x4 o[NSUB][MQ][4];
    float mrow[NSUB][MQ], lrow[NSUB][MQ];
#pragma unroll
    for (int sb = 0; sb < NSUB; ++sb)
#pragma unroll
        for (int mq = 0; mq < MQ; ++mq) {
            mrow[sb][mq] = -1e30f; lrow[sb][mq] = 0.f;
#pragma unroll
            for (int n = 0; n < 4; ++n) o[sb][mq][n] = (f32x4){0.f, 0.f, 0.f, 0.f};
        }
    constexpr int NKC = (64 * KCH + NTHR - 1) / NTHR;
    u32x4 rk[NKC], rv[2];
#define ATT_TSTART(kt) (NA ? ((kt) < 8 ? (a.na_rs + (kt)) * 64 : SEQ + ((kt) - 8) * 64) : a.kstart + (kt) * 64)
#define ATT_GLOAD(kt) do { const int _t0 = ATT_TSTART(kt); \
        _Pragma("unroll") for (int _i = 0; _i < NKC; ++_i) { const int _q = tid + _i * NTHR; if (_q < 64 * KCH) { const int _r = _q / KCH, _c = _q - _r * KCH; \
            rk[_i] = (_c < 8 || DQK == 64) ? *(const u32x4*)(a.K + (size_t)(_t0 + _r) * a.ks + _c * 8) : *(const u32x4*)(a.K2 + (size_t)(_t0 + _r) * a.k2s + (_c - 8) * 8); } } \
        _Pragma("unroll") for (int _i = 0; _i < 2; ++_i) { const int _q = tid + _i * NTHR, _r = _q >> 3, _c = _q & 7; rv[_i] = *(const u32x4*)(a.Vt + (size_t)_r * TT + _t0 + _c * 8); } } while (0)
#define ATT_LSTORE(buf) do { \
        _Pragma("unroll") for (int _i = 0; _i < NKC; ++_i) { const int _q = tid + _i * NTHR; if (_q < 64 * KCH) { const int _r = _q / KCH, _c = _q - _r * KCH; *(u32x4*)(Ksm + ((buf) * 64 + _r) * KP + _c * 8) = rk[_i]; } } \
        _Pragma("unroll") for (int _i = 0; _i < 2; ++_i) { const int _q = tid + _i * NTHR, _r = _q >> 3, _c = _q & 7; *(u32x4*)(Vsm + ((buf) * 64 + _r) * GP + _c * 8) = rv[_i]; } } while (0)
    ATT_GLOAD(0); ATT_LSTORE(0);
    __syncthreads();
    for (int kt = 0; kt < a.nkt; ++kt) {
        const int cur = kt & 1; const bool more = kt + 1 < a.nkt;
        if (more) ATT_GLOAD(kt + 1);
        const bool natile = NA && kt < 8;
        bf16x8 pb[NSUB][MQ][2];
#pragma unroll
        for (int sb = 0; sb < NSUB; ++sb) {
            f32x4 s[MQ][4];
#pragma unroll
            for (int k = 0; k < KS; ++k) {
                bf16x8 kb[4];
#pragma unroll
                for (int n = 0; n < 4; ++n) kb[n] = *(const bf16x8*)(Ksm + (cur * 64 + n * 16 + fr) * KP + (sb * KS + k) * 32 + fq * 8);
#pragma unroll
                for (int mq = 0; mq < MQ; ++mq)
#pragma unroll
                    for (int n = 0; n < 4; ++n) {
                        if (!natile || (n >= na_nlo && n <= na_nhi)) s[mq][n] = __builtin_amdgcn_mfma_f32_16x16x32_bf16(kb[n], qf[mq][sb * KS + k], k == 0 ? (f32x4){0.f, 0.f, 0.f, 0.f} : s[mq][n], 0, 0, 0);
                        else if (k == 0) s[mq][n] = (f32x4){0.f, 0.f, 0.f, 0.f};
                    }
            }
#pragma unroll
            for (int mq = 0; mq < MQ; ++mq) {
                float mx = -1e30f;
                if (natile) {
                    const int qc = wid * 16 + fr, cst = min(max(qc - 8, 0), 48), ro = a.na_rs + kt - a.na_r + 7;
                    const float* rrow = rpbs + ro * 31 + 15 - qc + fq * 4;
#pragma unroll
                    for (int n = 0; n < 4; ++n) {
                        if (n >= na_nlo && n <= na_nhi) {
#pragma unroll
                            for (int j = 0; j < 4; ++j) {
                                const int kc = n * 16 + fq * 4 + j;
                                const float x = (kc >= cst && kc < cst + 16) ? s[mq][n][j] * a.sc2 + rrow[n * 16 + j] : -1e30f;
                                s[mq][n][j] = x; mx = fmaxf(mx, x);
                            }
                        } else s[mq][n] = (f32x4){-1e30f, -1e30f, -1e30f, -1e30f};
                    }
                } else {
#pragma unroll
                    for (int n = 0; n < 4; ++n) { s[mq][n] = s[mq][n] * a.sc2; mx = fmaxf(fmaxf(mx, fmaxf(s[mq][n][0], s[mq][n][1])), fmaxf(s[mq][n][2], s[mq][n][3])); }
                }
                mx = red_rows_max(mx);
                const float mo = mrow[sb][mq], mn = fmaxf(mo, mx);
                const bool grow = __builtin_amdgcn_ballot_w64(mn > mo) != 0;
                mrow[sb][mq] = mn;
                float rsum = 0.f;
#pragma unroll
                for (int n = 0; n < 4; ++n) {
                    if (!natile || (n >= na_nlo && n <= na_nhi)) {
#pragma unroll
                        for (int j = 0; j < 4; ++j) { const float pv = __builtin_amdgcn_exp2f(s[mq][n][j] - mn); s[mq][n][j] = pv; rsum += pv; }
                    } else s[mq][n] = (f32x4){0.f, 0.f, 0.f, 0.f};
                }
                if (grow) {
                    const float alpha = __builtin_amdgcn_exp2f(mo - mn);
                    lrow[sb][mq] *= alpha;
#pragma unroll
                    for (int n = 0; n < 4; ++n) o[sb][mq][n] *= alpha;
                }
                lrow[sb][mq] += rsum;
#pragma unroll
                for (int k2 = 0; k2 < 2; ++k2) {
                    u32x4 w;
                    w.x = cvt_pk_bf16(s[mq][2 * k2][0], s[mq][2 * k2][1]); w.y = cvt_pk_bf16(s[mq][2 * k2][2], s[mq][2 * k2][3]);
                    w.z = cvt_pk_bf16(s[mq][2 * k2 + 1][0], s[mq][2 * k2 + 1][1]); w.w = cvt_pk_bf16(s[mq][2 * k2 + 1][2], s[mq][2 * k2 + 1][3]);
                    pb[sb][mq][k2] = __builtin_bit_cast(bf16x8, w);
                }
            }
        }
#pragma unroll
        for (int k2 = 0; k2 < 2; ++k2) {
            if (natile && (2 * k2 + 1 < na_nlo || 2 * k2 > na_nhi)) continue;
            bf16x8 va[4];
#pragma unroll
            for (int n = 0; n < 4; ++n) {
                const bf16_t* vp = Vsm + (cur * 64 + n * 16 + fr) * GP + 32 * k2 + fq * 4;
                u32x4 w; const u32x2 lo = *(const u32x2*)(vp), hi = *(const u32x2*)(vp + 16);
                w.x = lo.x; w.y = lo.y; w.z = hi.x; w.w = hi.y;
                va[n] = __builtin_bit_cast(bf16x8, w);
            }
#pragma unroll
            for (int sb = 0; sb < NSUB; ++sb)
#pragma unroll
                for (int mq = 0; mq < MQ; ++mq)
#pragma unroll
                    for (int n = 0; n < 4; ++n) o[sb][mq][n] = __builtin_amdgcn_mfma_f32_16x16x32_bf16(va[n], pb[sb][mq][k2], o[sb][mq][n], 0, 0, 0);
        }
        if (more) ATT_LSTORE(cur ^ 1);
        __syncthreads();
    }
#undef ATT_GLOAD
#undef ATT_LSTORE
#undef ATT_TSTART
#pragma unroll
    for (int mq = 0; mq < MQ; ++mq) {
        f32x4 v[4];
        if (NSUB == 1) {
            const float il = 1.f / red_rows_sum(lrow[0][mq]);
#pragma unroll
            for (int n = 0; n < 4; ++n) v[n] = o[0][mq][n] * il;
        } else {
            const float il0 = 1.f / red_rows_sum(lrow[0][mq]), il1 = a.lam / red_rows_sum(lrow[NSUB - 1][mq]);
            float ss = 0.f;
#pragma unroll
            for (int n = 0; n < 4; ++n) { v[n] = o[0][mq][n] * il0 - o[NSUB - 1][mq][n] * il1; ss += v[n][0] * v[n][0] + v[n][1] * v[n][1] + v[n][2] * v[n][2] + v[n][3] * v[n][3]; }
            ss = red_rows_sum(ss);
            const float rstd = rsqrtf(ss * (1.f / 64.f) + 1e-5f) * a.oscale;
#pragma unroll
            for (int n = 0; n < 4; ++n) v[n] = v[n] * rstd * *(const f32x4*)(a.subln + n * 16 + fq * 4);
        }
        bf16_t* op = a.O + (size_t)(wid * QR + mq * 16 + fr) * a.os + fq * 4;
#pragma unroll
        for (int n = 0; n < 4; ++n) { u32x2 w; w.x = cvt_pk_bf16(v[n][0], v[n][1]); w.y = cvt_pk_bf16(v[n][2], v[n][3]); *(u32x2*)(op + n * 16) = w; }
    }
    __syncthreads();
}

template <int N> DEV float rbc(float x) { return __builtin_bit_cast(float, __builtin_amdgcn_update_dpp(0, __builtin_bit_cast(int, x), 0x150 + N, 0xf, 0xf, true)); }
DEV float red_rows(float p) { return red_rows_sum(p); }
#define REP16(M) M(0) M(1) M(2) M(3) M(4) M(5) M(6) M(7) M(8) M(9) M(10) M(11) M(12) M(13) M(14) M(15)
DEV void scan_item(const bf16_t* SC, float* Y, int bl, int h, int dir, const float* k_a, char* smem) {
    const int tid = tid_(), lane = tid & 63, w = tid >> 6, ch = lane, sq = w;
    float* stg = (float*)smem;
    float* yb = stg + 2 * 16 * 6 * 64;
    const float ka = k_a[h * 64 + ch];
    unsigned short pre[4][6];
    float S[16];
#pragma unroll
    for (int j = 0; j < 16; ++j) S[j] = 0.f;
#define SC_TT(s) (dir == 0 ? ((s) < CTXL ? SEQ + (s) : (s) - CTXL) : ((s) < CTXL ? TT - 1 - (s) : SEQ - 1 - ((s) - CTXL)))
#define SC_GL(chunk) do { _Pragma("unroll") for (int _i = 0; _i < 4; ++_i) { const int _s = (chunk) * 16 + sq + 4 * _i; const int _tt = SC_TT(_s); \
        const bf16_t* _b = SC + ((size_t)(bl * TT + _tt)) * 2048 + h * 512 + ch; \
        pre[_i][0] = _b[0]; pre[_i][1] = _b[64]; pre[_i][2] = _b[128]; pre[_i][3] = _b[192]; pre[_i][4] = _b[(4 + dir) * 64]; pre[_i][5] = _b[(6 + dir) * 64]; } } while (0)
#define SC_ST(buf) do { _Pragma("unroll") for (int _i = 0; _i < 4; ++_i) { const int _st = sq + 4 * _i; \
        const float _r = bf2f(pre[_i][0]), _v = bf2f(pre[_i][1]), _k = bf2f(pre[_i][2]), _kk = bf2f(pre[_i][3]), _e = bf2f(pre[_i][4]), _sg = bf2f(pre[_i][5]); \
        float* _d = stg + (((buf) * 16 + _st) * 6) * 64 + ch; \
        _d[0] = -_kk; _d[64] = __expf(-_e); _d[128] = _kk * _sg; _d[192] = _k * (1.f + (_sg - 1.f) * ka); _d[256] = _r; _d[320] = _v; } } while (0)
    SC_GL(0); SC_ST(0);
    __syncthreads();
    constexpr int NCH = TT / 16;
    const int vrow = w * 16 + (lane & 15);
#define FMAC_BC(acc, x, sv, n) asm("v_fmac_f32_dpp %0, %1, %2 row_newbcast:" #n " row_mask:0xf bank_mask:0xf" : "+v"(acc) : "v"(x), "v"(sv))
#define MUL_BC(dst, x, sv, n) asm("v_mul_f32_dpp %0, %1, %2 row_newbcast:" #n " row_mask:0xf bank_mask:0xf" : "=v"(dst) : "v"(x), "v"(sv))
#define SC_LOAD(st_, A, W, B, K, R, V) do { const float* _dn = d0 + (st_) * 384; A = _dn[lane]; W = _dn[64 + lane]; B = _dn[128 + lane]; K = _dn[192 + lane]; R = _dn[256 + lane]; V = _dn[320 + vrow]; } while (0)
#define SA_(n) if ((n) & 1) FMAC_BC(p1, cA, S[n], n); else FMAC_BC(p0, cA, S[n], n);
#define UP_(n) { float t; MUL_BC(t, cW, S[n], n); FMAC_BC(t, cB, sa, n); FMAC_BC(t, cK, cV, n); S[n] = t; if ((n) & 1) FMAC_BC(y1, cR, t, n); else FMAC_BC(y0, cR, t, n); }
#define SC_STEP(st_, cA, cW, cB, cK, cR, cV) do { float p0 = 0.f, p1 = 0.f; REP16(SA_) const float sa = red_rows(p0 + p1); float y0 = 0.f, y1 = 0.f; REP16(UP_) \
        yb[((st_) * 4 + (lane >> 4)) * 64 + vrow] = y0 + y1; } while (0)
    for (int chunk = 0; chunk < NCH; ++chunk) {
        const int buf = chunk & 1;
        if (chunk + 1 < NCH) SC_GL(chunk + 1);
        const float* d0 = stg + (buf * 16 * 6) * 64;
        float a0, w0, b0, k0, r0, v0, a1, w1, b1, k1, r1, v1;
        SC_LOAD(0, a0, w0, b0, k0, r0, v0);
#pragma unroll
        for (int st = 0; st < 16; st += 2) {
            SC_LOAD(st + 1, a1, w1, b1, k1, r1, v1);
#define cA a0
#define cW w0
#define cB b0
#define cK k0
#define cR r0
#define cV v0
            SC_STEP(st, a0, w0, b0, k0, r0, v0);
#undef cA
#undef cW
#undef cB
#undef cK
#undef cR
#undef cV
            if (st + 2 < 16) SC_LOAD(st + 2, a0, w0, b0, k0, r0, v0);
#define cA a1
#define cW w1
#define cB b1
#define cK k1
#define cR r1
#define cV v1
            SC_STEP(st + 1, a1, w1, b1, k1, r1, v1);
#undef cA
#undef cW
#undef cB
#undef cK
#undef cR
#undef cV
        }
        __syncthreads();
#pragma unroll
        for (int i = 0; i < 4; ++i) {
            const int st = sq + 4 * i, s_ = chunk * 16 + st, tt = SC_TT(s_);
            ((bf16_t*)Y)[((size_t)dir * T_ALL + (size_t)bl * TT + tt) * 256 + h * 64 + ch] = f2bf((yb[(st * 4) * 64 + ch] + yb[(st * 4 + 1) * 64 + ch]) + (yb[(st * 4 + 2) * 64 + ch] + yb[(st * 4 + 3) * 64 + ch]));
        }
        if (chunk + 1 < NCH) SC_ST(buf ^ 1);
        __syncthreads();
    }
#undef SC_TT
#undef SC_GL
#undef SC_ST
#undef FMAC_BC
#undef MUL_BC
#undef SC_LOAD
#undef SA_
#undef UP_
#undef SC_STEP
}

DEV void phase_norm(const Params& p, int l, int which, bool skip_ctx) {
    const float* gam = p.in[which ? 5 : 4] + l * D;
    const float* mod = (const float*)(p.ws + OFF_MOD) + (size_t)l * 33 * 6144;
    bf16_t* H = (bf16_t*)(p.ws + OFF_H);
    const int lane = tid_() & 63, wave = blockIdx.x * 4 + (tid_() >> 6), nw = gridDim.x * 4;
    for (int g0 = wave; g0 < T_ALL; g0 += 2 * nw) {
        f32x4 v[2][4]; const float* m[2]; bool act[2];
#pragma unroll
        for (int u = 0; u < 2; ++u) {
            const int g = g0 + u * nw; act[u] = g < T_ALL;
            const int gg = act[u] ? g : g0;
            const int b = gg / TT, tt = gg - b * TT; const bool lat = tt < SEQ;
            if (!lat && skip_ctx) act[u] = false;
            const float* x = (l == 0 && which == 0) ? xrow_in(p, gg) : xrow(p, gg);
            m[u] = mod + (size_t)(lat ? b : 32) * 6144 + (which ? 3072 : 0);
#pragma unroll
            for (int i = 0; i < 4; ++i) v[u][i] = *(const f32x4*)(x + i * 256 + lane * 4);
        }
#pragma unroll
        for (int u = 0; u < 2; ++u) {
            float ss = 0.f;
#pragma unroll
            for (int i = 0; i < 4; ++i) ss += v[u][i][0] * v[u][i][0] + v[u][i][1] * v[u][i][1] + v[u][i][2] * v[u][i][2] + v[u][i][3] * v[u][i][3];
            ss = wave_sum_fast(ss);
            const float rstd = rsqrtf(ss * (1.f / 1024.f) + 1e-6f);
            if (act[u]) {
                const int g = g0 + u * nw;
#pragma unroll
                for (int i = 0; i < 4; ++i) {
                    const int col = i * 256 + lane * 4;
                    const f32x4 g4 = *(const f32x4*)(gam + col), sh = *(const f32x4*)(m[u] + col), sc = *(const f32x4*)(m[u] + 1024 + col);
                    const f32x4 o = v[u][i] * rstd * g4 * (sc + 1.f) + sh;
                    u32x2 w; w.x = pk2(o[0], o[1]); w.y = pk2(o[2], o[3]);
                    *(u32x2*)(H + (size_t)g * 1024 + col) = w;
                }
            }
        }
    }
}

DEV void phase_final(const Params& p) {
    const float* gam = p.in[32];
    const int lane = tid_() & 63, wave = blockIdx.x * 4 + (tid_() >> 6), nw = gridDim.x * 4;
    for (int g = wave; g < NBATCH * SEQ; g += nw) {
        float* x = p.out + (size_t)g * D;
        f32x4 v[4]; float ss = 0.f;
#pragma unroll
        for (int i = 0; i < 4; ++i) { v[i] = *(const f32x4*)(x + i * 256 + lane * 4); ss += v[i][0] * v[i][0] + v[i][1] * v[i][1] + v[i][2] * v[i][2] + v[i][3] * v[i][3]; }
        ss = wave_sum(ss);
        const float rstd = rsqrtf(ss * (1.f / 1024.f) + 1e-6f);
#pragma unroll
        for (int i = 0; i < 4; ++i) { const int col = i * 256 + lane * 4; *(f32x4*)(x + col) = v[i] * rstd * *(const f32x4*)(gam + col); }
    }
}

DEV void phase_prep(const Params& p, int l, int c) {
    char* scr = p.ws + OFF_SCR;
    const bf16_t* ZR = (const bf16_t*)(scr + SO_ZR);
    bf16_t* SC = (bf16_t*)(scr + SO_SC) + (size_t)c * TC * 2048; bf16_t* AWA = (bf16_t*)(scr + SO_AWA); bf16_t* AG = (bf16_t*)(scr + SO_AG) + (size_t)c * TC * 64;
    float* rsq = (float*)(p.ws + OFF_RSQ); float* rskv = (float*)(p.ws + OFF_RSKV);
    const float* mu0 = p.in[15] + (size_t)l * 2 * 896; const float* mu1 = mu0 + 896;
    const int lane = tid_() & 63, wave = blockIdx.x * 4 + (tid_() >> 6), nw = gridDim.x * 4;
    f32x4 m0[3], m1[3];
#pragma unroll
    for (int s3 = 0; s3 < 3; ++s3) { m0[s3] = *(const f32x4*)(mu0 + s3 * 256 + lane * 4); m1[s3] = *(const f32x4*)(mu1 + s3 * 256 + lane * 4); }
    const f32x4 kk4 = *(const f32x4*)(p.in[21] + l * 256 + lane * 4);
    const float mw0 = mu0[768 + lane], mw1 = mu1[768 + lane], mg0 = mu0[832 + lane], mg1 = mu1[832 + lane];
    for (int t0 = wave; t0 < TC; t0 += 2 * nw) {
        u32x2 q[2], c0[2][3], cp[2][3], cn[2][3]; unsigned kv[2]; bf16_t wz[2][3], gz[2][3]; bool act[2], hp[2], hn[2];
#pragma unroll
        for (int u = 0; u < 2; ++u) {
            const int t = t0 + u * nw; act[u] = t < TC;
            const int ts = act[u] ? t : t0, tt = ts % TT;
            hp[u] = !(tt == 0 || tt == SEQ); hn[u] = !(tt == SEQ - 1 || tt == TT - 1);
            const bf16_t* z = ZR + (size_t)ts * ZRW;
            const bf16_t* zp = hp[u] ? z - ZRW : z; const bf16_t* zn = hn[u] ? z + ZRW : z;
            q[u] = *(const u32x2*)(z + 768 + lane * 4); kv[u] = *(const unsigned*)(z + 1024 + lane * 2);
#pragma unroll
            for (int s3 = 0; s3 < 3; ++s3) { const int col = s3 * 256 + lane * 4; c0[u][s3] = *(const u32x2*)(z + col); cp[u][s3] = *(const u32x2*)(zp + col); cn[u][s3] = *(const u32x2*)(zn + col); }
            wz[u][0] = z[1184 + lane]; wz[u][1] = zp[1184 + lane]; wz[u][2] = zn[1184 + lane];
            gz[u][0] = z[1280 + lane]; gz[u][1] = zp[1280 + lane]; gz[u][2] = zn[1280 + lane];
        }
#pragma unroll
        for (int u = 0; u < 2; ++u) {
            const int t = t0 + u * nw;
            const float fp = hp[u] ? 1.f : 0.f, fn = hn[u] ? 1.f : 0.f;
            float s = lo_bf(q[u].x) * lo_bf(q[u].x) + hi_bf(q[u].x) * hi_bf(q[u].x) + lo_bf(q[u].y) * lo_bf(q[u].y) + hi_bf(q[u].y) * hi_bf(q[u].y);
            s = wave_sum_fast(s);
            float s2 = lo_bf(kv[u]) * lo_bf(kv[u]) + hi_bf(kv[u]) * hi_bf(kv[u]);
            s2 = wave_sum_fast(s2);
            float zs[3][4];
#pragma unroll
            for (int s3 = 0; s3 < 3; ++s3) {
                const float zc[4] = {lo_bf(c0[u][s3].x), hi_bf(c0[u][s3].x), lo_bf(c0[u][s3].y), hi_bf(c0[u][s3].y)};
                const float zp[4] = {lo_bf(cp[u][s3].x) * fp, hi_bf(cp[u][s3].x) * fp, lo_bf(cp[u][s3].y) * fp, hi_bf(cp[u][s3].y) * fp};
                const float zn[4] = {lo_bf(cn[u][s3].x) * fn, hi_bf(cn[u][s3].x) * fn, lo_bf(cn[u][s3].y) * fn, hi_bf(cn[u][s3].y) * fn};
#pragma unroll
                for (int i = 0; i < 4; ++i) zs[s3][i] = zc[i] + m0[s3][i] * (zp[i] - zc[i]) + m1[s3][i] * (zn[i] - zc[i]);
            }
            float kk[4]; float ss = 0.f;
#pragma unroll
            for (int i = 0; i < 4; ++i) { kk[i] = zs[1][i] * kk4[i]; ss += kk[i] * kk[i]; }
            ss = sum16(ss);
            const float inv = rsqrtf(fmaxf(ss, 1e-24f));
            float vw, vg;
            { const float zc = bf2f(wz[u][0]), zp = bf2f(wz[u][1]) * fp, zn = bf2f(wz[u][2]) * fn; vw = zc + mw0 * (zp - zc) + mw1 * (zn - zc); }
            { const float zc = bf2f(gz[u][0]), zp = bf2f(gz[u][1]) * fp, zn = bf2f(gz[u][2]) * fn; vg = zc + mg0 * (zp - zc) + mg1 * (zn - zc); }
            if (act[u]) {
                if (lane == 0) { rsq[t] = rsqrtf(s * (1.f / 256.f) + 1e-6f); rskv[t] = rsqrtf(s2 * (1.f / 128.f) + 1e-6f); }
                const int h = lane >> 4, j = (lane & 15) * 4;
                bf16_t* sc = SC + (size_t)t * 2048 + h * 512 + j;
                u32x2 w;
                w.x = pk2(zs[0][0], zs[0][1]); w.y = pk2(zs[0][2], zs[0][3]); *(u32x2*)(sc) = w;
                w.x = pk2(zs[2][0], zs[2][1]); w.y = pk2(zs[2][2], zs[2][3]); *(u32x2*)(sc + 64) = w;
                w.x = pk2(zs[1][0], zs[1][1]); w.y = pk2(zs[1][2], zs[1][3]); *(u32x2*)(sc + 128) = w;
                w.x = pk2(kk[0] * inv, kk[1] * inv); w.y = pk2(kk[2] * inv, kk[3] * inv); *(u32x2*)(sc + 192) = w;
                AWA[(size_t)t * 64 + lane] = f2bf(lane < 32 ? 2.f * sigmoidf_(2.f * vw) - 1.f : vw);
                AG[(size_t)t * 64 + lane] = f2bf(sigmoidf_(vg));
            }
        }
    }
}

DEV void phase_gemm_small(const Params& p, int l, int c, char* smem) {
    char* scr = p.ws + OFF_SCR;
    const bf16_t* ZR = (const bf16_t*)(scr + SO_ZR);
    const float* cosT = (const float*)(p.ws + OFF_COS); const float* sinT = (const float*)(p.ws + OFF_SIN);
    EpiUQ euq{(bf16_t*)(scr + SO_MQ), (const float*)(p.ws + OFF_RSQ), cosT, sinT};
    EpiUKV eukv{(bf16_t*)(scr + SO_KN), (bf16_t*)(scr + SO_VTM), (const float*)(p.ws + OFF_RSKV)};
    EpiWA ewa{(bf16_t*)(scr + SO_SC) + (size_t)c * TC * 2048, p.in[16] + (size_t)l * 512, p.in[18] + (size_t)l * 512};
    constexpr int NTM = TC / 128;
    constexpr int T1 = NTM * 3, T2 = T1 + NTM * 4, T3 = T2 + NTM * 8;
    for (int t = blockIdx.x; t < T3; t += gridDim.x) {
        if (t < T1) { const int tm = t / 3, tn = t - tm * 3; gemm_tile(ZR + 768, ZRW, wl(p, l, WE_UQ), 256, 256, tm, tn, smem, euq); }
        else if (t < T2) { const int u = t - T1, tm = u >> 2, tn = u & 3; gemm_tile(ZR + 1024, ZRW, wl(p, l, WE_UKV), 128, 128, tm, tn, smem, eukv); }
        else { const int u = t - T2, tm = u >> 3, tn = u & 7; gemm_tile((const bf16_t*)(scr + SO_AWA), 64, wl(p, l, WE_WA), 64, 64, tm, tn, smem, ewa); }
    }
}

DEV void phase_mix(const Params& p, int l, int c, int phase_idx, char* smem, int rmask, int* s_item) {
    char* scr = p.ws + OFF_SCR;
    const bf16_t* QK = (const bf16_t*)(scr + SO_QK); const bf16_t* ZR = (const bf16_t*)(scr + SO_ZR);
    const bf16_t* MQ = (const bf16_t*)(scr + SO_MQ); const bf16_t* KN = (const bf16_t*)(scr + SO_KN);
    const bf16_t* VtNA = (const bf16_t*)(scr + SO_VTNA); const bf16_t* VtD = (const bf16_t*)(scr + SO_VTD); const bf16_t* VtM = (const bf16_t*)(scr + SO_VTM);
    bf16_t* MIX = (bf16_t*)(p.ws + OFF_H) + (size_t)c * TC * 1024;
    int* ctr = (int*)(p.ws + OFF_CTR) + phase_idx;
    const bool need_ctx = l < DEPTH - 1;
    const float lam = ((const float*)(p.ws + OFF_LAM))[l];
    const float lam_init = 0.8f - 0.6f * expf(-0.3f * (float)l);
    constexpr int DQ = 64 * DMQ, DLT = SEQ / DQ, DCT = CTXL / DQ;
    const int N_SCAN = (c == NCHUNK - 1) ? NBATCH * 8 : 0; constexpr int N_ML = CB * 64, N_DL = CB * 4 * DLT, N_NL = CB * 128, N_MC = CB * 8, N_DC = CB * 4 * DCT, N_NC = CB * 16;
    const int E0 = N_SCAN, E1 = E0 + N_ML, E2 = E1 + N_DL, E3 = E2 + N_NL, E4 = E3 + N_MC, E5 = E4 + N_DC, E6 = E5 + N_NC;
    const int total = need_ctx ? E6 : E3;
    constexpr float L2E = 1.44269504f;
    if (rmask & 1) for (int it = blockIdx.x; it < N_SCAN; it += gridDim.x) {
        const int bl = it >> 3, h = (it >> 1) & 3, dir = it & 1;
        __builtin_amdgcn_s_setprio(3);
        scan_item((const bf16_t*)(scr + SO_SC), (float*)(scr + SO_Y), bl, h, dir, p.in[22] + l * 256, smem);
        __builtin_amdgcn_s_setprio(0);
    }
    for (;;) {
        if (tid_() == 0) *s_item = E0 + atomicAdd(ctr, 1);
        __syncthreads();
        const int it = __builtin_amdgcn_readfirstlane(*s_item);
        __syncthreads();
        if (it >= total) break;
        if (!(rmask & 2)) continue;
        AttnArgs a{};
        if (it < E0) {
        } else if (it < E1 || (it >= E3 && it < E4)) {
            const bool cx = it >= E3; int bl, h, q0;
            if (!cx) { const int u = it - E0; bl = u >> 6; h = (u >> 4) & 3; q0 = (u & 15) * 128; }
            else { const int u = it - E3; bl = u >> 3; h = (u >> 1) & 3; q0 = SEQ + (u & 1) * 128; }
            const size_t tb = (size_t)bl * TT;
            a.Q = MQ + (tb + q0) * 384 + h * 96; a.qs = 384;
            a.K = KN + tb * 256 + h * 64; a.ks = 256; a.K2 = ZR + tb * ZRW + 1152; a.k2s = ZRW;
            a.Vt = VtM + ((size_t)(bl * 4 + h) * 64) * TT;
            a.O = MIX + (tb + q0) * 1024 + 256 + h * 64; a.os = 1024;
            a.kstart = cx ? SEQ : 0; a.nkt = cx ? 4 : 36; a.sc2 = 0.10206207261596575f * L2E;
            if (MIXMASK & 2) attn_item<96, 1, 2, false>(a, smem);
        } else if (it < E2 || (it >= E4 && it < E5)) {
            const bool cx = it >= E4; int bl, h, q0;
            if (!cx) { const int u = it - E1; bl = u / (4 * DLT); h = (u / DLT) & 3; q0 = (u % DLT) * DQ; }
            else { const int u = it - E4; bl = u / (4 * DCT); h = (u / DCT) & 3; q0 = SEQ + (u % DCT) * DQ; }
            const size_t tb = (size_t)bl * TT;
            a.Q = QK + (tb + q0) * 1024 + 512 + h * 64; a.qs = 1024;
            a.K = QK + tb * 1024 + 768 + h * 64; a.ks = 1024;
            a.Vt = VtD + ((size_t)(bl * 4 + h) * 64) * TT;
            a.O = MIX + (tb + q0) * 1024 + 768 + h * 64; a.os = 1024;
            a.kstart = cx ? SEQ : 0; a.nkt = cx ? 4 : 36; a.sc2 = 0.17677669529663687f * L2E;
            a.lam = lam; a.oscale = 1.f - lam_init; a.subln = p.in[27] + l * 64;
            if (MIXMASK & 4) attn_item<64, 2, DMQ, false>(a, smem);
        } else {
            const bool cx = it >= E5; int bl, h, q0;
            if (!cx) { const int u = it - E2; bl = u >> 7; h = (u >> 5) & 3; const int r = u & 31; q0 = r * 64; a.na_r = r; a.na_rs = min(max(r - 4, 0), 24); }
            else { const int u = it - E5; bl = u >> 4; h = (u >> 2) & 3; q0 = SEQ + (u & 3) * 64; }
            const size_t tb = (size_t)bl * TT;
            a.Q = QK + (tb + q0) * 1024 + h * 64; a.qs = 1024;
            a.K = QK + tb * 1024 + 256 + h * 64; a.ks = 1024;
            a.Vt = VtNA + ((size_t)(bl * 4 + h) * 64) * TT;
            a.O = MIX + (tb + q0) * 1024 + h * 64; a.os = 1024;
            a.sc2 = 0.125f * L2E; a.rpb = p.in[10] + ((size_t)l * 4 + h) * 465;
            if (!cx) { a.nkt = 12; if (MIXMASK & 8) attn_item<64, 1, 1, true>(a, smem); }
            else { a.kstart = SEQ; a.nkt = 4; if (MIXMASK & 16) attn_item<64, 1, 1, false>(a, smem); }
        }
    }
}

DEV void phase_fix(const Params& p, int l) {
    char* scr = p.ws + OFF_SCR;
    bf16_t* G = (bf16_t*)(scr + SO_G); const float* E = (const float*)(scr + SO_E);
    const float* cw = p.in[29] + (size_t)l * 3 * DFF;
    const bool skip_ctx = !(l < DEPTH - 1);
    constexpr int NTM = T_ALL / 128;
    const int total = NTM * (DFF / 4);
    for (int idx = blockIdx.x * NTHR + tid_(); idx < total; idx += gridDim.x * NTHR) {
        const int tm = idx / (DFF / 4), j = (idx - tm * (DFF / 4)) * 4;
        const int row0 = tm * 128, tt0 = row0 % TT;
        if (skip_ctx && tt0 >= SEQ) continue;
        const bool first = (tt0 == 0 || tt0 == SEQ), last = (tt0 + 127 == SEQ - 1 || tt0 + 127 == TT - 1);
        if (!first) {
            const float* e = E + ((size_t)tm * 6) * DFF + j; const float* ep = E + ((size_t)(tm - 1) * 6 + 5) * DFF + j;
            const f32x4 pre = *(const f32x4*)(e) + *(const f32x4*)(cw + j) * *(const f32x4*)(ep), bv = *(const f32x4*)(e + DFF);
            u32x2 w; w.x = pk2(siluf_(pre[0]) * bv[0], siluf_(pre[1]) * bv[1]); w.y = pk2(siluf_(pre[2]) * bv[2], siluf_(pre[3]) * bv[3]);
            *(u32x2*)(G + (size_t)row0 * DFF + j) = w;
        }
        if (!last) {
            const float* e = E + ((size_t)tm * 6 + 3) * DFF + j; const float* en = E + ((size_t)(tm + 1) * 6 + 2) * DFF + j;
            const f32x4 pre = *(const f32x4*)(e) + *(const f32x4*)(cw + 2 * DFF + j) * *(const f32x4*)(en), bv = *(const f32x4*)(e + DFF);
            u32x2 w; w.x = pk2(siluf_(pre[0]) * bv[0], siluf_(pre[1]) * bv[1]); w.y = pk2(siluf_(pre[2]) * bv[2], siluf_(pre[3]) * bv[3]);
            *(u32x2*)(G + (size_t)(row0 + 127) * DFF + j) = w;
        }
    }
}

DEV int cm_in(int n) {
    if (n < 768) return n;
    if (n < 1536) return 2080 + (n - 768);
    if (n < 2304) return 1184 + (n - 1536);
    if (n < 2560) return 768 + (n - 2304);
    if (n < 2688) return 1024 + (n - 2560);
    if (n < 2816) { const int o = n - 2688; return o < 32 ? 1152 + o : (o < 64 ? 1952 + (o - 32) : (o < 96 ? 1984 + (o - 64) : -1)); }
    { const int o = n - 2816; return o < 64 ? 2016 + o : -1; }
}
DEV int cm_up(int n) { const int t = n >> 7, o = n & 127; return o < 64 ? t * 64 + o : DFF + t * 64 + (o - 64); }

template <int MODE>
DEV void conv_unit(const float* src, int lds_, bf16_t* dst, int K, int nt, int kt, float* tile) {
    const int tid = tid_(), a = tid & 63, b = tid >> 6;
    const int n = nt * 64 + a;
    const int col = MODE == 0 ? cm_in(n) : (MODE == 2 ? cm_up(n) : n);
#pragma unroll 4
    for (int i = 0; i < 16; ++i) { const int kl = b + 4 * i; tile[kl * 65 + a] = col >= 0 ? src[(size_t)(kt * 64 + kl) * lds_ + col] : 0.f; }
    __syncthreads();
#pragma unroll 4
    for (int i = 0; i < 16; ++i) { const int nl = b + 4 * i; dst[(size_t)(nt * 64 + nl) * K + kt * 64 + a] = f2bf(tile[a * 65 + nl]); }
    __syncthreads();
}

DEV void phase_prologue(const Params& p, char* smem) {
    const int tid = tid_(), gtid = blockIdx.x * NTHR + tid, gsz = gridDim.x * NTHR;
    if (blockIdx.x == 0) {
        int* ctr = (int*)(p.ws + OFF_CTR); ctr[tid] = 0;
        if (tid < DEPTH) {
            const float* lp = p.in[26] + tid * 128; float s0 = 0.f, s1 = 0.f;
            for (int i = 0; i < 32; ++i) { s0 += lp[i] * lp[32 + i]; s1 += lp[64 + i] * lp[96 + i]; }
            ((float*)(p.ws + OFF_LAM))[tid] = expf(s0) - expf(s1) + (0.8f - 0.6f * expf(-0.3f * (float)tid));
        }
    }
    for (int i = gtid; i < 2048 * 16; i += gsz) {
        const int tt = i >> 4, f = i & 15; const float pos = (float)(f < 8 ? tt / 64 : tt % 64);
        const float freq = powf(10000.f, -(float)(f & 7) / 8.f); const float ang = pos * freq;
        ((float*)(p.ws + OFF_COS))[i] = cosf(ang); ((float*)(p.ws + OFF_SIN))[i] = sinf(ang);
    }
    for (int i = gtid; i < DEPTH * 245760; i += gsz) {
        const int l = i / 245760; int e = i - l * 245760;
        if (e < 98304) { const int n = e >> 8, k = e & 255; wlw(p, l, WE_UQ)[e] = f2bf(p.in[13][((size_t)l * 256 + k) * 384 + n] * p.in[11][l * 256 + k]); }
        else if ((e -= 98304) < 65536) { const int n = e >> 7, k = e & 127; wlw(p, l, WE_UKV)[e] = f2bf(p.in[14][((size_t)l * 128 + k) * 512 + n] * p.in[12][l * 128 + k]); }
        else if ((e -= 65536) < 65536) { const int n = e >> 6, k = e & 63, seg = n >> 8, ch = n & 255; float v = 0.f;
            if (seg < 2) { if (k < 32) v = p.in[17][(((size_t)l * 2 + seg) * 32 + k) * 256 + ch]; }
            else { if (k >= 32) v = p.in[19][(((size_t)l * 2 + (seg - 2)) * 32 + (k - 32)) * 256 + ch]; }
            wlw(p, l, WE_WA)[e] = f2bf(v); }
        else { e -= 65536; const int n = e >> 6, k = e & 63; wlw(p, l, WE_G)[e] = f2bf(p.in[20][((size_t)l * 64 + k) * 256 + n]); }
    }
    {
        constexpr int U_IN = (ZN / 64) * 16, U_OUT = 16 * 16, U_UP = 88 * 16, U_DN = 16 * 44, U_L = U_IN + U_OUT + U_UP + U_DN;
        float* tile = (float*)smem;
        for (int u = blockIdx.x; u < DEPTH * U_L; u += gridDim.x) {
            const int l = u / U_L; int e = u - l * U_L;
            if (e < U_IN) conv_unit<0>(p.in[8] + (size_t)l * 1024 * 2848, 2848, wlw(p, l, WE_IN), 1024, e >> 4, e & 15, tile);
            else if ((e -= U_IN) < U_OUT) conv_unit<1>(p.in[9] + (size_t)l * 1024 * 1024, 1024, wlw(p, l, WE_OUT), 1024, e >> 4, e & 15, tile);
            else if ((e -= U_OUT) < U_UP) conv_unit<2>(p.in[28] + (size_t)l * 1024 * 5632, 5632, wlw(p, l, WE_UP), 1024, e >> 4, e & 15, tile);
            else { e -= U_UP; conv_unit<1>(p.in[31] + (size_t)l * 2816 * 1024, 1024, wlw(p, l, WE_DOWN), 2816, e / 44, e % 44, tile); }
        }
    }
    {
        float* Ssm = (float*)smem;
        float* red = Ssm + 33 * 128;
        const int lane = tid & 63, w = tid >> 6;
        for (int u = blockIdx.x; u < DEPTH * 96; u += gridDim.x) {
            const int l = u / 96, n0 = (u - l * 96) * 64;
            const float* W = p.in[6] + (size_t)l * 1024 * 6144 + n0 + lane;
            float acc[33];
#pragma unroll
            for (int r = 0; r < 33; ++r) acc[r] = 0.f;
            for (int kc = 0; kc < 8; ++kc) {
                __syncthreads();
                for (int i = tid; i < 33 * 128; i += NTHR) { const int r = i >> 7, k = kc * 128 + (i & 127); const float cv = r < 32 ? p.in[1][r * 1024 + k] : p.in[3][k]; Ssm[i] = siluf_(cv); }
                __syncthreads();
                for (int kk = 0; kk < 32; ++kk) {
                    const int kl = w * 32 + kk; const float wv = W[(size_t)(kc * 128 + kl) * 6144];
#pragma unroll
                    for (int r = 0; r < 33; ++r) acc[r] += Ssm[r * 128 + kl] * wv;
                }
            }
#pragma unroll
            for (int r = 0; r < 33; ++r) red[(w * 33 + r) * 64 + lane] = acc[r];
            __syncthreads();
            for (int i = tid; i < 33 * 64; i += NTHR) {
                const int r = i >> 6, n = i & 63;
                const float v = red[(0 * 33 + r) * 64 + n] + red[(1 * 33 + r) * 64 + n] + red[(2 * 33 + r) * 64 + n] + red[(3 * 33 + r) * 64 + n];
                ((float*)(p.ws + OFF_MOD))[((size_t)l * 33 + r) * 6144 + n0 + n] = v + p.in[7][(size_t)l * 6144 + n0 + n];
            }
            __syncthreads();
        }
    }
}

constexpr int PH_PER_LAYER = 15, N_PHASES = 2 + DEPTH * PH_PER_LAYER;

DEV void run_phase(const Params& p, int ph, char* smem, int ctr_off, int* s_item) {
    if (ph == 0) { phase_prologue(p, smem); return; }
    if (ph == N_PHASES - 1) { phase_final(p); return; }
    const int l = (ph - 1) / PH_PER_LAYER, s = (ph - 1) % PH_PER_LAYER;
    const bool last_layer = (l == DEPTH - 1);
    char* scr = p.ws + OFF_SCR;
    const float* mod = (const float*)(p.ws + OFF_MOD) + (size_t)l * 33 * 6144;
    const bf16_t* H = (const bf16_t*)(p.ws + OFF_H);
    if (s == 0) { phase_norm(p, l, 0, false); return; }
    if (s >= 1 && s <= 8) {
        const int c = (s - 1) / 4, q = (s - 1) % 4;
        if (q == 0) {
            EpiIn e{(bf16_t*)(scr + SO_QK), (bf16_t*)(scr + SO_ZR), (bf16_t*)(scr + SO_VTNA), (bf16_t*)(scr + SO_VTD), (const float*)(p.ws + OFF_COS), (const float*)(p.ws + OFF_SIN)};
            gemm_phase(H + (size_t)c * TC * 1024, 1024, wl(p, l, WE_IN), 1024, 1024, TC / 128, ZN / 128, false, smem, e);
        } else if (q == 1) phase_prep(p, l, c);
        else if (q == 2) phase_gemm_small(p, l, c, smem);
        else phase_mix(p, l, c, ph + ctr_off, smem, ctr_off ? PROBE_MIXSEL : 3, s_item);
        return;
    }
    if (s == 9) {
        EpiG e{(bf16_t*)(p.ws + OFF_H), (const bf16_t*)(scr + SO_SC), (const float*)(scr + SO_Y), p.in[23] + l * 256, p.in[24] + l * 256, p.in[25] + l * 256, 0};
        gemm_phase((const bf16_t*)(scr + SO_AG), 64, wl(p, l, WE_G), 64, 64, T_ALL / 128, 2, last_layer, smem, e);
        return;
    }
    if (s == 10) { EpiRes e{&p, mod, 2048, l == 0 ? 1 : 0}; gemm_phase(H, 1024, wl(p, l, WE_OUT), 1024, 1024, T_ALL / 128, 8, last_layer, smem, e); return; }
    if (s == 11) { phase_norm(p, l, 1, last_layer); return; }
    if (s == 12) { EpiUp e{(bf16_t*)(scr + SO_G), (float*)(scr + SO_E), p.in[29] + (size_t)l * 3 * DFF, p.in[30] + (size_t)l * DFF};
                   gemm_phase(H, 1024, wl(p, l, WE_UP), 1024, 1024, T_ALL / 128, 44, last_layer, smem, e); return; }
    if (s == 13) { phase_fix(p, l); return; }
    { EpiRes e{&p, mod, 5120, 0}; gemm_phase((const bf16_t*)(scr + SO_G), DFF, wl(p, l, WE_DOWN), DFF, DFF, T_ALL / 128, 8, last_layer, smem, e); }
}

#define XB_TMO      128
#define XB_XCNT(j)  (256  + 64 * (j))
#define XB_XSUB(j)  (1280 + 64 * (j))
#define XB_XGEN(j)  (2304 + 64 * (j))
#define XB_TOP      3328
#define XB_TOPGEN   3392
#define XCD_BAR_WORDS 3456
#define XB_SPIN_CAP (1u << 18)

__device__ __forceinline__ unsigned xb_ld(unsigned* p)              { return __hip_atomic_load(p, __ATOMIC_RELAXED, __HIP_MEMORY_SCOPE_AGENT); }
__device__ __forceinline__ unsigned xb_add(unsigned* p, unsigned v) { return __hip_atomic_fetch_add(p, v, __ATOMIC_RELAXED, __HIP_MEMORY_SCOPE_AGENT); }
__device__ __forceinline__ unsigned xb_xcc_id() { return (unsigned)__builtin_amdgcn_s_getreg((3 << 11) | 20) & 0xFu; }
#define XB_SPIN(cond, bar) do { unsigned _sp = 0; while (cond) { __builtin_amdgcn_s_sleep(1); \
    if ((++_sp & 255u) == 0u) { if (xb_ld(&(bar)[XB_TMO])) break; if (_sp > XB_SPIN_CAP) { atomicAdd(&(bar)[XB_TMO], 1u); break; } } } } while (0)

struct XcdBarrier {
    unsigned* bar; unsigned x;
    volatile LAS unsigned* st;
};

__device__ __forceinline__ XcdBarrier xcd_barrier_post(unsigned* bar, volatile LAS unsigned* st) {
    XcdBarrier b; b.bar = bar; b.x = xb_xcc_id(); b.st = st;
    if (threadIdx.x == 0) (void)xb_add(&bar[XB_XCNT(b.x)], 1u);
    return b;
}
__device__ __forceinline__ void xcd_barrier_complete(unsigned* bar, unsigned x, unsigned& nloc, unsigned& nx) {
    const unsigned G = gridDim.x * gridDim.y * gridDim.z;
    unsigned sum, cnt, mine, sp = 0u;
    for (;;) {
        sum = 0u; cnt = 0u; mine = 0u;
#pragma unroll
        for (unsigned j = 0; j < 16; ++j) { const unsigned c = xb_ld(&bar[XB_XCNT(j)]); sum += c; cnt += (c > 0u) ? 1u : 0u; mine = (j == x) ? c : mine; }
        if (sum == G) break;
        __builtin_amdgcn_s_sleep(1);
        if ((++sp & 255u) == 0u) { if (xb_ld(&bar[XB_TMO])) break; if (sp > XB_SPIN_CAP) { atomicAdd(&bar[XB_TMO], 1u); break; } }
    }
    nloc = mine > 0u ? mine : 1u; nx = cnt > 0u ? cnt : 1u;
}

__device__ __forceinline__ void xcd_barrier(const XcdBarrier& b) {
    asm volatile("s_waitcnt vmcnt(0)" ::: "memory");
    __syncthreads();
    if (threadIdx.x == 0) {
        unsigned* bar = b.bar;
        __builtin_amdgcn_s_waitcnt(0);
        unsigned nloc = b.st[0], nx = b.st[1];
        if (nloc == 0u) { xcd_barrier_complete(bar, b.x, nloc, nx); b.st[0] = nloc; b.st[1] = nx; }
        const unsigned old = xb_add(&bar[XB_XSUB(b.x)], 1u);
        const unsigned gen = old / nloc;
        if (old + 1u == (gen + 1u) * nloc) {
            __builtin_amdgcn_fence(__ATOMIC_RELEASE, "agent");
            asm volatile("s_waitcnt vmcnt(0)" ::: "memory");
            const unsigned og = xb_add(&bar[XB_TOP], 1u);
            const unsigned tg = og / nx;
            if (og + 1u == (tg + 1u) * nx) xb_add(&bar[XB_TOPGEN], 1u);
            else XB_SPIN(xb_ld(&bar[XB_TOPGEN]) == tg, bar);
            __builtin_amdgcn_fence(__ATOMIC_ACQUIRE, "agent");
            xb_add(&bar[XB_XGEN(b.x)], 1u);
            asm volatile("s_waitcnt vmcnt(0)" ::: "memory");
        } else {
            XB_SPIN(xb_ld(&bar[XB_XGEN(b.x)]) == gen, bar);
            __builtin_amdgcn_fence(__ATOMIC_ACQUIRE, "agent");
            asm volatile("s_waitcnt vmcnt(0)" ::: "memory");
        }
    }
    __syncthreads();
}


__global__ void __launch_bounds__(NTHR, 2) mk_fwd(Params p, int ph_lo, int ph_hi) {
    extern __shared__ __attribute__((aligned(16))) char smem[];
    __shared__ uint4 s_ctl;
    if (threadIdx.x == 0) s_ctl = make_uint4(0u, 0u, 0u, 0u);
    __syncthreads();
    XcdBarrier xb = xcd_barrier_post((unsigned*)(p.ws + OFF_XBAR), (volatile LAS unsigned*)&s_ctl);
    int* s_item = (int*)&s_ctl + 2;
    for (int ph = ph_lo; ph <= ph_hi; ++ph) {
        run_phase(p, ph, smem, 0, s_item);
#ifdef PROBE_DUP
        if (ph > 0 && ph < N_PHASES - 1) {
            const int s_ = (ph - 1) % PH_PER_LAYER, q_ = (s_ >= 1 && s_ <= 8) ? (s_ - 1) % 4 : -1;
            bool dup = false;
            if ((PROBE_DUP & 1) && (q_ == 0)) dup = true;
            if ((PROBE_DUP & 2) && (s_ == 12)) dup = true;
            if ((PROBE_DUP & 4) && (q_ == 3)) dup = true;
            if ((PROBE_DUP & 8) && (q_ == 2 || s_ == 9)) dup = true;
            if ((PROBE_DUP & 16) && (s_ == 0 || s_ == 11 || q_ == 1 || s_ == 13)) dup = true;
            if (dup) run_phase(p, ph, smem, 100, s_item);
        }
#endif
        if (ph < ph_hi) {
            if (ph_lo < 0) cg::this_grid().sync();
            xcd_barrier(xb);
        }
    }
}

extern "C" void kernel_launch(void* const* d_in, const int* in_sizes, int n_in, void* d_out, int out_size, void* d_ws, size_t ws_size, hipStream_t stream) {
    static int grid = 0;
    if (grid == 0) {
        if (n_in != 33 || ws_size < WS_NEED) { fprintf(stderr, "kernel_launch: n_in %d ws %zu need %zu\n", n_in, ws_size, (size_t)WS_NEED); grid = -1; return; }
        int dev = 0, cus = 0, per_cu = 0;
        hipGetDevice(&dev);
        hipDeviceGetAttribute(&cus, hipDeviceAttributeMultiprocessorCount, dev);
        if (hipFuncSetAttribute((const void*)mk_fwd, hipFuncAttributeMaxDynamicSharedMemorySize, LDS_BYTES) != hipSuccess) { fprintf(stderr, "hipFuncSetAttribute failed\n"); grid = -1; return; }
        if (hipOccupancyMaxActiveBlocksPerMultiprocessor(&per_cu, (const void*)mk_fwd, NTHR, LDS_BYTES) != hipSuccess || per_cu < 1) { fprintf(stderr, "occupancy query failed (%d)\n", per_cu); per_cu = 1; }
        if (per_cu > 2) per_cu = 2;
        grid = cus * per_cu;
        fprintf(stderr, "kernel_launch: grid %d (%d CUs x %d)\n", grid, cus, per_cu);
    }
    if (grid < 0) return;
    Params p{};
    for (int i = 0; i < 33; ++i) p.in[i] = (const float*)d_in[i];
    p.out = (float*)d_out; p.ws = (char*)d_ws;
#if MK_ONE_LAUNCH
    if (hipMemsetAsync((char*)d_ws + OFF_XBAR, 0, XCD_BAR_WORDS * 4, stream) != hipSuccess) { fprintf(stderr, "memset failed\n"); return; }
    int lo = 0, hi = N_PHASES - 1;
    void* args[] = {&p, &lo, &hi};
    hipError_t e = hipLaunchCooperativeKernel((const void*)mk_fwd, dim3(grid), dim3(NTHR), args, LDS_BYTES, stream);
    if (e != hipSuccess) fprintf(stderr, "cooperative launch failed: %s (grid %d)\n", hipGetErrorString(e), grid);
#else
    for (int ph = 0; ph < N_PHASES; ++ph) {
        int lo = ph, hi = ph;
        void* args[] = {&p, &lo, &hi};
        hipError_t e = hipLaunchCooperativeKernel((const void*)mk_fwd, dim3(grid), dim3(NTHR), args, LDS_BYTES, stream);
        if (e != hipSuccess) { fprintf(stderr, "launch %d failed: %s (grid %d)\n", ph, hipGetErrorString(e), grid); break; }
    }
#endif
}
```

```cpp
#include <hip/hip_runtime.h>
#include <hip/hip_cooperative_groups.h>
#include <cstdio>
#include <cstdint>
namespace cg = cooperative_groups;

#ifndef MK_ONE_LAUNCH
#define MK_ONE_LAUNCH 1
#endif

typedef unsigned short bf16_t;
typedef short bf16x8 __attribute__((ext_vector_type(8)));
typedef float f32x4 __attribute__((ext_vector_type(4)));
typedef unsigned u32x4 __attribute__((ext_vector_type(4)));
typedef unsigned u32x2 __attribute__((ext_vector_type(2)));
#define DEV __device__ __forceinline__
#define LAS __attribute__((address_space(3)))

constexpr int D = 1024, NBATCH = 32, SEQ = 2048, CTXL = 256, TT = 2304, T_ALL = NBATCH * TT, DEPTH = 4, DFF = 2816;
constexpr int NCHUNK = 2, CB = NBATCH / NCHUNK, TC = CB * TT;
constexpr int ZN = 2944, ZRW = 1408;
constexpr int NTHR = 256;
constexpr int LDS_BYTES = 73728;
constexpr int GP = 72;
constexpr int CP = 132;
#ifndef PROBE_MIXSEL
#define PROBE_MIXSEL 3
#endif
#ifndef MIXMASK
#define MIXMASK 31
#endif
#ifndef DMQ
#define DMQ 2
#endif

constexpr size_t al256(size_t x) { return (x + 255) & ~(size_t)255; }
constexpr size_t OFF_CTR = 0;
constexpr size_t OFF_LAM = 1024;
constexpr size_t OFF_XBAR = 4096;
constexpr size_t OFF_COS = 32768;
constexpr size_t OFF_SIN = OFF_COS + 2048 * 16 * 4;
constexpr size_t OFF_MOD = OFF_SIN + 2048 * 16 * 4;
constexpr size_t OFF_RSQ = al256(OFF_MOD + (size_t)DEPTH * 33 * 6144 * 4);
constexpr size_t OFF_RSKV = OFF_RSQ + (size_t)TC * 4;
constexpr size_t OFF_XC = al256(OFF_RSKV + (size_t)TC * 4);
constexpr size_t OFF_W = al256(OFF_XC + (size_t)NBATCH * CTXL * D * 4);
constexpr size_t WE_IN = 0;
constexpr size_t WE_OUT = WE_IN + (size_t)ZN * 1024;
constexpr size_t WE_UP = WE_OUT + (size_t)1024 * 1024;
constexpr size_t WE_DOWN = WE_UP + (size_t)5632 * 1024;
constexpr size_t WE_UQ = WE_DOWN + (size_t)1024 * 2816;
constexpr size_t WE_UKV = WE_UQ + (size_t)384 * 256;
constexpr size_t WE_WA = WE_UKV + (size_t)512 * 128;
constexpr size_t WE_G = WE_WA + (size_t)1024 * 64;
constexpr size_t WE_TOTAL = WE_G + (size_t)256 * 64;
constexpr size_t OFF_H = al256(OFF_W + (size_t)DEPTH * WE_TOTAL * 2);
constexpr size_t OFF_SCR = al256(OFF_H + (size_t)T_ALL * 1024 * 2);
constexpr size_t SO_QK = 0;
constexpr size_t SO_ZR = al256(SO_QK + (size_t)TC * 1024 * 2);
constexpr size_t VT_ELEMS = (size_t)CB * 4 * 64 * TT;
constexpr size_t SO_VTNA = al256(SO_ZR + (size_t)TC * ZRW * 2);
constexpr size_t SO_VTD = SO_VTNA + VT_ELEMS * 2;
constexpr size_t SO_VTM = SO_VTD + VT_ELEMS * 2;
constexpr size_t SO_MQ = SO_VTM + VT_ELEMS * 2;
constexpr size_t SO_KN = al256(SO_MQ + (size_t)TC * 384 * 2);
constexpr size_t SO_AWA = al256(SO_KN + (size_t)TC * 256 * 2);
constexpr size_t SO_AG = al256(SO_AWA + (size_t)TC * 64 * 2);
constexpr size_t SO_SC = al256(SO_AG + (size_t)T_ALL * 64 * 2);
constexpr size_t SO_Y = al256(SO_SC + (size_t)T_ALL * 2048 * 2);
constexpr size_t SO_END = al256(SO_Y + (size_t)2 * T_ALL * 256 * 4);
constexpr size_t SO_G = 0;
constexpr size_t SO_E = al256(SO_G + (size_t)T_ALL * DFF * 2);
constexpr size_t SO_END2 = al256(SO_E + (size_t)(T_ALL / 128) * 6 * DFF * 4);
constexpr size_t WS_NEED = OFF_SCR + (SO_END > SO_END2 ? SO_END : SO_END2);

struct Params { const float* in[33]; float* out; char* ws; };

DEV int tid_() { int t = __builtin_amdgcn_workitem_id_x(); asm volatile("" : "+v"(t)); return t; }
DEV float bf2f(bf16_t b) { return __uint_as_float(((unsigned)b) << 16); }
DEV bf16_t f2bf(float f) { unsigned u = __float_as_uint(f); u += 0x7fffu + ((u >> 16) & 1u); return (bf16_t)(u >> 16); }
typedef __bf16 bf16v2_t __attribute__((ext_vector_type(2)));
typedef float f32v2_t __attribute__((ext_vector_type(2)));
DEV unsigned pk2(float a, float b) { const f32v2_t f = {a, b}; return __builtin_bit_cast(unsigned, __builtin_convertvector(f, bf16v2_t)); }
DEV float lo_bf(unsigned u) { return __uint_as_float(u << 16); }
DEV float hi_bf(unsigned u) { return __uint_as_float(u & 0xffff0000u); }
DEV float wave_sum(float v) {
#pragma unroll
    for (int o = 32; o >= 1; o >>= 1) v += __shfl_xor(v, o);
    return v;
}
template <int CTRL> DEV float dppf(float v) { return __builtin_bit_cast(float, __builtin_amdgcn_update_dpp(0, __builtin_bit_cast(int, v), CTRL, 0xf, 0xf, true)); }
DEV float sum16(float v) { v += dppf<0xB1>(v); v += dppf<0x4E>(v); v += dppf<0x124>(v); v += dppf<0x128>(v); return v; }
DEV float max16(float v) { v = fmaxf(v, dppf<0xB1>(v)); v = fmaxf(v, dppf<0x4E>(v)); v = fmaxf(v, dppf<0x124>(v)); v = fmaxf(v, dppf<0x128>(v)); return v; }
DEV float sum32(float v) { v = sum16(v); v += __shfl_xor(v, 16); return v; }
DEV float sigmoidf_(float x) { return __builtin_amdgcn_rcpf(1.f + __expf(-x)); }
DEV float siluf_(float x) { return x * __builtin_amdgcn_rcpf(1.f + __expf(-x)); }

DEV float* xrow(const Params& p, int g) {
    const int b = g / TT, tt = g - b * TT;
    return tt < SEQ ? p.out + ((size_t)b * SEQ + tt) * D : (float*)(p.ws + OFF_XC) + ((size_t)b * CTXL + (tt - SEQ)) * D;
}
DEV const float* xrow_in(const Params& p, int g) {
    const int b = g / TT, tt = g - b * TT;
    return tt < SEQ ? p.in[0] + ((size_t)b * SEQ + tt) * D : p.in[2] + ((size_t)b * CTXL + (tt - SEQ)) * D;
}
DEV const bf16_t* wl(const Params& p, int l, size_t we) { return (const bf16_t*)(p.ws + OFF_W) + (size_t)l * WE_TOTAL + we; }
DEV bf16_t* wlw(const Params& p, int l, size_t we) { return (bf16_t*)(p.ws + OFF_W) + (size_t)l * WE_TOTAL + we; }

template <class Epi>
DEV void gemm_tile(const bf16_t* __restrict__ A, int lda, const bf16_t* __restrict__ Bt, int ldb, int K, int tm, int tn, char* smem, const Epi& epi) {
    const int tid = tid_(), lane = tid & 63, wid = tid >> 6, wr = wid >> 1, wc = wid & 1, fr = lane & 15, fq = lane >> 4;
    bf16_t* As = (bf16_t*)smem;
    bf16_t* Bs = As + 2 * 128 * 64;
    const int lrow = tid >> 3, lcc = (tid & 7) * 8, lsw = (((tid & 7) ^ (lrow & 7)) * 8);
    const bf16_t* Ag = A + (size_t)(tm * 128 + lrow) * lda + lcc;
    const bf16_t* Bg = Bt + (size_t)(tn * 128 + lrow) * ldb + lcc;
    f32x4 acc[4][4];
#pragma unroll
    for (int m = 0; m < 4; ++m)
#pragma unroll
        for (int n = 0; n < 4; ++n) acc[m][n] = (f32x4){0.f, 0.f, 0.f, 0.f};
    const int gsw = (((tid & 7) ^ (lrow & 7)) * 8);
    const bf16_t* Ad = A + (size_t)(tm * 128 + lrow) * lda + gsw;
    const bf16_t* Bd = Bt + (size_t)(tn * 128 + lrow) * ldb + gsw;
    char* Asb = (char*)As; char* Bsb = (char*)Bs;
#define G_DMA(buf_, kt_) do { const int ko_ = (kt_) * 64; \
        _Pragma("unroll") for (int i = 0; i < 4; ++i) { \
            __builtin_amdgcn_global_load_lds((const unsigned*)(Ad + (size_t)(32 * i) * lda + ko_), (LAS unsigned*)(Asb + (buf_) * 16384 + i * 4096 + tid * 16), 16, 0, 0); \
            __builtin_amdgcn_global_load_lds((const unsigned*)(Bd + (size_t)(32 * i) * ldb + ko_), (LAS unsigned*)(Bsb + (buf_) * 16384 + i * 4096 + tid * 16), 16, 0, 0); } } while (0)
#define G_FRAGS(cur_, ks_) const bf16_t* Ac##ks_ = As + (cur_) * 128 * 64 + (wr * 64 + fr) * 64 + ((((ks_) * 4 + fq) ^ (fr & 7)) * 8); const bf16_t* Bc##ks_ = Bs + (cur_) * 128 * 64 + (wc * 64 + fr) * 64 + ((((ks_) * 4 + fq) ^ (fr & 7)) * 8); \
        bf16x8 af##ks_[4], bfv##ks_[4]; \
        _Pragma("unroll") for (int m = 0; m < 4; ++m) af##ks_[m] = *(const bf16x8*)(Ac##ks_ + m * 16 * 64); \
        _Pragma("unroll") for (int n = 0; n < 4; ++n) bfv##ks_[n] = *(const bf16x8*)(Bc##ks_ + n * 16 * 64);
#define G_MMA(ks_) __builtin_amdgcn_s_setprio(1); _Pragma("unroll") for (int m = 0; m < 4; ++m) \
        _Pragma("unroll") for (int n = 0; n < 4; ++n) acc[m][n] = __builtin_amdgcn_mfma_f32_16x16x32_bf16(bfv##ks_[n], af##ks_[m], acc[m][n], 0, 0, 0); __builtin_amdgcn_s_setprio(0);
    const int nk = K >> 6;
    G_DMA(0, 0);
    asm volatile("s_waitcnt vmcnt(0)" ::: "memory");
    __syncthreads();
#pragma unroll 4
    for (int kt = 0; kt < nk; ++kt) {
        const int cur = kt & 1;
        if (kt + 1 < nk) G_DMA(cur ^ 1, kt + 1);
        {
            G_FRAGS(cur, 0)
            G_MMA(0)
            G_FRAGS(cur, 1)
            G_MMA(1)
        }
        asm volatile("s_waitcnt vmcnt(0)" ::: "memory");
        __syncthreads();
    }
#undef G_DMA
#undef G_FRAGS
#undef G_MMA
    float* Ct = (float*)smem;
#pragma unroll
    for (int m = 0; m < 4; ++m)
#pragma unroll
        for (int n = 0; n < 4; ++n) *(f32x4*)(Ct + (wr * 64 + m * 16 + fr) * CP + wc * 64 + n * 16 + fq * 4) = acc[m][n];
    __syncthreads();
    epi(tm, tn, Ct);
    __syncthreads();
}

DEV f32x4 rope4(const float* Crow, int c, int o, const float* cosT, const float* sinT, int tt, f32x4 v) {
    const int sub = o >> 3, ti = (sub >> 1) * 8 + (o & 7);
    const f32x4 cs = *(const f32x4*)(cosT + tt * 16 + ti), sn = *(const f32x4*)(sinT + tt * 16 + ti);
    const f32x4 pv = *(const f32x4*)(Crow + ((sub & 1) ? c - 8 : c + 8));
    return (sub & 1) ? v * cs + pv * sn : v * cs - pv * sn;
}

DEV void store_vt(const float* Ct, int c0, bf16_t* vt_head  , int tt0, const float* rowscale) {
    for (int item = tid_(); item < 64 * 16; item += NTHR) {
        const int d = item & 63, rg = item >> 6;
        float v[8];
#pragma unroll
        for (int i = 0; i < 8; ++i) { v[i] = Ct[(rg * 8 + i) * CP + c0 + d]; if (rowscale) v[i] *= rowscale[rg * 8 + i]; }
        u32x4 w; w.x = pk2(v[0], v[1]); w.y = pk2(v[2], v[3]); w.z = pk2(v[4], v[5]); w.w = pk2(v[6], v[7]);
        *(u32x4*)(vt_head + (size_t)d * TT + tt0 + rg * 8) = w;
    }
}

DEV f32x4 rope4v(f32x4 v, f32x4 pv, f32x4 cs, f32x4 sn, int sub) { return (sub & 1) ? v * cs + pv * sn : v * cs - pv * sn; }

struct EpiIn {
    bf16_t* QK; bf16_t* ZR; bf16_t* VtNA; bf16_t* VtD; const float* cosT; const float* sinT;
    DEV void operator()(int tm, int tn, const float* Ct) const {
        const int row0 = tm * 128, bl = row0 / TT, tt0 = row0 - bl * TT; const bool lat = tt0 < SEQ;
        if (tn == 4 || tn == 5 || tn == 10 || tn == 11) {
            bf16_t* Vt = (tn < 6) ? VtNA : VtD; const int hp = (tn & 1) * 2;
            store_vt(Ct, 0, Vt + ((size_t)(bl * 4 + hp) * 64) * TT, tt0, nullptr);
            store_vt(Ct, 64, Vt + ((size_t)(bl * 4 + hp + 1) * 64) * TT, tt0, nullptr);
            return;
        }
        bf16_t* dst; int ds, dc; unsigned ropem = 0;
        if (tn < 4) { dst = QK; ds = 1024; dc = tn * 128; }
        else if (tn < 10) { dst = QK; ds = 1024; dc = 512 + (tn - 6) * 128; ropem = 0xf; }
        else { dst = ZR; ds = ZRW; dc = (tn - 12) * 128; if (tn == 21) ropem = 1; }
        if (!lat) ropem = 0;
        const int tid = tid_(), c = (tid & 31) << 2, rb = tid >> 5;
        const bool rp = (ropem >> (c >> 5)) & 1;
        const int o = c & 31, sub = o >> 3, ti = (sub >> 1) * 8 + (o & 7), pc = (sub & 1) ? c - 8 : c + 8;
        bf16_t* dp = dst + (size_t)row0 * ds + dc + c;
#pragma unroll
        for (int it0 = 0; it0 < 16; it0 += 4) {
            f32x4 cs[4], sn[4];
            if (rp) {
#pragma unroll
                for (int u = 0; u < 4; ++u) { const int r = rb + 8 * (it0 + u); cs[u] = *(const f32x4*)(cosT + (tt0 + r) * 16 + ti); sn[u] = *(const f32x4*)(sinT + (tt0 + r) * 16 + ti); }
            }
#pragma unroll
            for (int u = 0; u < 4; ++u) {
                const int r = rb + 8 * (it0 + u);
                f32x4 v = *(const f32x4*)(Ct + r * CP + c);
                if (rp) v = rope4v(v, *(const f32x4*)(Ct + r * CP + pc), cs[u], sn[u], sub);
                u32x2 w; w.x = pk2(v[0], v[1]); w.y = pk2(v[2], v[3]);
                *(u32x2*)(dp + (size_t)r * ds) = w;
            }
        }
    }
};
struct EpiUQ {
    bf16_t* MQ; const float* rs; const float* cosT; const float* sinT;
    DEV void operator()(int tm, int tn, const float* Ct) const {
        const int row0 = tm * 128, bl = row0 / TT, tt0 = row0 - bl * TT; const bool lat = tt0 < SEQ;
        const int tid = tid_(), c = (tid & 31) << 2, rb = tid >> 5, col = tn * 128 + c, hc = col % 96;
        const bool rp = lat && hc >= 64;
        const int o = rp ? hc - 64 : 0, sub = o >> 3, ti = (sub >> 1) * 8 + (o & 7), pc = (sub & 1) ? c - 8 : c + 8;
#pragma unroll
        for (int it0 = 0; it0 < 16; it0 += 4) {
            f32x4 cs[4], sn[4]; float sc[4];
#pragma unroll
            for (int u = 0; u < 4; ++u) { const int r = rb + 8 * (it0 + u); sc[u] = rs[row0 + r]; if (rp) { cs[u] = *(const f32x4*)(cosT + (tt0 + r) * 16 + ti); sn[u] = *(const f32x4*)(sinT + (tt0 + r) * 16 + ti); } }
#pragma unroll
            for (int u = 0; u < 4; ++u) {
                const int r = rb + 8 * (it0 + u);
                f32x4 v = *(const f32x4*)(Ct + r * CP + c);
                if (rp) v = rope4v(v, *(const f32x4*)(Ct + r * CP + pc), cs[u], sn[u], sub);
                v = v * sc[u];
                u32x2 w; w.x = pk2(v[0], v[1]); w.y = pk2(v[2], v[3]);
                *(u32x2*)(MQ + (size_t)(row0 + r) * 384 + col) = w;
            }
        }
    }
};
struct EpiUKV {
    bf16_t* KN; bf16_t* VtM; const float* rs;
    DEV void operator()(int tm, int tn, const float* Ct) const {
        const int row0 = tm * 128, bl = row0 / TT, tt0 = row0 - bl * TT;
        const int tid = tid_(), c = (tid & 15) << 2, rb = tid >> 4;
        float* rsl = (float*)((char*)Ct + 128 * CP * 4);
        if (tid < 128) rsl[tid] = rs[row0 + tid];
        __syncthreads();
#pragma unroll
        for (int it = 0; it < 8; ++it) {
            const int r = rb + 16 * it;
            const f32x4 v = *(const f32x4*)(Ct + r * CP + c) * rsl[r];
            u32x2 w; w.x = pk2(v[0], v[1]); w.y = pk2(v[2], v[3]);
            *(u32x2*)(KN + (size_t)(row0 + r) * 256 + tn * 64 + c) = w;
        }
        store_vt(Ct, 64, VtM + ((size_t)(bl * 4 + tn) * 64) * TT, tt0, rsl);
    }
};
struct EpiWA {
    bf16_t* SC; const float* w0; const float* a0;
    DEV void operator()(int tm, int tn, const float* Ct) const {
        const int row0 = tm * 128, seg = tn >> 1;
        const int tid = tid_(), c = (tid & 31) << 2, rb = tid >> 5, ch = (tn & 1) * 128 + c, h = ch >> 6, j = ch & 63;
        const f32x4 bias = seg < 2 ? *(const f32x4*)(w0 + seg * 256 + ch) : *(const f32x4*)(a0 + (seg - 2) * 256 + ch);
        bf16_t* dp = SC + (size_t)row0 * 2048 + h * 512 + (4 + seg) * 64 + j;
#pragma unroll 4
        for (int it = 0; it < 16; ++it) {
            const int r = rb + 8 * it;
            const f32x4 v = *(const f32x4*)(Ct + r * CP + c) + bias;
            float o[4];
#pragma unroll
            for (int i = 0; i < 4; ++i) {
                if (seg < 2) o[i] = 0.60653065971f * sigmoidf_(v[i]);
                else o[i] = sigmoidf_(v[i]);
            }
            u32x2 w; w.x = pk2(o[0], o[1]); w.y = pk2(o[2], o[3]);
            *(u32x2*)(dp + (size_t)r * 2048) = w;
        }
    }
};
struct EpiG {
    bf16_t* MIX; const bf16_t* SC; const float* Y; const float* r_k; const float* ln_w; const float* ln_b; int gbase;
    DEV void operator()(int tm, int tn, const float* Ct) const {
        const int row0 = tm * 128;
        const int tid = tid_(), l32 = tid & 31, hh = (tid >> 5) & 1, rb = tid >> 6, h = tn * 2 + hh, j = l32 * 2, ch = h * 64 + j;
        const float rk0 = r_k[ch], rk1 = r_k[ch + 1], lw0 = ln_w[ch], lw1 = ln_w[ch + 1], lb0 = ln_b[ch], lb1 = ln_b[ch + 1];
#pragma unroll
        for (int it0 = 0; it0 < 32; it0 += 4) {
            unsigned yfu[4], ybu[4]; unsigned ur[4], uv[4], uk[4];
#pragma unroll
            for (int u = 0; u < 4; ++u) {
                const size_t row = (size_t)(row0 + rb + 4 * (it0 + u));
                yfu[u] = *(const unsigned*)((const bf16_t*)Y + row * 256 + ch); ybu[u] = *(const unsigned*)((const bf16_t*)Y + ((size_t)T_ALL + row) * 256 + ch);
                const bf16_t* sc = SC + row * 2048 + h * 512 + j;
                ur[u] = *(const unsigned*)(sc); uv[u] = *(const unsigned*)(sc + 64); uk[u] = *(const unsigned*)(sc + 128);
            }
#pragma unroll
            for (int u = 0; u < 4; ++u) {
                const int r = rb + 4 * (it0 + u);
                const float y0 = lo_bf(yfu[u]) + lo_bf(ybu[u]), y1 = hi_bf(yfu[u]) + hi_bf(ybu[u]);
                const float mean = sum32(y0 + y1) * (1.f / 64.f);
                const float d0 = y0 - mean, d1 = y1 - mean;
                const float var = sum32(d0 * d0 + d1 * d1) * (1.f / 64.f);
                const float rstd = rsqrtf(var + 64e-5f);
                const float rk = sum32(lo_bf(ur[u]) * lo_bf(uk[u]) * rk0 + hi_bf(ur[u]) * hi_bf(uk[u]) * rk1);
                const float g0 = Ct[r * CP + hh * 64 + j], g1 = Ct[r * CP + hh * 64 + j + 1];
                const float o0 = (d0 * rstd * lw0 + lb0 + rk * lo_bf(uv[u])) * g0;
                const float o1 = (d1 * rstd * lw1 + lb1 + rk * hi_bf(uv[u])) * g1;
                *(unsigned*)(MIX + (size_t)(row0 + r) * 1024 + 512 + ch) = pk2(o0, o1);
            }
        }
    }
};
struct EpiRes {
    const Params* p; const float* mod; int goff; int from_in;
    DEV void operator()(int tm, int tn, const float* Ct) const {
        const int row0 = tm * 128, b = row0 / TT, tt0 = row0 - b * TT;
        const int tid = tid_(), c = (tid & 31) << 2, rb = tid >> 5;
        const f32x4 g = *(const f32x4*)(mod + (size_t)(tt0 < SEQ ? b : 32) * 6144 + goff + tn * 128 + c);
        float* x0 = xrow(*p, row0) + tn * 128 + c;
        const float* xs = from_in ? xrow_in(*p, row0) + tn * 128 + c : x0;
#pragma unroll
        for (int it0 = 0; it0 < 16; it0 += 8) {
            f32x4 xv[8];
#pragma unroll
            for (int u = 0; u < 8; ++u) xv[u] = *(const f32x4*)(xs + (size_t)(rb + 8 * (it0 + u)) * D);
#pragma unroll
            for (int u = 0; u < 8; ++u) { const int r = rb + 8 * (it0 + u); *(f32x4*)(x0 + (size_t)r * D) = xv[u] + g * *(const f32x4*)(Ct + r * CP + c); }
        }
    }
};
struct EpiUp {
    bf16_t* G; float* E; const float* cw; const float* cb;
    DEV void operator()(int tm, int tn, const float* Ct) const {
        const int row0 = tm * 128, tt0 = row0 % TT;
        const bool first = (tt0 == 0 || tt0 == SEQ), last = (tt0 + 127 == SEQ - 1 || tt0 + 127 == TT - 1);
        const int tid = tid_(), c = (tid & 15) << 2, rb = tid >> 4, j = tn * 64 + c;
        const f32x4 w0 = *(const f32x4*)(cw + j), w1 = *(const f32x4*)(cw + DFF + j), w2 = *(const f32x4*)(cw + 2 * DFF + j), bb = *(const f32x4*)(cb + j);
        const f32x4 z = (f32x4){0.f, 0.f, 0.f, 0.f};
#pragma unroll 2
        for (int it = 0; it < 8; ++it) {
            const int r = rb + 16 * it;
            const f32x4 ac = *(const f32x4*)(Ct + r * CP + c);
            const f32x4 ap = r > 0 ? *(const f32x4*)(Ct + (r - 1) * CP + c) : z;
            const f32x4 an = r < 127 ? *(const f32x4*)(Ct + (r + 1) * CP + c) : z;
            const f32x4 bv = *(const f32x4*)(Ct + r * CP + 64 + c);
            const f32x4 pre = w0 * ap + w1 * ac + w2 * an + bb;
            if ((r == 0 && !first) || (r == 127 && !last)) {
                float* e = E + ((size_t)tm * 6 + (r == 0 ? 0 : 3)) * DFF + j;
                *(f32x4*)(e) = pre; *(f32x4*)(e + DFF) = bv; *(f32x4*)(e + 2 * DFF) = ac;
            } else {
                u32x2 w; w.x = pk2(siluf_(pre[0]) * bv[0], siluf_(pre[1]) * bv[1]); w.y = pk2(siluf_(pre[2]) * bv[2], siluf_(pre[3]) * bv[3]);
                *(u32x2*)(G + (size_t)(row0 + r) * DFF + j) = w;
            }
        }
    }
};

template <class Epi>
DEV void gemm_phase(const bf16_t* A, int lda, const bf16_t* Bt, int ldb, int K, int ntm, int ntn, bool skip_ctx, char* smem, const Epi& epi) {
    if ((gridDim.x & 7) == 0 && (ntm & 7) == 0) {
        const int xcd = blockIdx.x & 7, slot = blockIdx.x >> 3, nper = gridDim.x >> 3, R = ntm >> 3, per = R * ntn;
        const int nfb = ntn >> 3, fullq = nfb * R * 8, w = ntn - nfb * 8;
        for (int q = slot; q < per; q += nper) {
            int tm, tn;
            if (q < fullq) { const int tb = q / (R * 8), r = q - tb * (R * 8); tm = r >> 3; tn = tb * 8 + (r & 7); }
            else { const int q2 = q - fullq; tm = q2 / w; tn = nfb * 8 + (q2 - tm * w); }
            tm += xcd * R;
            if (skip_ctx && ((tm * 128) % TT) >= SEQ) continue;
            gemm_tile(A, lda, Bt, ldb, K, tm, tn, smem, epi);
        }
        return;
    }
    const int total = ntm * ntn;
    for (int t = blockIdx.x; t < total; t += gridDim.x) {
        const int tm = t / ntn, tn = t - tm * ntn;
        if (skip_ctx && ((tm * 128) % TT) >= SEQ) continue;
        gemm_tile(A, lda, Bt, ldb, K, tm, tn, smem, epi);
    }
}

struct AttnArgs {
    const bf16_t* Q; int qs;
    const bf16_t* K; int ks;
    const bf16_t* K2; int k2s;
    const bf16_t* Vt;
    bf16_t* O; int os;
    int nkt; int kstart;
    float sc2;
    int na_r, na_rs; const float* rpb;
    float lam, oscale; const float* subln;
};

DEV unsigned cvt_pk_bf16(float lo, float hi) { return pk2(lo, hi); }
DEV float red_rows_sum(float p) {
    float a = p, b = p;
    asm volatile("s_nop 1\n\tv_permlane16_swap_b32 %0, %1" : "+v"(a), "+v"(b));
    const float q = a + b; a = q; b = q;
    asm volatile("s_nop 1\n\tv_permlane32_swap_b32 %0, %1" : "+v"(a), "+v"(b));
    return a + b;
}
DEV float vmax2(float a, float b) { float r; asm("v_max_f32 %0, %1, %2" : "=v"(r) : "v"(a), "v"(b)); return r; }
DEV float vmax3(float a, float b, float c) { float r; asm("v_max3_f32 %0, %1, %2, %3" : "=v"(r) : "v"(a), "v"(b), "v"(c)); return r; }
DEV float wave_sum_fast(float v) { return red_rows_sum(sum16(v)); }
DEV float red_rows_max(float p) {
    float a = p, b = p;
    asm volatile("s_nop 1\n\tv_permlane16_swap_b32 %0, %1" : "+v"(a), "+v"(b));
    const float q = fmaxf(a, b); a = q; b = q;
    asm volatile("s_nop 1\n\tv_permlane32_swap_b32 %0, %1" : "+v"(a), "+v"(b));
    return fmaxf(a, b);
}
template <int DQK, int NSUB, int MQ, bool NA>
DEV void attn_item(const AttnArgs& a, char* smem) {
    constexpr int KP = DQK + 8, KS = DQK / 32 / NSUB, KCH = DQK / 8, QR = 16 * MQ;
    const int tid = tid_(), lane = tid & 63, wid = tid >> 6, fr = lane & 15, fq = lane >> 4;
    bf16_t* Ksm = (bf16_t*)smem;
    bf16_t* Vsm = Ksm + 2 * 64 * KP;
    float* rpbs = (float*)(Vsm + 2 * 64 * GP);
    if (NA) { for (int i = tid; i < 465; i += NTHR) rpbs[i] = a.rpb[i] * 1.44269504f; }
    const int na_nlo = NA ? (max(16 * wid - 8, 0) >> 4) : 0, na_nhi = NA ? (min(16 * wid + 22, 63) >> 4) : 3;
    bf16x8 qf[MQ][DQK / 32];
#pragma unroll
    for (int mq = 0; mq < MQ; ++mq)
#pragma unroll
        for (int k = 0; k < DQK / 32; ++k) qf[mq][k] = *(const bf16x8*)(a.Q + (size_t)(wid * QR + mq * 16 + fr) * a.qs + k * 32 + fq * 8);
    f32x4 o[NSUB][MQ][4];
    float mrow[NSUB][MQ], lrow[NSUB][MQ];
#pragma unroll
    for (int sb = 0; sb < NSUB; ++sb)
#pragma unroll
        for (int mq = 0; mq < MQ; ++mq) {
            mrow[sb][mq] = -1e30f; lrow[sb][mq] = 0.f;
#pragma unroll
            for (int n = 0; n < 4; ++n) o[sb][mq][n] = (f32x4){0.f, 0.f, 0.f, 0.f};
        }
    constexpr int NKC = (64 * KCH + NTHR - 1) / NTHR;
    u32x4 rk[NKC], rv[2];
#define ATT_TSTART(kt) (NA ? ((kt) < 8 ? (a.na_rs + (kt)) * 64 : SEQ + ((kt) - 8) * 64) : a.kstart + (kt) * 64)
#define ATT_GLOAD(kt) do { const int _t0 = ATT_TSTART(kt); \
        _Pragma("unroll") for (int _i = 0; _i < NKC; ++_i) { const int _q = tid + _i * NTHR; if (_q < 64 * KCH) { const int _r = _q / KCH, _c = _q - _r * KCH; \
            rk[_i] = (_c < 8 || DQK == 64) ? *(const u32x4*)(a.K + (size_t)(_t0 + _r) * a.ks + _c * 8) : *(const u32x4*)(a.K2 + (size_t)(_t0 + _r) * a.k2s + (_c - 8) * 8); } } \
        _Pragma("unroll") for (int _i = 0; _i < 2; ++_i) { const int _q = tid + _i * NTHR, _r = _q >> 3, _c = _q & 7; rv[_i] = *(const u32x4*)(a.Vt + (size_t)_r * TT + _t0 + _c * 8); } } while (0)
#define ATT_LSTORE(buf) do { \
        _Pragma("unroll") for (int _i = 0; _i < NKC; ++_i) { const int _q = tid + _i * NTHR; if (_q < 64 * KCH) { const int _r = _q / KCH, _c = _q - _r * KCH; *(u32x4*)(Ksm + ((buf) * 64 + _r) * KP + _c * 8) = rk[_i]; } } \
        _Pragma("unroll") for (int _i = 0; _i < 2; ++_i) { const int _q = tid + _i * NTHR, _r = _q >> 3, _c = _q & 7; *(u32x4*)(Vsm + ((buf) * 64 + _r) * GP + _c * 8) = rv[_i]; } } while (0)
    ATT_GLOAD(0); ATT_LSTORE(0);
    __syncthreads();
    for (int kt = 0; kt < a.nkt; ++kt) {
        const int cur = kt & 1; const bool more = kt + 1 < a.nkt;
        if (more) ATT_GLOAD(kt + 1);
        const bool natile = NA && kt < 8;
        bf16x8 pb[NSUB][MQ][2];
#pragma unroll
        for (int sb = 0; sb < NSUB; ++sb) {
            f32x4 s[MQ][4];
#pragma unroll
            for (int k = 0; k < KS; ++k) {
                bf16x8 kb[4];
#pragma unroll
                for (int n = 0; n < 4; ++n) kb[n] = *(const bf16x8*)(Ksm + (cur * 64 + n * 16 + fr) * KP + (sb * KS + k) * 32 + fq * 8);
#pragma unroll
                for (int mq = 0; mq < MQ; ++mq)
#pragma unroll
                    for (int n = 0; n < 4; ++n) {
                        if (!natile || (n >= na_nlo && n <= na_nhi)) s[mq][n] = __builtin_amdgcn_mfma_f32_16x16x32_bf16(kb[n], qf[mq][sb * KS + k], k == 0 ? (f32x4){0.f, 0.f, 0.f, 0.f} : s[mq][n], 0, 0, 0);
                        else if (k == 0) s[mq][n] = (f32x4){0.f, 0.f, 0.f, 0.f};
                    }
            }
#pragma unroll
            for (int mq = 0; mq < MQ; ++mq) {
                float mx = -1e30f;
                if (natile) {
                    const int qc = wid * 16 + fr, cst = min(max(qc - 8, 0), 48), ro = a.na_rs + kt - a.na_r + 7;
                    const float* rrow = rpbs + ro * 31 + 15 - qc + fq * 4;
#pragma unroll
                    for (int n = 0; n < 4; ++n) {
                        if (n >= na_nlo && n <= na_nhi) {
#pragma unroll
                            for (int j = 0; j < 4; ++j) {
                                const int kc = n * 16 + fq * 4 + j;
                                const float x = (kc >= cst && kc < cst + 16) ? s[mq][n][j] * a.sc2 + rrow[n * 16 + j] : -1e30f;
                                s[mq][n][j] = x; mx = fmaxf(mx, x);
                            }
                        } else s[mq][n] = (f32x4){-1e30f, -1e30f, -1e30f, -1e30f};
                    }
                } else {
#pragma unroll
                    for (int n = 0; n < 4; ++n) { s[mq][n] = s[mq][n] * a.sc2; mx = fmaxf(fmaxf(mx, fmaxf(s[mq][n][0], s[mq][n][1])), fmaxf(s[mq][n][2], s[mq][n][3])); }
                }
                mx = red_rows_max(mx);
                const float mo = mrow[sb][mq], mn = fmaxf(mo, mx);
                const bool grow = __builtin_amdgcn_ballot_w64(mn > mo) != 0;
                mrow[sb][mq] = mn;
                float rsum = 0.f;
#pragma unroll
                for (int n = 0; n < 4; ++n) {
                    if (!natile || (n >= na_nlo && n <= na_nhi)) {
#pragma unroll
                        for (int j = 0; j < 4; ++j) { const float pv = __builtin_amdgcn_exp2f(s[mq][n][j] - mn); s[mq][n][j] = pv; rsum += pv; }
                    } else s[mq][n] = (f32x4){0.f, 0.f, 0.f, 0.f};
                }
                if (grow) {
                    const float alpha = __builtin_amdgcn_exp2f(mo - mn);
                    lrow[sb][mq] *= alpha;
#pragma unroll
                    for (int n = 0; n < 4; ++n) o[sb][mq][n] *= alpha;
                }
                lrow[sb][mq] += rsum;
#pragma unroll
                for (int k2 = 0; k2 < 2; ++k2) {
                    u32x4 w;
                    w.x = cvt_pk_bf16(s[mq][2 * k2][0], s[mq][2 * k2][1]); w.y = cvt_pk_bf16(s[mq][2 * k2][2], s[mq][2 * k2][3]);
                    w.z = cvt_pk_bf16(s[mq][2 * k2 + 1][0], s[mq][2 * k2 + 1][1]); w.w = cvt_pk_bf16(s[mq][2 * k2 + 1][2], s[mq][2 * k2 + 1][3]);
                    pb[sb][mq][k2] = __builtin_bit_cast(bf16x8, w);
                }
            }
        }
#pragma unroll
        for (int k2 = 0; k2 < 2; ++k2) {
            if (natile && (2 * k2 + 1 < na_nlo || 2 * k2 > na_nhi)) continue;
            bf16x8 va[4];
#pragma unroll
            for (int n = 0; n < 4; ++n) {
                const bf16_t* vp = Vsm + (cur * 64 + n * 16 + fr) * GP + 32 * k2 + fq * 4;
                u32x4 w; const u32x2 lo = *(const u32x2*)(vp), hi = *(const u32x2*)(vp + 16);
                w.x = lo.x; w.y = lo.y; w.z = hi.x; w.w = hi.y;
                va[n] = __builtin_bit_cast(bf16x8, w);
            }
#pragma unroll
            for (int sb = 0; sb < NSUB; ++sb)
#pragma unroll
                for (int mq = 0; mq < MQ; ++mq)
#pragma unroll
                    for (int n = 0; n < 4; ++n) o[sb][mq][n] = __builtin_amdgcn_mfma_f32_16x16x32_bf16(va[n], pb[sb][mq][k2], o[sb][mq][n], 0, 0, 0);
        }
        if (more) ATT_LSTORE(cur ^ 1);
        __syncthreads();
    }
#undef ATT_GLOAD
#undef ATT_LSTORE
#undef ATT_TSTART
#pragma unroll
    for (int mq = 0; mq < MQ; ++mq) {
        f32x4 v[4];
        if (NSUB == 1) {
            const float il = 1.f / red_rows_sum(lrow[0][mq]);
#pragma unroll
            for (int n = 0; n < 4; ++n) v[n] = o[0][mq][n] * il;
        } else {
            const float il0 = 1.f / red_rows_sum(lrow[0][mq]), il1 = a.lam / red_rows_sum(lrow[NSUB - 1][mq]);
            float ss = 0.f;
#pragma unroll
            for (int n = 0; n < 4; ++n) { v[n] = o[0][mq][n] * il0 - o[NSUB - 1][mq][n] * il1; ss += v[n][0] * v[n][0] + v[n][1] * v[n][1] + v[n][2] * v[n][2] + v[n][3] * v[n][3]; }
            ss = red_rows_sum(ss);
            const float rstd = rsqrtf(ss * (1.f / 64.f) + 1e-5f) * a.oscale;
#pragma unroll
            for (int n = 0; n < 4; ++n) v[n] = v[n] * rstd * *(const f32x4*)(a.subln + n * 16 + fq * 4);
        }
        bf16_t* op = a.O + (size_t)(wid * QR + mq * 16 + fr) * a.os + fq * 4;
#pragma unroll
        for (int n = 0; n < 4; ++n) { u32x2 w; w.x = cvt_pk_bf16(v[n][0], v[n][1]); w.y = cvt_pk_bf16(v[n][2], v[n][3]); *(u32x2*)(op + n * 16) = w; }
    }
    __syncthreads();
}

template <int N> DEV float rbc(float x) { return __builtin_bit_cast(float, __builtin_amdgcn_update_dpp(0, __builtin_bit_cast(int, x), 0x150 + N, 0xf, 0xf, true)); }
DEV float red_rows(float p) { return red_rows_sum(p); }
#define REP16(M) M(0) M(1) M(2) M(3) M(4) M(5) M(6) M(7) M(8) M(9) M(10) M(11) M(12) M(13) M(14) M(15)
DEV void scan_item(const bf16_t* SC, float* Y, int bl, int h, int dir, const float* k_a, char* smem) {
    const int tid = tid_(), lane = tid & 63, w = tid >> 6, ch = lane, sq = w;
    float* stg = (float*)smem;
    float* yb = stg + 2 * 16 * 6 * 64;
    const float ka = k_a[h * 64 + ch];
    unsigned short pre[4][6];
    float S[16];
#pragma unroll
    for (int j = 0; j < 16; ++j) S[j] = 0.f;
#define SC_TT(s) (dir == 0 ? ((s) < CTXL ? SEQ + (s) : (s) - CTXL) : ((s) < CTXL ? TT - 1 - (s) : SEQ - 1 - ((s) - CTXL)))
#define SC_GL(chunk) do { _Pragma("unroll") for (int _i = 0; _i < 4; ++_i) { const int _s = (chunk) * 16 + sq + 4 * _i; const int _tt = SC_TT(_s); \
        const bf16_t* _b = SC + ((size_t)(bl * TT + _tt)) * 2048 + h * 512 + ch; \
        pre[_i][0] = _b[0]; pre[_i][1] = _b[64]; pre[_i][2] = _b[128]; pre[_i][3] = _b[192]; pre[_i][4] = _b[(4 + dir) * 64]; pre[_i][5] = _b[(6 + dir) * 64]; } } while (0)
#define SC_ST(buf) do { _Pragma("unroll") for (int _i = 0; _i < 4; ++_i) { const int _st = sq + 4 * _i; \
        const float _r = bf2f(pre[_i][0]), _v = bf2f(pre[_i][1]), _k = bf2f(pre[_i][2]), _kk = bf2f(pre[_i][3]), _e = bf2f(pre[_i][4]), _sg = bf2f(pre[_i][5]); \
        float* _d = stg + (((buf) * 16 + _st) * 6) * 64 + ch; \
        _d[0] = -_kk; _d[64] = __expf(-_e); _d[128] = _kk * _sg; _d[192] = _k * (1.f + (_sg - 1.f) * ka); _d[256] = _r; _d[320] = _v; } } while (0)
    SC_GL(0); SC_ST(0);
    __syncthreads();
    constexpr int NCH = TT / 16;
    const int vrow = w * 16 + (lane & 15);
#define FMAC_BC(acc, x, sv, n) asm("v_fmac_f32_dpp %0, %1, %2 row_newbcast:" #n " row_mask:0xf bank_mask:0xf" : "+v"(acc) : "v"(x), "v"(sv))
#define MUL_BC(dst, x, sv, n) asm("v_mul_f32_dpp %0, %1, %2 row_newbcast:" #n " row_mask:0xf bank_mask:0xf" : "=v"(dst) : "v"(x), "v"(sv))
#define SC_LOAD(st_, A, W, B, K, R, V) do { const float* _dn = d0 + (st_) * 384; A = _dn[lane]; W = _dn[64 + lane]; B = _dn[128 + lane]; K = _dn[192 + lane]; R = _dn[256 + lane]; V = _dn[320 + vrow]; } while (0)
#define SA_(n) if ((n) & 1) FMAC_BC(p1, cA, S[n], n); else FMAC_BC(p0, cA, S[n], n);
#define UP_(n) { float t; MUL_BC(t, cW, S[n], n); FMAC_BC(t, cB, sa, n); FMAC_BC(t, cK, cV, n); S[n] = t; if ((n) & 1) FMAC_BC(y1, cR, t, n); else FMAC_BC(y0, cR, t, n); }
#define SC_STEP(st_, cA, cW, cB, cK, cR, cV) do { float p0 = 0.f, p1 = 0.f; REP16(SA_) const float sa = red_rows(p0 + p1); float y0 = 0.f, y1 = 0.f; REP16(UP_) \
        yb[((st_) * 4 + (lane >> 4)) * 64 + vrow] = y0 + y1; } while (0)
    for (int chunk = 0; chunk < NCH; ++chunk) {
        const int buf = chunk & 1;
        if (chunk + 1 < NCH) SC_GL(chunk + 1);
        const float* d0 = stg + (buf * 16 * 6) * 64;
        float a0, w0, b0, k0, r0, v0, a1, w1, b1, k1, r1, v1;
        SC_LOAD(0, a0, w0, b0, k0, r0, v0);
#pragma unroll
        for (int st = 0; st < 16; st += 2) {
            SC_LOAD(st + 1, a1, w1, b1, k1, r1, v1);
#define cA a0
#define cW w0
#define cB b0
#define cK k0
#define cR r0
#define cV v0
            SC_STEP(st, a0, w0, b0, k0, r0, v0);
#undef cA
#undef cW
#undef cB
#undef cK
#undef cR
#undef cV
            if (st + 2 < 16) SC_LOAD(st + 2, a0, w0, b0, k0, r0, v0);
#define cA a1
#define cW w1
#define cB b1
#define cK k1
#define cR r1
#define cV v1
            SC_STEP(st + 1, a1, w1, b1, k1, r1, v1);
#undef cA
#undef cW
#undef cB
#undef cK
#undef cR
#undef cV
        }
        __syncthreads();
#pragma unroll
        for (int i = 0; i < 4; ++i) {
            const int st = sq + 4 * i, s_ = chunk * 16 + st, tt = SC_TT(s_);
            ((bf16_t*)Y)[((size_t)dir * T_ALL + (size_t)bl * TT + tt) * 256 + h * 64 + ch] = f2bf((yb[(st * 4) * 64 + ch] + yb[(st * 4 + 1) * 64 + ch]) + (yb[(st * 4 + 2) * 64 + ch] + yb[(st * 4 + 3) * 64 + ch]));
        }
        if (chunk + 1 < NCH) SC_ST(buf ^ 1);
        __syncthreads();
    }
#undef SC_TT
#undef SC_GL
#undef SC_ST
#undef FMAC_BC
#undef MUL_BC
#undef SC_LOAD
#undef SA_
#undef UP_
#undef SC_STEP
}

DEV void phase_norm(const Params& p, int l, int which, bool skip_ctx) {
    const float* gam = p.in[which ? 5 : 4] + l * D;
    const float* mod = (const float*)(p.ws + OFF_MOD) + (size_t)l * 33 * 6144;
    bf16_t* H = (bf16_t*)(p.ws + OFF_H);
    const int lane = tid_() & 63, wave = blockIdx.x * 4 + (tid_() >> 6), nw = gridDim.x * 4;
    for (int g0 = wave; g0 < T_ALL; g0 += 2 * nw) {
        f32x4 v[2][4]; const float* m[2]; bool act[2];
#pragma unroll
        for (int u = 0; u < 2; ++u) {
            const int g = g0 + u * nw; act[u] = g < T_ALL;
            const int gg = act[u] ? g : g0;
            const int b = gg / TT, tt = gg - b * TT; const bool lat = tt < SEQ;
            if (!lat && skip_ctx) act[u] = false;
            const float* x = (l == 0 && which == 0) ? xrow_in(p, gg) : xrow(p, gg);
            m[u] = mod + (size_t)(lat ? b : 32) * 6144 + (which ? 3072 : 0);
#pragma unroll
            for (int i = 0; i < 4; ++i) v[u][i] = *(const f32x4*)(x + i * 256 + lane * 4);
        }
#pragma unroll
        for (int u = 0; u < 2; ++u) {
            float ss = 0.f;
#pragma unroll
            for (int i = 0; i < 4; ++i) ss += v[u][i][0] * v[u][i][0] + v[u][i][1] * v[u][i][1] + v[u][i][2] * v[u][i][2] + v[u][i][3] * v[u][i][3];
            ss = wave_sum_fast(ss);
            const float rstd = rsqrtf(ss * (1.f / 1024.f) + 1e-6f);
            if (act[u]) {
                const int g = g0 + u * nw;
#pragma unroll
                for (int i = 0; i < 4; ++i) {
                    const int col = i * 256 + lane * 4;
                    const f32x4 g4 = *(const f32x4*)(gam + col), sh = *(const f32x4*)(m[u] + col), sc = *(const f32x4*)(m[u] + 1024 + col);
                    const f32x4 o = v[u][i] * rstd * g4 * (sc + 1.f) + sh;
                    u32x2 w; w.x = pk2(o[0], o[1]); w.y = pk2(o[2], o[3]);
                    *(u32x2*)(H + (size_t)g * 1024 + col) = w;
                }
            }
        }
    }
}

DEV void phase_final(const Params& p) {
    const float* gam = p.in[32];
    const int lane = tid_() & 63, wave = blockIdx.x * 4 + (tid_() >> 6), nw = gridDim.x * 4;
    for (int g = wave; g < NBATCH * SEQ; g += nw) {
        float* x = p.out + (size_t)g * D;
        f32x4 v[4]; float ss = 0.f;
#pragma unroll
        for (int i = 0; i < 4; ++i) { v[i] = *(const f32x4*)(x + i * 256 + lane * 4); ss += v[i][0] * v[i][0] + v[i][1] * v[i][1] + v[i][2] * v[i][2] + v[i][3] * v[i][3]; }
        ss = wave_sum(ss);
        const float rstd = rsqrtf(ss * (1.f / 1024.f) + 1e-6f);
#pragma unroll
        for (int i = 0; i < 4; ++i) { const int col = i * 256 + lane * 4; *(f32x4*)(x + col) = v[i] * rstd * *(const f32x4*)(gam + col); }
    }
}

DEV void phase_prep(const Params& p, int l, int c) {
    char* scr = p.ws + OFF_SCR;
    const bf16_t* ZR = (const bf16_t*)(scr + SO_ZR);
    bf16_t* SC = (bf16_t*)(scr + SO_SC) + (size_t)c * TC * 2048; bf16_t* AWA = (bf16_t*)(scr + SO_AWA); bf16_t* AG = (bf16_t*)(scr + SO_AG) + (size_t)c * TC * 64;
    float* rsq = (float*)(p.ws + OFF_RSQ); float* rskv = (float*)(p.ws + OFF_RSKV);
    const float* mu0 = p.in[15] + (size_t)l * 2 * 896; const float* mu1 = mu0 + 896;
    const int lane = tid_() & 63, wave = blockIdx.x * 4 + (tid_() >> 6), nw = gridDim.x * 4;
    f32x4 m0[3], m1[3];
#pragma unroll
    for (int s3 = 0; s3 < 3; ++s3) { m0[s3] = *(const f32x4*)(mu0 + s3 * 256 + lane * 4); m1[s3] = *(const f32x4*)(mu1 + s3 * 256 + lane * 4); }
    const f32x4 kk4 = *(const f32x4*)(p.in[21] + l * 256 + lane * 4);
    const float mw0 = mu0[768 + lane], mw1 = mu1[768 + lane], mg0 = mu0[832 + lane], mg1 = mu1[832 + lane];
    for (int t0 = wave; t0 < TC; t0 += 2 * nw) {
        u32x2 q[2], c0[2][3], cp[2][3], cn[2][3]; unsigned kv[2]; bf16_t wz[2][3], gz[2][3]; bool act[2], hp[2], hn[2];
#pragma unroll
        for (int u = 0; u < 2; ++u) {
            const int t = t0 + u * nw; act[u] = t < TC;
            const int ts = act[u] ? t : t0, tt = ts % TT;
            hp[u] = !(tt == 0 || tt == SEQ); hn[u] = !(tt == SEQ - 1 || tt == TT - 1);
            const bf16_t* z = ZR + (size_t)ts * ZRW;
            const bf16_t* zp = hp[u] ? z - ZRW : z; const bf16_t* zn = hn[u] ? z + ZRW : z;
            q[u] = *(const u32x2*)(z + 768 + lane * 4); kv[u] = *(const unsigned*)(z + 1024 + lane * 2);
#pragma unroll
            for (int s3 = 0; s3 < 3; ++s3) { const int col = s3 * 256 + lane * 4; c0[u][s3] = *(const u32x2*)(z + col); cp[u][s3] = *(const u32x2*)(zp + col); cn[u][s3] = *(const u32x2*)(zn + col); }
            wz[u][0] = z[1184 + lane]; wz[u][1] = zp[1184 + lane]; wz[u][2] = zn[1184 + lane];
            gz[u][0] = z[1280 + lane]; gz[u][1] = zp[1280 + lane]; gz[u][2] = zn[1280 + lane];
        }
#pragma unroll
        for (int u = 0; u < 2; ++u) {
            const int t = t0 + u * nw;
            const float fp = hp[u] ? 1.f : 0.f, fn = hn[u] ? 1.f : 0.f;
            float s = lo_bf(q[u].x) * lo_bf(q[u].x) + hi_bf(q[u].x) * hi_bf(q[u].x) + lo_bf(q[u].y) * lo_bf(q[u].y) + hi_bf(q[u].y) * hi_bf(q[u].y);
            s = wave_sum_fast(s);
            float s2 = lo_bf(kv[u]) * lo_bf(kv[u]) + hi_bf(kv[u]) * hi_bf(kv[u]);
            s2 = wave_sum_fast(s2);
            float zs[3][4];
#pragma unroll
            for (int s3 = 0; s3 < 3; ++s3) {
                const float zc[4] = {lo_bf(c0[u][s3].x), hi_bf(c0[u][s3].x), lo_bf(c0[u][s3].y), hi_bf(c0[u][s3].y)};
                const float zp[4] = {lo_bf(cp[u][s3].x) * fp, hi_bf(cp[u][s3].x) * fp, lo_bf(cp[u][s3].y) * fp, hi_bf(cp[u][s3].y) * fp};
                const float zn[4] = {lo_bf(cn[u][s3].x) * fn, hi_bf(cn[u][s3].x) * fn, lo_bf(cn[u][s3].y) * fn, hi_bf(cn[u][s3].y) * fn};
#pragma unroll
                for (int i = 0; i < 4; ++i) zs[s3][i] = zc[i] + m0[s3][i] * (zp[i] - zc[i]) + m1[s3][i] * (zn[i] - zc[i]);
            }
            float kk[4]; float ss = 0.f;
#pragma unroll
            for (int i = 0; i < 4; ++i) { kk[i] = zs[1][i] * kk4[i]; ss += kk[i] * kk[i]; }
            ss = sum16(ss);
            const float inv = rsqrtf(fmaxf(ss, 1e-24f));
            float vw, vg;
            { const float zc = bf2f(wz[u][0]), zp = bf2f(wz[u][1]) * fp, zn = bf2f(wz[u][2]) * fn; vw = zc + mw0 * (zp - zc) + mw1 * (zn - zc); }
            { const float zc = bf2f(gz[u][0]), zp = bf2f(gz[u][1]) * fp, zn = bf2f(gz[u][2]) * fn; vg = zc + mg0 * (zp - zc) + mg1 * (zn - zc); }
            if (act[u]) {
                if (lane == 0) { rsq[t] = rsqrtf(s * (1.f / 256.f) + 1e-6f); rskv[t] = rsqrtf(s2 * (1.f / 128.f) + 1e-6f); }
                const int h = lane >> 4, j = (lane & 15) * 4;
                bf16_t* sc = SC + (size_t)t * 2048 + h * 512 + j;
                u32x2 w;
                w.x = pk2(zs[0][0], zs[0][1]); w.y = pk2(zs[0][2], zs[0][3]); *(u32x2*)(sc) = w;
                w.x = pk2(zs[2][0], zs[2][1]); w.y = pk2(zs[2][2], zs[2][3]); *(u32x2*)(sc + 64) = w;
                w.x = pk2(zs[1][0], zs[1][1]); w.y = pk2(zs[1][2], zs[1][3]); *(u32x2*)(sc + 128) = w;
                w.x = pk2(kk[0] * inv, kk[1] * inv); w.y = pk2(kk[2] * inv, kk[3] * inv); *(u32x2*)(sc + 192) = w;
                AWA[(size_t)t * 64 + lane] = f2bf(lane < 32 ? 2.f * sigmoidf_(2.f * vw) - 1.f : vw);
                AG[(size_t)t * 64 + lane] = f2bf(sigmoidf_(vg));
            }
        }
    }
}

DEV void phase_gemm_small(const Params& p, int l, int c, char* smem) {
    char* scr = p.ws + OFF_SCR;
    const bf16_t* ZR = (const bf16_t*)(scr + SO_ZR);
    const float* cosT = (const float*)(p.ws + OFF_COS); const float* sinT = (const float*)(p.ws + OFF_SIN);
    EpiUQ euq{(bf16_t*)(scr + SO_MQ), (const float*)(p.ws + OFF_RSQ), cosT, sinT};
    EpiUKV eukv{(bf16_t*)(scr + SO_KN), (bf16_t*)(scr + SO_VTM), (const float*)(p.ws + OFF_RSKV)};
    EpiWA ewa{(bf16_t*)(scr + SO_SC) + (size_t)c * TC * 2048, p.in[16] + (size_t)l * 512, p.in[18] + (size_t)l * 512};
    constexpr int NTM = TC / 128;
    constexpr int T1 = NTM * 3, T2 = T1 + NTM * 4, T3 = T2 + NTM * 8;
    for (int t = blockIdx.x; t < T3; t += gridDim.x) {
        if (t < T1) { const int tm = t / 3, tn = t - tm * 3; gemm_tile(ZR + 768, ZRW, wl(p, l, WE_UQ), 256, 256, tm, tn, smem, euq); }
        else if (t < T2) { const int u = t - T1, tm = u >> 2, tn = u & 3; gemm_tile(ZR + 1024, ZRW, wl(p, l, WE_UKV), 128, 128, tm, tn, smem, eukv); }
        else { const int u = t - T2, tm = u >> 3, tn = u & 7; gemm_tile((const bf16_t*)(scr + SO_AWA), 64, wl(p, l, WE_WA), 64, 64, tm, tn, smem, ewa); }
    }
}

DEV void phase_mix(const Params& p, int l, int c, int phase_idx, char* smem, int rmask, int* s_item) {
    char* scr = p.ws + OFF_SCR;
    const bf16_t* QK = (const bf16_t*)(scr + SO_QK); const bf16_t* ZR = (const bf16_t*)(scr + SO_ZR);
    const bf16_t* MQ = (const bf16_t*)(scr + SO_MQ); const bf16_t* KN = (const bf16_t*)(scr + SO_KN);
    const bf16_t* VtNA = (const bf16_t*)(scr + SO_VTNA); const bf16_t* VtD = (const bf16_t*)(scr + SO_VTD); const bf16_t* VtM = (const bf16_t*)(scr + SO_VTM);
    bf16_t* MIX = (bf16_t*)(p.ws + OFF_H) + (size_t)c * TC * 1024;
    int* ctr = (int*)(p.ws + OFF_CTR) + phase_idx;
    const bool need_ctx = l < DEPTH - 1;
    const float lam = ((const float*)(p.ws + OFF_LAM))[l];
    const float lam_init = 0.8f - 0.6f * expf(-0.3f * (float)l);
    constexpr int DQ = 64 * DMQ, DLT = SEQ / DQ, DCT = CTXL / DQ;
    const int N_SCAN = (c == NCHUNK - 1) ? NBATCH * 8 : 0; constexpr int N_ML = CB * 64, N_DL = CB * 4 * DLT, N_NL = CB * 128, N_MC = CB * 8, N_DC = CB * 4 * DCT, N_NC = CB * 16;
    const int E0 = N_SCAN, E1 = E0 + N_ML, E2 = E1 + N_DL, E3 = E2 + N_NL, E4 = E3 + N_MC, E5 = E4 + N_DC, E6 = E5 + N_NC;
    const int total = need_ctx ? E6 : E3;
    constexpr float L2E = 1.44269504f;
    if (rmask & 1) for (int it = blockIdx.x; it < N_SCAN; it += gridDim.x) {
        const int bl = it >> 3, h = (it >> 1) & 3, dir = it & 1;
        __builtin_amdgcn_s_setprio(3);
        scan_item((const bf16_t*)(scr + SO_SC), (float*)(scr + SO_Y), bl, h, dir, p.in[22] + l * 256, smem);
        __builtin_amdgcn_s_setprio(0);
    }
    for (;;) {
        if (tid_() == 0) *s_item = E0 + atomicAdd(ctr, 1);
        __syncthreads();
        const int it = __builtin_amdgcn_readfirstlane(*s_item);
        __syncthreads();
        if (it >= total) break;
        if (!(rmask & 2)) continue;
        AttnArgs a{};
        if (it < E0) {
        } else if (it < E1 || (it >= E3 && it < E4)) {
            const bool cx = it >= E3; int bl, h, q0;
            if (!cx) { const int u = it - E0; bl = u >> 6; h = (u >> 4) & 3; q0 = (u & 15) * 128; }
            else { const int u = it - E3; bl = u >> 3; h = (u >> 1) & 3; q0 = SEQ + (u & 1) * 128; }
            const size_t tb = (size_t)bl * TT;
            a.Q = MQ + (tb + q0) * 384 + h * 96; a.qs = 384;
            a.K = KN + tb * 256 + h * 64; a.ks = 256; a.K2 = ZR + tb * ZRW + 1152; a.k2s = ZRW;
            a.Vt = VtM + ((size_t)(bl * 4 + h) * 64) * TT;
            a.O = MIX + (tb + q0) * 1024 + 256 + h * 64; a.os = 1024;
            a.kstart = cx ? SEQ : 0; a.nkt = cx ? 4 : 36; a.sc2 = 0.10206207261596575f * L2E;
            if (MIXMASK & 2) attn_item<96, 1, 2, false>(a, smem);
        } else if (it < E2 || (it >= E4 && it < E5)) {
            const bool cx = it >= E4; int bl, h, q0;
            if (!cx) { const int u = it - E1; bl = u / (4 * DLT); h = (u / DLT) & 3; q0 = (u % DLT) * DQ; }
            else { const int u = it - E4; bl = u / (4 * DCT); h = (u / DCT) & 3; q0 = SEQ + (u % DCT) * DQ; }
            const size_t tb = (size_t)bl * TT;
            a.Q = QK + (tb + q0) * 1024 + 512 + h * 64; a.qs = 1024;
            a.K = QK + tb * 1024 + 768 + h * 64; a.ks = 1024;
            a.Vt = VtD + ((size_t)(bl * 4 + h) * 64) * TT;
            a.O = MIX + (tb + q0) * 1024 + 768 + h * 64; a.os = 1024;
            a.kstart = cx ? SEQ : 0; a.nkt = cx ? 4 : 36; a.sc2 = 0.17677669529663687f * L2E;
            a.lam = lam; a.oscale = 1.f - lam_init; a.subln = p.in[27] + l * 64;
            if (MIXMASK & 4) attn_item<64, 2, DMQ, false>(a, smem);
        } else {
            const bool cx = it >= E5; int bl, h, q0;
            if (!cx) { const int u = it - E2; bl = u >> 7; h = (u >> 5) & 3; const int r = u & 31; q0 = r * 64; a.na_r = r; a.na_rs = min(max(r - 4, 0), 24); }
            else { const int u = it - E5; bl = u >> 4; h = (u >> 2) & 3; q0 = SEQ + (u & 3) * 64; }
            const size_t tb = (size_t)bl * TT;
            a.Q = QK + (tb + q0) * 1024 + h * 64; a.qs = 1024;
            a.K = QK + tb * 1024 + 256 + h * 64; a.ks = 1024;
            a.Vt = VtNA + ((size_t)(bl * 4 + h) * 64) * TT;
            a.O = MIX + (tb + q0) * 1024 + h * 64; a.os = 1024;
            a.sc2 = 0.125f * L2E; a.rpb = p.in[10] + ((size_t)l * 4 + h) * 465;
            if (!cx) { a.nkt = 12; if (MIXMASK & 8) attn_item<64, 1, 1, true>(a, smem); }
            else { a.kstart = SEQ; a.nkt = 4; if (MIXMASK & 16) attn_item<64, 1, 1, false>(a, smem); }
        }
    }
}

DEV void phase_fix(const Params& p, int l) {
    char* scr = p.ws + OFF_SCR;
    bf16_t* G = (bf16_t*)(scr + SO_G); const float* E = (const float*)(scr + SO_E);
    const float* cw = p.in[29] + (size_t)l * 3 * DFF;
    const bool skip_ctx = !(l < DEPTH - 1);
    constexpr int NTM = T_ALL / 128;
    const int total = NTM * (DFF / 4);
    for (int idx = blockIdx.x * NTHR + tid_(); idx < total; idx += gridDim.x * NTHR) {
        const int tm = idx / (DFF / 4), j = (idx - tm * (DFF / 4)) * 4;
        const int row0 = tm * 128, tt0 = row0 % TT;
        if (skip_ctx && tt0 >= SEQ) continue;
        const bool first = (tt0 == 0 || tt0 == SEQ), last = (tt0 + 127 == SEQ - 1 || tt0 + 127 == TT - 1);
        if (!first) {
            const float* e = E + ((size_t)tm * 6) * DFF + j; const float* ep = E + ((size_t)(tm - 1) * 6 + 5) * DFF + j;
            const f32x4 pre = *(const f32x4*)(e) + *(const f32x4*)(cw + j) * *(const f32x4*)(ep), bv = *(const f32x4*)(e + DFF);
            u32x2 w; w.x = pk2(siluf_(pre[0]) * bv[0], siluf_(pre[1]) * bv[1]); w.y = pk2(siluf_(pre[2]) * bv[2], siluf_(pre[3]) * bv[3]);
            *(u32x2*)(G + (size_t)row0 * DFF + j) = w;
        }
        if (!last) {
            const float* e = E + ((size_t)tm * 6 + 3) * DFF + j; const float* en = E + ((size_t)(tm + 1) * 6 + 2) * DFF + j;
            const f32x4 pre = *(const f32x4*)(e) + *(const f32x4*)(cw + 2 * DFF + j) * *(const f32x4*)(en), bv = *(const f32x4*)(e + DFF);
            u32x2 w; w.x = pk2(siluf_(pre[0]) * bv[0], siluf_(pre[1]) * bv[1]); w.y = pk2(siluf_(pre[2]) * bv[2], siluf_(pre[3]) * bv[3]);
            *(u32x2*)(G + (size_t)(row0 + 127) * DFF + j) = w;
        }
    }
}

DEV int cm_in(int n) {
    if (n < 768) return n;
    if (n < 1536) return 2080 + (n - 768);
    if (n < 2304) return 1184 + (n - 1536);
    if (n < 2560) return 768 + (n - 2304);
    if (n < 2688) return 1024 + (n - 2560);
    if (n < 2816) { const int o = n - 2688; return o < 32 ? 1152 + o : (o < 64 ? 1952 + (o - 32) : (o < 96 ? 1984 + (o - 64) : -1)); }
    { const int o = n - 2816; return o < 64 ? 2016 + o : -1; }
}
DEV int cm_up(int n) { const int t = n >> 7, o = n & 127; return o < 64 ? t * 64 + o : DFF + t * 64 + (o - 64); }

template <int MODE>
DEV void conv_unit(const float* src, int lds_, bf16_t* dst, int K, int nt, int kt, float* tile) {
    const int tid = tid_(), a = tid & 63, b = tid >> 6;
    const int n = nt * 64 + a;
    const int col = MODE == 0 ? cm_in(n) : (MODE == 2 ? cm_up(n) : n);
#pragma unroll 4
    for (int i = 0; i < 16; ++i) { const int kl = b + 4 * i; tile[kl * 65 + a] = col >= 0 ? src[(size_t)(kt * 64 + kl) * lds_ + col] : 0.f; }
    __syncthreads();
#pragma unroll 4
    for (int i = 0; i < 16; ++i) { const int nl = b + 4 * i; dst[(size_t)(nt * 64 + nl) * K + kt * 64 + a] = f2bf(tile[a * 65 + nl]); }
    __syncthreads();
}

DEV void phase_prologue(const Params& p, char* smem) {
    const int tid = tid_(), gtid = blockIdx.x * NTHR + tid, gsz = gridDim.x * NTHR;
    if (blockIdx.x == 0) {
        int* ctr = (int*)(p.ws + OFF_CTR); ctr[tid] = 0;
        if (tid < DEPTH) {
            const float* lp = p.in[26] + tid * 128; float s0 = 0.f, s1 = 0.f;
            for (int i = 0; i < 32; ++i) { s0 += lp[i] * lp[32 + i]; s1 += lp[64 + i] * lp[96 + i]; }
            ((float*)(p.ws + OFF_LAM))[tid] = expf(s0) - expf(s1) + (0.8f - 0.6f * expf(-0.3f * (float)tid));
        }
    }
    for (int i = gtid; i < 2048 * 16; i += gsz) {
        const int tt = i >> 4, f = i & 15; const float pos = (float)(f < 8 ? tt / 64 : tt % 64);
        const float freq = powf(10000.f, -(float)(f & 7) / 8.f); const float ang = pos * freq;
        ((float*)(p.ws + OFF_COS))[i] = cosf(ang); ((float*)(p.ws + OFF_SIN))[i] = sinf(ang);
    }
    for (int i = gtid; i < DEPTH * 245760; i += gsz) {
        const int l = i / 245760; int e = i - l * 245760;
        if (e < 98304) { const int n = e >> 8, k = e & 255; wlw(p, l, WE_UQ)[e] = f2bf(p.in[13][((size_t)l * 256 + k) * 384 + n] * p.in[11][l * 256 + k]); }
        else if ((e -= 98304) < 65536) { const int n = e >> 7, k = e & 127; wlw(p, l, WE_UKV)[e] = f2bf(p.in[14][((size_t)l * 128 + k) * 512 + n] * p.in[12][l * 128 + k]); }
        else if ((e -= 65536) < 65536) { const int n = e >> 6, k = e & 63, seg = n >> 8, ch = n & 255; float v = 0.f;
            if (seg < 2) { if (k < 32) v = p.in[17][(((size_t)l * 2 + seg) * 32 + k) * 256 + ch]; }
            else { if (k >= 32) v = p.in[19][(((size_t)l * 2 + (seg - 2)) * 32 + (k - 32)) * 256 + ch]; }
            wlw(p, l, WE_WA)[e] = f2bf(v); }
        else { e -= 65536; const int n = e >> 6, k = e & 63; wlw(p, l, WE_G)[e] = f2bf(p.in[20][((size_t)l * 64 + k) * 256 + n]); }
    }
    {
        constexpr int U_IN = (ZN / 64) * 16, U_OUT = 16 * 16, U_UP = 88 * 16, U_DN = 16 * 44, U_L = U_IN + U_OUT + U_UP + U_DN;
        float* tile = (float*)smem;
        for (int u = blockIdx.x; u < DEPTH * U_L; u += gridDim.x) {
            const int l = u / U_L; int e = u - l * U_L;
            if (e < U_IN) conv_unit<0>(p.in[8] + (size_t)l * 1024 * 2848, 2848, wlw(p, l, WE_IN), 1024, e >> 4, e & 15, tile);
            else if ((e -= U_IN) < U_OUT) conv_unit<1>(p.in[9] + (size_t)l * 1024 * 1024, 1024, wlw(p, l, WE_OUT), 1024, e >> 4, e & 15, tile);
            else if ((e -= U_OUT) < U_UP) conv_unit<2>(p.in[28] + (size_t)l * 1024 * 5632, 5632, wlw(p, l, WE_UP), 1024, e >> 4, e & 15, tile);
            else { e -= U_UP; conv_unit<1>(p.in[31] + (size_t)l * 2816 * 1024, 1024, wlw(p, l, WE_DOWN), 2816, e / 44, e % 44, tile); }
        }
    }
    {
        float* Ssm = (float*)smem;
        float* red = Ssm + 33 * 128;
        const int lane = tid & 63, w = tid >> 6;
        for (int u = blockIdx.x; u < DEPTH * 96; u += gridDim.x) {
            const int l = u / 96, n0 = (u - l * 96) * 64;
            const float* W = p.in[6] + (size_t)l * 1024 * 6144 + n0 + lane;
            float acc[33];
#pragma unroll
            for (int r = 0; r < 33; ++r) acc[r] = 0.f;
            for (int kc = 0; kc < 8; ++kc) {
                __syncthreads();
                for (int i = tid; i < 33 * 128; i += NTHR) { const int r = i >> 7, k = kc * 128 + (i & 127); const float cv = r < 32 ? p.in[1][r * 1024 + k] : p.in[3][k]; Ssm[i] = siluf_(cv); }
                __syncthreads();
                for (int kk = 0; kk < 32; ++kk) {
                    const int kl = w * 32 + kk; const float wv = W[(size_t)(kc * 128 + kl) * 6144];
#pragma unroll
                    for (int r = 0; r < 33; ++r) acc[r] += Ssm[r * 128 + kl] * wv;
                }
            }
#pragma unroll
            for (int r = 0; r < 33; ++r) red[(w * 33 + r) * 64 + lane] = acc[r];
            __syncthreads();
            for (int i = tid; i < 33 * 64; i += NTHR) {
                const int r = i >> 6, n = i & 63;
                const float v = red[(0 * 33 + r) * 64 + n] + red[(1 * 33 + r) * 64 + n] + red[(2 * 33 + r) * 64 + n] + red[(3 * 33 + r) * 64 + n];
                ((float*)(p.ws + OFF_MOD))[((size_t)l * 33 + r) * 6144 + n0 + n] = v + p.in[7][(size_t)l * 6144 + n0 + n];
            }
            __syncthreads();
        }
    }
}

constexpr int PH_PER_LAYER = 15, N_PHASES = 2 + DEPTH * PH_PER_LAYER;

DEV void run_phase(const Params& p, int ph, char* smem, int ctr_off, int* s_item) {
    if (ph == 0) { phase_prologue(p, smem); return; }
    if (ph == N_PHASES - 1) { phase_final(p); return; }
    const int l = (ph - 1) / PH_PER_LAYER, s = (ph - 1) % PH_PER_LAYER;
    const bool last_layer = (l == DEPTH - 1);
    char* scr = p.ws + OFF_SCR;
    const float* mod = (const float*)(p.ws + OFF_MOD) + (size_t)l * 33 * 6144;
    const bf16_t* H = (const bf16_t*)(p.ws + OFF_H);
    if (s == 0) { phase_norm(p, l, 0, false); return; }
    if (s >= 1 && s <= 8) {
        const int c = (s - 1) / 4, q = (s - 1) % 4;
        if (q == 0) {
            EpiIn e{(bf16_t*)(scr + SO_QK), (bf16_t*)(scr + SO_ZR), (bf16_t*)(scr + SO_VTNA), (bf16_t*)(scr + SO_VTD), (const float*)(p.ws + OFF_COS), (const float*)(p.ws + OFF_SIN)};
            gemm_phase(H + (size_t)c * TC * 1024, 1024, wl(p, l, WE_IN), 1024, 1024, TC / 128, ZN / 128, false, smem, e);
        } else if (q == 1) phase_prep(p, l, c);
        else if (q == 2) phase_gemm_small(p, l, c, smem);
        else phase_mix(p, l, c, ph + ctr_off, smem, ctr_off ? PROBE_MIXSEL : 3, s_item);
        return;
    }
    if (s == 9) {
        EpiG e{(bf16_t*)(p.ws + OFF_H), (const bf16_t*)(scr + SO_SC), (const float*)(scr + SO_Y), p.in[23] + l * 256, p.in[24] + l * 256, p.in[25] + l * 256, 0};
        gemm_phase((const bf16_t*)(scr + SO_AG), 64, wl(p, l, WE_G), 64, 64, T_ALL / 128, 2, last_layer, smem, e);
        return;
    }
    if (s == 10) { EpiRes e{&p, mod, 2048, l == 0 ? 1 : 0}; gemm_phase(H, 1024, wl(p, l, WE_OUT), 1024, 1024, T_ALL / 128, 8, last_layer, smem, e); return; }
    if (s == 11) { phase_norm(p, l, 1, last_layer); return; }
    if (s == 12) { EpiUp e{(bf16_t*)(scr + SO_G), (float*)(scr + SO_E), p.in[29] + (size_t)l * 3 * DFF, p.in[30] + (size_t)l * DFF};
                   gemm_phase(H, 1024, wl(p, l, WE_UP), 1024, 1024, T_ALL / 128, 44, last_layer, smem, e); return; }
    if (s == 13) { phase_fix(p, l); return; }
    { EpiRes e{&p, mod, 5120, 0}; gemm_phase((const bf16_t*)(scr + SO_G), DFF, wl(p, l, WE_DOWN), DFF, DFF, T_ALL / 128, 8, last_layer, smem, e); }
}

#define XB_TMO      128
#define XB_XCNT(j)  (256  + 64 * (j))
#define XB_XSUB(j)  (1280 + 64 * (j))
#define XB_XGEN(j)  (2304 + 64 * (j))
#define XB_TOP      3328
#define XB_TOPGEN   3392
#define XCD_BAR_WORDS 3456
#define XB_SPIN_CAP (1u << 18)

__device__ __forceinline__ unsigned xb_ld(unsigned* p)              { return __hip_atomic_load(p, __ATOMIC_RELAXED, __HIP_MEMORY_SCOPE_AGENT); }
__device__ __forceinline__ unsigned xb_add(unsigned* p, unsigned v) { return __hip_atomic_fetch_add(p, v, __ATOMIC_RELAXED, __HIP_MEMORY_SCOPE_AGENT); }
__device__ __forceinline__ unsigned xb_xcc_id() { return (unsigned)__builtin_amdgcn_s_getreg((3 << 11) | 20) & 0xFu; }
#define XB_SPIN(cond, bar) do { unsigned _sp = 0; while (cond) { __builtin_amdgcn_s_sleep(1); \
    if ((++_sp & 255u) == 0u) { if (xb_ld(&(bar)[XB_TMO])) break; if (_sp > XB_SPIN_CAP) { atomicAdd(&(bar)[XB_TMO], 1u); break; } } } } while (0)

struct XcdBarrier {
    unsigned* bar; unsigned x;
    volatile LAS unsigned* st;
};

__device__ __forceinline__ XcdBarrier xcd_barrier_post(unsigned* bar, volatile LAS unsigned* st) {
    XcdBarrier b; b.bar = bar; b.x = xb_xcc_id(); b.st = st;
    if (threadIdx.x == 0) (void)xb_add(&bar[XB_XCNT(b.x)], 1u);
    return b;
}
__device__ __forceinline__ void xcd_barrier_complete(unsigned* bar, unsigned x, unsigned& nloc, unsigned& nx) {
    const unsigned G = gridDim.x * gridDim.y * gridDim.z;
    unsigned sum, cnt, mine, sp = 0u;
    for (;;) {
        sum = 0u; cnt = 0u; mine = 0u;
#pragma unroll
        for (unsigned j = 0; j < 16; ++j) { const unsigned c = xb_ld(&bar[XB_XCNT(j)]); sum += c; cnt += (c > 0u) ? 1u : 0u; mine = (j == x) ? c : mine; }
        if (sum == G) break;
        __builtin_amdgcn_s_sleep(1);
        if ((++sp & 255u) == 0u) { if (xb_ld(&bar[XB_TMO])) break; if (sp > XB_SPIN_CAP) { atomicAdd(&bar[XB_TMO], 1u); break; } }
    }
    nloc = mine > 0u ? mine : 1u; nx = cnt > 0u ? cnt : 1u;
}

__device__ __forceinline__ void xcd_barrier(const XcdBarrier& b) {
    asm volatile("s_waitcnt vmcnt(0)" ::: "memory");
    __syncthreads();
    if (threadIdx.x == 0) {
        unsigned* bar = b.bar;
        __builtin_amdgcn_s_waitcnt(0);
        unsigned nloc = b.st[0], nx = b.st[1];
        if (nloc == 0u) { xcd_barrier_complete(bar, b.x, nloc, nx); b.st[0] = nloc; b.st[1] = nx; }
        const unsigned old = xb_add(&bar[XB_XSUB(b.x)], 1u);
        const unsigned gen = old / nloc;
        if (old + 1u == (gen + 1u) * nloc) {
            __builtin_amdgcn_fence(__ATOMIC_RELEASE, "agent");
            asm volatile("s_waitcnt vmcnt(0)" ::: "memory");
            const unsigned og = xb_add(&bar[XB_TOP], 1u);
            const unsigned tg = og / nx;
            if (og + 1u == (tg + 1u) * nx) xb_add(&bar[XB_TOPGEN], 1u);
            else XB_SPIN(xb_ld(&bar[XB_TOPGEN]) == tg, bar);
            __builtin_amdgcn_fence(__ATOMIC_ACQUIRE, "agent");
            xb_add(&bar[XB_XGEN(b.x)], 1u);
            asm volatile("s_waitcnt vmcnt(0)" ::: "memory");
        } else {
            XB_SPIN(xb_ld(&bar[XB_XGEN(b.x)]) == gen, bar);
            __builtin_amdgcn_fence(__ATOMIC_ACQUIRE, "agent");
            asm volatile("s_waitcnt vmcnt(0)" ::: "memory");
        }
    }
    __syncthreads();
}


__global__ void __launch_bounds__(NTHR, 2) mk_fwd(Params p, int ph_lo, int ph_hi) {
    extern __shared__ __attribute__((aligned(16))) char smem[];
    __shared__ uint4 s_ctl;
    if (threadIdx.x == 0) s_ctl = make_uint4(0u, 0u, 0u, 0u);
    __syncthreads();
    XcdBarrier xb = xcd_barrier_post((unsigned*)(p.ws + OFF_XBAR), (volatile LAS unsigned*)&s_ctl);
    int* s_item = (int*)&s_ctl + 2;
    for (int ph = ph_lo; ph <= ph_hi; ++ph) {
        run_phase(p, ph, smem, 0, s_item);
#ifdef PROBE_DUP
        if (ph > 0 && ph < N_PHASES - 1) {
            const int s_ = (ph - 1) % PH_PER_LAYER, q_ = (s_ >= 1 && s_ <= 8) ? (s_ - 1) % 4 : -1;
            bool dup = false;
            if ((PROBE_DUP & 1) && (q_ == 0)) dup = true;
            if ((PROBE_DUP & 2) && (s_ == 12)) dup = true;
            if ((PROBE_DUP & 4) && (q_ == 3)) dup = true;
            if ((PROBE_DUP & 8) && (q_ == 2 || s_ == 9)) dup = true;
            if ((PROBE_DUP & 16) && (s_ == 0 || s_ == 11 || q_ == 1 || s_ == 13)) dup = true;
            if (dup) run_phase(p, ph, smem, 100, s_item);
        }
#endif
        if (ph < ph_hi) {
            if (ph_lo < 0) cg::this_grid().sync();
            xcd_barrier(xb);
        }
    }
}

extern "C" void kernel_launch(void* const* d_in, const int* in_sizes, int n_in, void* d_out, int out_size, void* d_ws, size_t ws_size, hipStream_t stream) {
    static int grid = 0;
    if (grid == 0) {
        if (n_in != 33 || ws_size < WS_NEED) { fprintf(stderr, "kernel_launch: n_in %d ws %zu need %zu\n", n_in, ws_size, (size_t)WS_NEED); grid = -1; return; }
        int dev = 0, cus = 0, per_cu = 0;
        hipGetDevice(&dev);
        hipDeviceGetAttribute(&cus, hipDeviceAttributeMultiprocessorCount, dev);
        if (hipFuncSetAttribute((const void*)mk_fwd, hipFuncAttributeMaxDynamicSharedMemorySize, LDS_BYTES) != hipSuccess) { fprintf(stderr, "hipFuncSetAttribute failed\n"); grid = -1; return; }
        if (hipOccupancyMaxActiveBlocksPerMultiprocessor(&per_cu, (const void*)mk_fwd, NTHR, LDS_BYTES) != hipSuccess || per_cu < 1) { fprintf(stderr, "occupancy query failed (%d)\n", per_cu); per_cu = 1; }
        if (per_cu > 2) per_cu = 2;
        grid = cus * per_cu;
        fprintf(stderr, "kernel_launch: grid %d (%d CUs x %d)\n", grid, cus, per_cu);
    }
    if (grid < 0) return;
    Params p{};
    for (int i = 0; i < 33; ++i) p.in[i] = (const float*)d_in[i];
    p.out = (float*)d_out; p.ws = (char*)d_ws;
#if MK_ONE_LAUNCH
    if (hipMemsetAsync((char*)d_ws + OFF_XBAR, 0, XCD_BAR_WORDS * 4, stream) != hipSuccess) { fprintf(stderr, "memset failed\n"); return; }
    int lo = 0, hi = N_PHASES - 1;
    void* args[] = {&p, &lo, &hi};
    hipError_t e = hipLaunchCooperativeKernel((const void*)mk_fwd, dim3(grid), dim3(NTHR), args, LDS_BYTES, stream);
    if (e != hipSuccess) fprintf(stderr, "cooperative launch failed: %s (grid %d)\n", hipGetErrorString(e), grid);
#else
    for (int ph = 0; ph < N_PHASES; ++ph) {
        int lo = ph, hi = ph;
        void* args[] = {&p, &lo, &hi};
        hipError_t e = hipLaunchCooperativeKernel((const void*)mk_fwd, dim3(grid), dim3(NTHR), args, LDS_BYTES, stream);
        if (e != hipSuccess) { fprintf(stderr, "launch %d failed: %s (grid %d)\n", ph, hipGetErrorString(e), grid); break; }
    }
#endif
}
```
